# Optimizing an MI355X kernel written in HIP

```python
import jax
import jax.numpy as jnp
from jax import lax
import numpy as np

D_MODEL = 1024
BATCH = 1
SEQ = 16384
DEPTH = 1
DEC_BATCH = 4
DEC_SEQ = 4096
PAST_LEN = 128

GRID_W = 64
Q_BLOCK = 128
ROPE_THETA = 10000.0
EPS = 1e-6

A_HEADS = 8
A_KV_HEADS = 2
A_HEAD_DIM = 64
A_WIDTH = A_HEADS * A_HEAD_DIM

B_HEADS = 8
B_NOPE = 64
B_ROPE = 32
B_V = 64
B_Q_RANK = 384
B_KV_RANK = 256
B_WIDTH = B_HEADS * B_V

IN_SIZES = (A_HEADS * A_HEAD_DIM, A_KV_HEADS * A_HEAD_DIM, A_KV_HEADS * A_HEAD_DIM, A_WIDTH,
            B_Q_RANK, B_KV_RANK, B_ROPE, B_WIDTH, D_MODEL, D_MODEL)
IN_WIDTH = sum(IN_SIZES)

kernel_name = 'hybrid_gqa_mla_encoder'


def _split_points():
    pts, acc = [], 0
    for s in IN_SIZES[:-1]:
        acc += s
        pts.append(acc)
    return pts


def rms_norm(x, g):
    xf = x.astype(jnp.float32)
    y = xf * lax.rsqrt(jnp.mean(xf * xf, axis=-1, keepdims=True) + EPS)
    return (y * g.astype(jnp.float32)).astype(x.dtype)


def axial_rope_tables(n, d_rot):
    rows = n // GRID_W
    row_ids = jnp.repeat(jnp.arange(rows, dtype=jnp.float32), GRID_W)
    col_ids = jnp.tile(jnp.arange(GRID_W, dtype=jnp.float32), rows)
    d_axis = d_rot // 2
    inv = ROPE_THETA ** (-jnp.arange(0, d_axis, 2, dtype=jnp.float32) / d_axis)
    ang = jnp.concatenate([row_ids[:, None] * inv, col_ids[:, None] * inv], axis=-1)
    return jnp.cos(ang), jnp.sin(ang)


def apply_rope(x, cos, sin):
    half = x.shape[-1] // 2
    xf = x.astype(jnp.float32)
    x1, x2 = xf[..., :half], xf[..., half:]
    c = cos[None, :, None, :]
    s = sin[None, :, None, :]
    return jnp.concatenate([x1 * c - x2 * s, x2 * c + x1 * s], axis=-1).astype(x.dtype)


def block_attention(q, k, v, scale):
    bsz, n, h, dk = q.shape
    g = k.shape[2]
    r = h // g
    nb = n // Q_BLOCK
    qb = q.reshape(bsz, nb, Q_BLOCK, g, r, dk).transpose(1, 0, 2, 3, 4, 5)

    def one_block(qblk):
        s = jnp.einsum('bqgrd,bkgd->bgrqk', qblk, k, preferred_element_type=jnp.float32) * scale
        p = jax.nn.softmax(s, axis=-1).astype(v.dtype)
        return jnp.einsum('bgrqk,bkgd->bqgrd', p, v)

    o = lax.map(one_block, qb)
    return o.transpose(1, 0, 2, 3, 4, 5).reshape(bsz, n, h, v.shape[-1])


def encoder_layer(x, c, cos_a, sin_a, cos_b, sin_b, ada_w, ada_b, pre_g, post_g, w_in,
                  a_q_g, a_k_g, b_q_g, b_q_up, b_kv_g, b_kv_up, a_out, b_out, w_o):
    bsz, n, _ = x.shape
    mod = jax.nn.silu(c) @ ada_w + ada_b
    shift, scale, gate = jnp.split(mod[:, None, :], 3, axis=-1)
    h = rms_norm(x, pre_g) * (1.0 + scale) + shift
    aq, ak, av, ag, bq, bkv, bkr, bg, ma, mb = jnp.split(h @ w_in, _split_points(), axis=-1)

    qa = apply_rope(rms_norm(aq.reshape(bsz, n, A_HEADS, A_HEAD_DIM), a_q_g), cos_a, sin_a)
    ka = apply_rope(rms_norm(ak.reshape(bsz, n, A_KV_HEADS, A_HEAD_DIM), a_k_g), cos_a, sin_a)
    va = av.reshape(bsz, n, A_KV_HEADS, A_HEAD_DIM)
    ya = block_attention(qa, ka, va, A_HEAD_DIM ** -0.5).reshape(bsz, n, A_WIDTH) * jax.nn.silu(ag)

    qb = (rms_norm(bq, b_q_g) @ b_q_up).reshape(bsz, n, B_HEADS, B_NOPE + B_ROPE)
    qb = jnp.concatenate([qb[..., :B_NOPE], apply_rope(qb[..., B_NOPE:], cos_b, sin_b)], axis=-1)
    kv = (rms_norm(bkv, b_kv_g) @ b_kv_up).reshape(bsz, n, B_HEADS, B_NOPE + B_V)
    kr = apply_rope(bkr.reshape(bsz, n, 1, B_ROPE), cos_b, sin_b)
    kb = jnp.concatenate([kv[..., :B_NOPE], jnp.broadcast_to(kr, (bsz, n, B_HEADS, B_ROPE))], axis=-1)
    vb = kv[..., B_NOPE:]
    yb = block_attention(qb, kb, vb, (B_NOPE + B_ROPE) ** -0.5).reshape(bsz, n, B_WIDTH) * jax.nn.silu(bg)

    merged = jax.nn.sigmoid(ma) * (ya @ a_out) + jax.nn.sigmoid(mb) * (yb @ b_out)
    return x + gate * rms_norm(merged @ w_o, post_g)


def trunk(x, c, ada_w, ada_b, pre_norm_g, post_norm_g, w_in, a_q_norm_g, a_k_norm_g,
          b_q_norm_g, b_q_up, b_kv_norm_g, b_kv_up, a_out, b_out, w_o):
    n = x.shape[1]
    cos_a, sin_a = axial_rope_tables(n, A_HEAD_DIM)
    cos_b, sin_b = axial_rope_tables(n, B_ROPE)
    for l in range(DEPTH):
        x = encoder_layer(x, c, cos_a, sin_a, cos_b, sin_b, ada_w[l], ada_b[l], pre_norm_g[l],
                          post_norm_g[l], w_in[l], a_q_norm_g[l], a_k_norm_g[l], b_q_norm_g[l],
                          b_q_up[l], b_kv_norm_g[l], b_kv_up[l], a_out[l], b_out[l], w_o[l])
    return x


def setup_inputs(seed: int = 0) -> dict:
    key = jax.random.key(seed)
    ks = jax.random.split(key, 20)
    f32 = jnp.float32

    def nrm(k, shape, s):
        return jax.random.normal(k, shape, f32) * s

    def gain(k, d):
        return 1.0 + 0.02 * jax.random.normal(k, (DEPTH, d), f32)

    return {
        'x_prompt': jax.random.normal(ks[0], (BATCH, SEQ, D_MODEL), f32),
        'x_sample': jax.random.normal(ks[1], (DEC_BATCH, DEC_SEQ, D_MODEL), f32),
        'c_prompt': jax.random.normal(ks[2], (BATCH, D_MODEL), f32),
        'c_sample': jax.random.normal(ks[3], (DEC_BATCH, D_MODEL), f32),
        'ada_w': nrm(ks[4], (DEPTH, D_MODEL, 3 * D_MODEL), 0.2 * D_MODEL ** -0.5),
        'ada_b': nrm(ks[5], (DEPTH, 3 * D_MODEL), 0.02),
        'pre_norm_g': gain(ks[6], D_MODEL),
        'post_norm_g': gain(ks[7], D_MODEL),
        'w_in': nrm(ks[8], (DEPTH, D_MODEL, IN_WIDTH), D_MODEL ** -0.5),
        'a_q_norm_g': gain(ks[9], A_HEAD_DIM),
        'a_k_norm_g': gain(ks[10], A_HEAD_DIM),
        'b_q_norm_g': gain(ks[11], B_Q_RANK),
        'b_q_up': nrm(ks[12], (DEPTH, B_Q_RANK, B_HEADS * (B_NOPE + B_ROPE)), B_Q_RANK ** -0.5),
        'b_kv_norm_g': gain(ks[13], B_KV_RANK),
        'b_kv_up': nrm(ks[14], (DEPTH, B_KV_RANK, B_HEADS * (B_NOPE + B_V)), B_KV_RANK ** -0.5),
        'a_out': nrm(ks[15], (DEPTH, A_WIDTH, D_MODEL), A_WIDTH ** -0.5),
        'b_out': nrm(ks[16], (DEPTH, B_WIDTH, D_MODEL), B_WIDTH ** -0.5),
        'w_o': nrm(ks[17], (DEPTH, D_MODEL, D_MODEL), D_MODEL ** -0.5),
    }


def reference(x_prompt, x_sample, c_prompt, c_sample, ada_w, ada_b, pre_norm_g, post_norm_g,
              w_in, a_q_norm_g, a_k_norm_g, b_q_norm_g, b_q_up, b_kv_norm_g, b_kv_up,
              a_out, b_out, w_o):
    y_prompt = trunk(x_prompt, c_prompt, ada_w, ada_b, pre_norm_g, post_norm_g, w_in,
                     a_q_norm_g, a_k_norm_g, b_q_norm_g, b_q_up, b_kv_norm_g, b_kv_up,
                     a_out, b_out, w_o)
    y_sample = trunk(x_sample, c_sample, ada_w, ada_b, pre_norm_g, post_norm_g, w_in,
                     a_q_norm_g, a_k_norm_g, b_q_norm_g, b_q_up, b_kv_norm_g, b_kv_up,
                     a_out, b_out, w_o)
    return (y_prompt, y_sample)
```

```cpp
#include <hip/hip_runtime.h>
#include <hip/hip_cooperative_groups.h>
#include <stdint.h>
#include <cstdio>
namespace cg = cooperative_groups;

#ifndef MK_SINGLE
#define MK_SINGLE 1
#endif
#ifndef PH_MASK
#define PH_MASK 255
#endif

typedef unsigned short bf16_t;
typedef short bf16x8 __attribute__((ext_vector_type(8)));
typedef short s16x4 __attribute__((ext_vector_type(4)));
typedef float f32x16 __attribute__((ext_vector_type(16)));
typedef unsigned u32x4 __attribute__((ext_vector_type(4)));
typedef unsigned u32x2 __attribute__((ext_vector_type(2)));

constexpr int T = 32768, NP = 16384, NS = 4096, DM = 1024;
constexpr float EPS = 1e-6f;
constexpr float LOG2E = 1.4426950408889634f;
constexpr float PS_A = 0.125f * LOG2E;
constexpr float PS_B = 0.10206207261596575f * LOG2E;

constexpr size_t U = 67108864ull;
constexpr size_t OFF_H = 0;
constexpr size_t OFF_QA = U;
constexpr size_t OFF_KA = U + U / 2;
constexpr size_t OFF_VA = OFF_KA + U / 8;
constexpr size_t OFF_KR = OFF_VA + U / 8;
constexpr size_t OFF_QB = 2 * U;
constexpr size_t OFF_KBN = OFF_QB + (U / 4) * 3;
constexpr size_t OFF_VB = OFF_KBN + U / 2;
constexpr size_t OFF_W = OFF_VB + U / 2;
constexpr size_t OFF_WIN = OFF_W;
constexpr size_t OFF_WQUP = OFF_WIN + 4608ull * 1024 * 2;
constexpr size_t OFF_WKVUP = OFF_WQUP + 768ull * 384 * 2;
constexpr size_t OFF_WAOUT = OFF_WKVUP + 1024ull * 256 * 2;
constexpr size_t OFF_WBOUT = OFF_WAOUT + 1024ull * 512 * 2;
constexpr size_t OFF_WO = OFF_WBOUT + 1024ull * 512 * 2;
constexpr size_t OFF_MOD = OFF_WO + 1024ull * 1024 * 2;
constexpr size_t OFF_SSQ = OFF_MOD + 5 * 3072 * 4;
constexpr size_t OFF_TABA = OFF_SSQ + 3ull * T * 4;
constexpr size_t OFF_TABB = OFF_TABA + 256 * 16 * 8;
constexpr size_t WS_END = OFF_TABB + 256 * 8 * 8;
static_assert(WS_END <= 4 * U, "workspace map exceeds 256 MiB");
constexpr size_t OO_BQ = 0;
constexpr size_t OO_BKV = (size_t)T * 384 * 2;
constexpr size_t OO_YB = 0;
constexpr size_t OO_GA = U;
constexpr size_t OO_GB = U + U / 2;
constexpr size_t OO_MERGED = U;

constexpr int LDS_BYTES = 98304;

struct Params {
  const float *x_prompt, *x_sample, *c_prompt, *c_sample, *ada_w, *ada_b, *pre_g, *post_g, *w_in, *a_q_g, *a_k_g, *b_q_g, *b_q_up,
      *b_kv_g, *b_kv_up, *a_out, *b_out, *w_o;
  float* out;
  char* ws;
};

typedef float f32x2_t __attribute__((ext_vector_type(2)));
typedef __bf16 bf16x2_t __attribute__((ext_vector_type(2)));
__device__ __forceinline__ unsigned cvtpk(float lo, float hi) { f32x2_t v = {lo, hi}; bf16x2_t b = __builtin_convertvector(v, bf16x2_t); return __builtin_bit_cast(unsigned, b); }
__device__ __forceinline__ float bf2f(unsigned short v) { return __uint_as_float(((unsigned)v) << 16); }
__device__ __forceinline__ int crow(int r, int hi) { return (r & 3) + 8 * (r >> 2) + 4 * hi; }
__device__ __forceinline__ void st4(bf16_t* p, float a, float b, float c, float d) { u32x2 w; w.x = cvtpk(a, b); w.y = cvtpk(c, d); *(u32x2*)p = w; }
__device__ __forceinline__ float sigmoidf_(float v) { return 1.0f / (1.0f + __expf(-v)); }
__device__ __forceinline__ const float* xrow_ptr(const Params& p, int tok) { return tok < NP ? p.x_prompt + (size_t)tok * DM : p.x_sample + (size_t)(tok - NP) * DM; }
__device__ __forceinline__ int batch_of(int tok) { return tok < NP ? 0 : 1 + ((tok - NP) >> 12); }
__device__ __forceinline__ int pos_of(int tok) { return tok < NP ? tok : ((tok - NP) & 4095); }

__device__ __forceinline__ int win_src(int n) {
  if (n < 768) return n;
  if (n < 1152) return 1280 + (n - 768);
  if (n < 1408) return 1664 + (n - 1152);
  if (n < 1440) return 1920 + (n - 1408);
  if (n < 1536) return -1;
  if (n < 2048) return 768 + (n - 1536);
  if (n < 2560) return 1952 + (n - 2048);
  return 2464 + (n - 2560);
}
__device__ __forceinline__ void cvt_wt(const float* __restrict__ W, int ldn, int K, bf16_t* __restrict__ dst, int Ndst, bool remap,
                                       const float* __restrict__ gain, int gtid, int gsz) {
  const int kch = K >> 3;
  const int total = Ndst * kch;
  for (int i = gtid; i < total; i += gsz) {
    const int n = i % Ndst, kc = i / Ndst;
    const int src = remap ? win_src(n) : n;
    float v[8];
#pragma unroll
    for (int j = 0; j < 8; ++j) {
      float w = 0.f;
      if (src >= 0) { w = W[(size_t)(kc * 8 + j) * ldn + src]; if (gain) w *= gain[kc * 8 + j]; }
      v[j] = w;
    }
    u32x4 o; o.x = cvtpk(v[0], v[1]); o.y = cvtpk(v[2], v[3]); o.z = cvtpk(v[4], v[5]); o.w = cvtpk(v[6], v[7]);
    *(u32x4*)(dst + (size_t)n * K + kc * 8) = o;
  }
}

__device__ __forceinline__ void phase0(const Params& p, char* lds) {
  const int tid = threadIdx.x, gsz = gridDim.x * 512, gtid = blockIdx.x * 512 + tid;
  float* ssq = (float*)(p.ws + OFF_SSQ);
  for (int i = gtid; i < 3 * T; i += gsz) ssq[i] = 0.f;
  float2* tabA = (float2*)(p.ws + OFF_TABA);
  float2* tabB = (float2*)(p.ws + OFF_TABB);
  for (int i = gtid; i < 256 * 16 + 256 * 8; i += gsz) {
    int pos, f; float inv;
    const float L2T = 13.287712379549449f;
    if (i < 4096) { pos = i >> 4; f = i & 15; inv = exp2f(-(float)f * (1.0f / 16.0f) * L2T); }
    else { int k = i - 4096; pos = k >> 3; f = k & 7; inv = exp2f(-(float)f * (1.0f / 8.0f) * L2T); }
    float ang = (float)pos * inv;
    float rev = ang * 0.15915494309189535f; rev -= floorf(rev);
    float2 cs; cs.x = __builtin_amdgcn_cosf(rev); cs.y = __builtin_amdgcn_sinf(rev);
    if (i < 4096) tabA[i] = cs; else tabB[i - 4096] = cs;
  }
  cvt_wt(p.w_in, 4512, 1024, (bf16_t*)(p.ws + OFF_WIN), 4608, true, nullptr, gtid, gsz);
  cvt_wt(p.b_q_up, 768, 384, (bf16_t*)(p.ws + OFF_WQUP), 768, false, p.b_q_g, gtid, gsz);
  cvt_wt(p.b_kv_up, 1024, 256, (bf16_t*)(p.ws + OFF_WKVUP), 1024, false, p.b_kv_g, gtid, gsz);
  cvt_wt(p.a_out, 1024, 512, (bf16_t*)(p.ws + OFF_WAOUT), 1024, false, nullptr, gtid, gsz);
  cvt_wt(p.b_out, 1024, 512, (bf16_t*)(p.ws + OFF_WBOUT), 1024, false, nullptr, gtid, gsz);
  cvt_wt(p.w_o, 1024, 1024, (bf16_t*)(p.ws + OFF_WO), 1024, false, nullptr, gtid, gsz);
  float* red = (float*)lds;
  float* mod = (float*)(p.ws + OFF_MOD);
  for (int it = blockIdx.x; it < 256; it += gridDim.x) {
    const int c = tid & 15, kg = tid >> 4;
    float a0 = 0.f, a1 = 0.f, a2 = 0.f, a3 = 0.f, a4 = 0.f;
    if (c < 12) {
      const int col = it * 12 + c;
      for (int k = kg; k < 1024; k += 32) {
        const float w = p.ada_w[(size_t)k * 3072 + col];
        float c0 = p.c_prompt[k], c1 = p.c_sample[k], c2 = p.c_sample[1024 + k], c3 = p.c_sample[2048 + k], c4 = p.c_sample[3072 + k];
        a0 += c0 * sigmoidf_(c0) * w; a1 += c1 * sigmoidf_(c1) * w; a2 += c2 * sigmoidf_(c2) * w; a3 += c3 * sigmoidf_(c3) * w; a4 += c4 * sigmoidf_(c4) * w;
      }
    }
    float* rp = red + (kg * 16 + c) * 5;
    rp[0] = a0; rp[1] = a1; rp[2] = a2; rp[3] = a3; rp[4] = a4;
    __syncthreads();
    if (tid < 60) {
      const int cc = tid / 5, b = tid % 5;
      float s = 0.f;
      for (int g = 0; g < 32; ++g) s += red[(g * 16 + cc) * 5 + b];
      const int col = it * 12 + cc;
      mod[b * 3072 + col] = s + p.ada_b[col];
    }
    __syncthreads();
  }
}

__device__ __forceinline__ float wave_sum(float v) {
#pragma unroll
  for (int o = 32; o >= 1; o >>= 1) v += __shfl_xor(v, o);
  return v;
}
__device__ __forceinline__ void phase1(const Params& p) {
  const int tid = threadIdx.x, wid = tid >> 6, lane = tid & 63;
  const float* mod = (const float*)(p.ws + OFF_MOD);
  bf16_t* H = (bf16_t*)(p.ws + OFF_H);
  for (int row = blockIdx.x * 8 + wid; row < T; row += gridDim.x * 8) {
    const float* xr = xrow_ptr(p, row);
    const int b = batch_of(row);
    float4 v[4];
#pragma unroll
    for (int i = 0; i < 4; ++i) v[i] = *(const float4*)(xr + i * 256 + lane * 4);
    float ss = 0.f;
#pragma unroll
    for (int i = 0; i < 4; ++i) ss += v[i].x * v[i].x + v[i].y * v[i].y + v[i].z * v[i].z + v[i].w * v[i].w;
    ss = wave_sum(ss);
    const float rn = rsqrtf(ss * (1.0f / 1024.0f) + EPS);
#pragma unroll
    for (int i = 0; i < 4; ++i) {
      const int col = i * 256 + lane * 4;
      const float4 g = *(const float4*)(p.pre_g + col);
      const float4 sh = *(const float4*)(mod + b * 3072 + col);
      const float4 sc = *(const float4*)(mod + b * 3072 + 1024 + col);
      st4(H + (size_t)row * DM + col, v[i].x * rn * g.x * (1.f + sc.x) + sh.x, v[i].y * rn * g.y * (1.f + sc.y) + sh.y,
          v[i].z * rn * g.z * (1.f + sc.z) + sh.z, v[i].w * rn * g.w * (1.f + sc.w) + sh.w);
    }
  }
}

constexpr int G_XB = 256 * 128, G_WB = 128 * 128, G_STAGE = G_XB + G_WB;
__device__ __forceinline__ int gswz(int row, int c) { return row * 128 + ((c ^ ((row >> 1) & 7)) << 4); }

__device__ __forceinline__ void gemm_kloop(const bf16_t* __restrict__ X, int ldx, const bf16_t* __restrict__ W, int ldw, int nk,
                                           f32x16 (&acc)[2][2], char* lds) {
  const int tid = threadIdx.x, wid = tid >> 6, lane = tid & 63, r32 = lane & 31, hi = lane >> 5, wm = wid & 3, wn = wid >> 2;
  const int srow = tid >> 3, sch = tid & 7;
  const bf16_t* xg = X + (size_t)srow * ldx + sch * 8;
  const bf16_t* wg = W + (size_t)srow * ldw + sch * 8;
  const int sw = gswz(srow, sch);
  u32x4 xr[4], wr[2];
  const int fsw = (r32 >> 1) & 7;
  int koff[4];
#pragma unroll
  for (int ks = 0; ks < 4; ++ks) koff[ks] = ((2 * ks + hi) ^ fsw) << 4;
  const int rowA = G_XB + (wn * 64 + r32) * 128, rowB = (wm * 64 + r32) * 128;
#define GLOAD(kt) do { _Pragma("unroll") for (int i = 0; i < 4; ++i) xr[i] = *(const u32x4*)(xg + (size_t)(64 * i) * ldx + (kt) * 64); \
    _Pragma("unroll") for (int i = 0; i < 2; ++i) wr[i] = *(const u32x4*)(wg + (size_t)(64 * i) * ldw + (kt) * 64); } while (0)
#define GWRITE(s) do { char* b_ = lds + (s) * G_STAGE; _Pragma("unroll") for (int i = 0; i < 4; ++i) *(u32x4*)(b_ + sw + i * 8192) = xr[i]; \
    _Pragma("unroll") for (int i = 0; i < 2; ++i) *(u32x4*)(b_ + G_XB + sw + i * 8192) = wr[i]; } while (0)
  __syncthreads();
  GLOAD(0); GWRITE(0); __syncthreads();
  for (int kt = 0; kt < nk; ++kt) {
    const bool more = kt + 1 < nk;
    if (more) GLOAD(kt + 1);
    const char* sb = lds + (kt & 1) * G_STAGE;
#pragma unroll
    for (int ks = 0; ks < 4; ++ks) {
      const bf16x8 a0 = *(const bf16x8*)(sb + rowA + koff[ks]);
      const bf16x8 a1 = *(const bf16x8*)(sb + rowA + 4096 + koff[ks]);
      const bf16x8 b0 = *(const bf16x8*)(sb + rowB + koff[ks]);
      const bf16x8 b1 = *(const bf16x8*)(sb + rowB + 4096 + koff[ks]);
      acc[0][0] = __builtin_amdgcn_mfma_f32_32x32x16_bf16(a0, b0, acc[0][0], 0, 0, 0);
      acc[0][1] = __builtin_amdgcn_mfma_f32_32x32x16_bf16(a0, b1, acc[0][1], 0, 0, 0);
      acc[1][0] = __builtin_amdgcn_mfma_f32_32x32x16_bf16(a1, b0, acc[1][0], 0, 0, 0);
      acc[1][1] = __builtin_amdgcn_mfma_f32_32x32x16_bf16(a1, b1, acc[1][1], 0, 0, 0);
    }
    if (more) GWRITE((kt + 1) & 1);
    __syncthreads();
  }
#undef GLOAD
#undef GWRITE
}
__device__ __forceinline__ void zero_acc(f32x16 (&acc)[2][2]) {
#pragma unroll
  for (int a = 0; a < 2; ++a)
#pragma unroll
    for (int b = 0; b < 2; ++b)
#pragma unroll
      for (int r = 0; r < 16; ++r) acc[a][b][r] = 0.f;
}

__device__ __forceinline__ void epi_rope64(const f32x16& a0, const f32x16& a1, int t, const float* __restrict__ gain, float ps,
                                           const float2* __restrict__ tabA, bf16_t* dst, int hi) {
  float ss = 0.f;
#pragma unroll
  for (int r = 0; r < 16; ++r) ss += a0[r] * a0[r] + a1[r] * a1[r];
  ss += __shfl_xor(ss, 32);
  const float rn = rsqrtf(ss * (1.0f / 64.0f) + EPS);
  const int prow = t >> 6, pcol = t & 63;
#pragma unroll
  for (int g = 0; g < 4; ++g) {
    const int f0 = 8 * (g & 1) + 4 * hi, pos = g < 2 ? prow : pcol, d = 8 * g + 4 * hi;
    const float4* tp = (const float4*)(tabA + pos * 16 + f0);
    const float4 t01 = tp[0], t23 = tp[1];
    const float4 g1 = *(const float4*)(gain + d), g2 = *(const float4*)(gain + 32 + d);
    const float x10 = a0[4 * g + 0] * rn * g1.x, x11 = a0[4 * g + 1] * rn * g1.y, x12 = a0[4 * g + 2] * rn * g1.z, x13 = a0[4 * g + 3] * rn * g1.w;
    const float x20 = a1[4 * g + 0] * rn * g2.x, x21 = a1[4 * g + 1] * rn * g2.y, x22 = a1[4 * g + 2] * rn * g2.z, x23 = a1[4 * g + 3] * rn * g2.w;
    st4(dst + d, (x10 * t01.x - x20 * t01.y) * ps, (x11 * t01.z - x21 * t01.w) * ps, (x12 * t23.x - x22 * t23.y) * ps, (x13 * t23.z - x23 * t23.w) * ps);
    st4(dst + 32 + d, (x20 * t01.x + x10 * t01.y) * ps, (x21 * t01.z + x11 * t01.w) * ps, (x22 * t23.x + x12 * t23.y) * ps, (x23 * t23.z + x13 * t23.w) * ps);
  }
}
__device__ __forceinline__ void epi_rope32(const f32x16& a, float mul, int t, const float2* __restrict__ tabB, bf16_t* dst, int hi) {
  const int prow = t >> 6, pcol = t & 63;
#pragma unroll
  for (int g = 0; g < 2; ++g) {
    const int pos = g == 0 ? prow : pcol, d = 8 * g + 4 * hi;
    const float4* tp = (const float4*)(tabB + pos * 8 + 4 * hi);
    const float4 t01 = tp[0], t23 = tp[1];
    const float x10 = a[4 * g + 0] * mul, x11 = a[4 * g + 1] * mul, x12 = a[4 * g + 2] * mul, x13 = a[4 * g + 3] * mul;
    const float x20 = a[8 + 4 * g + 0] * mul, x21 = a[8 + 4 * g + 1] * mul, x22 = a[8 + 4 * g + 2] * mul, x23 = a[8 + 4 * g + 3] * mul;
    st4(dst + d, x10 * t01.x - x20 * t01.y, x11 * t01.z - x21 * t01.w, x12 * t23.x - x22 * t23.y, x13 * t23.z - x23 * t23.w);
    st4(dst + 16 + d, x20 * t01.x + x10 * t01.y, x21 * t01.z + x11 * t01.w, x22 * t23.x + x12 * t23.y, x23 * t23.z + x13 * t23.w);
  }
}
__device__ __forceinline__ void epi_plain32(const f32x16& a, float mul, bf16_t* dst, int hi) {
#pragma unroll
  for (int g = 0; g < 4; ++g) st4(dst + 8 * g + 4 * hi, a[4 * g] * mul, a[4 * g + 1] * mul, a[4 * g + 2] * mul, a[4 * g + 3] * mul);
}
__device__ __forceinline__ void epi_silu32(const f32x16& a, bf16_t* dst, int hi) {
#pragma unroll
  for (int g = 0; g < 4; ++g)
    st4(dst + 8 * g + 4 * hi, a[4 * g] * sigmoidf_(a[4 * g]), a[4 * g + 1] * sigmoidf_(a[4 * g + 1]), a[4 * g + 2] * sigmoidf_(a[4 * g + 2]),
        a[4 * g + 3] * sigmoidf_(a[4 * g + 3]));
}
__device__ __forceinline__ float sumsq16(const f32x16& a) {
  float s = 0.f;
#pragma unroll
  for (int r = 0; r < 16; ++r) s += a[r] * a[r];
  return s;
}

__device__ __forceinline__ void phase_g1(const Params& p, char* lds) {
  const int tid = threadIdx.x, wid = tid >> 6, lane = tid & 63, r32 = lane & 31, hi = lane >> 5, wm = wid & 3, wn = wid >> 2;
  const bf16_t* H = (const bf16_t*)(p.ws + OFF_H);
  const bf16_t* WIN = (const bf16_t*)(p.ws + OFF_WIN);
  const float2* tabA = (const float2*)(p.ws + OFF_TABA);
  const float2* tabB = (const float2*)(p.ws + OFF_TABB);
  float* ssq = (float*)(p.ws + OFF_SSQ);
  char* dout = (char*)p.out;
  for (int tile = blockIdx.x; tile < 128 * 20; tile += gridDim.x) {
    const int mt = tile / 20, nt = tile % 20, m0 = mt * 256;
    f32x16 acc[2][2];
    zero_acc(acc);
    gemm_kloop(H + (size_t)m0 * DM, DM, WIN + (size_t)nt * 128 * DM, DM, 16, acc, lds);
#pragma unroll
    for (int ti = 0; ti < 2; ++ti) {
      const int tok = m0 + wm * 64 + ti * 32 + r32;
      const int t = pos_of(tok);
      if (nt < 4) {
        const int head = nt * 2 + wn;
        epi_rope64(acc[0][ti], acc[1][ti], t, p.a_q_g, PS_A, tabA, (bf16_t*)(p.ws + OFF_QA) + (size_t)tok * 512 + head * 64, hi);
      } else if (nt == 4) {
        epi_rope64(acc[0][ti], acc[1][ti], t, p.a_k_g, 1.0f, tabA, (bf16_t*)(p.ws + OFF_KA) + (size_t)tok * 128 + wn * 64, hi);
      } else if (nt == 5) {
        bf16_t* d = (bf16_t*)(p.ws + OFF_VA) + (size_t)tok * 128 + wn * 64;
        epi_plain32(acc[0][ti], 1.0f, d, hi); epi_plain32(acc[1][ti], 1.0f, d + 32, hi);
      } else if (nt < 9) {
        bf16_t* d = (bf16_t*)(dout + OO_BQ) + (size_t)tok * 384 + (nt - 6) * 128 + wn * 64;
        epi_plain32(acc[0][ti], 1.0f, d, hi); epi_plain32(acc[1][ti], 1.0f, d + 32, hi);
        float s = sumsq16(acc[0][ti]) + sumsq16(acc[1][ti]); s += __shfl_xor(s, 32);
        if (hi == 0) atomicAdd(ssq + tok, s);
      } else if (nt < 11) {
        bf16_t* d = (bf16_t*)(dout + OO_BKV) + (size_t)tok * 256 + (nt - 9) * 128 + wn * 64;
        epi_plain32(acc[0][ti], 1.0f, d, hi); epi_plain32(acc[1][ti], 1.0f, d + 32, hi);
        float s = sumsq16(acc[0][ti]) + sumsq16(acc[1][ti]); s += __shfl_xor(s, 32);
        if (hi == 0) atomicAdd(ssq + T + tok, s);
      } else if (nt == 11) {
        if (wn == 0) epi_rope32(acc[0][ti], 1.0f, t, tabB, (bf16_t*)(p.ws + OFF_KR) + (size_t)tok * 32, hi);
      } else if (nt < 16) {
        bf16_t* d = (bf16_t*)(dout + OO_GA) + (size_t)tok * 512 + (nt - 12) * 128 + wn * 64;
        epi_silu32(acc[0][ti], d, hi); epi_silu32(acc[1][ti], d + 32, hi);
      } else {
        bf16_t* d = (bf16_t*)(dout + OO_GB) + (size_t)tok * 512 + (nt - 16) * 128 + wn * 64;
        epi_silu32(acc[0][ti], d, hi); epi_silu32(acc[1][ti], d + 32, hi);
      }
    }
  }
}

__device__ __forceinline__ void phase_g2(const Params& p, char* lds) {
  const int tid = threadIdx.x, wid = tid >> 6, lane = tid & 63, r32 = lane & 31, hi = lane >> 5, wm = wid & 3, wn = wid >> 2;
  const float2* tabB = (const float2*)(p.ws + OFF_TABB);
  const float* ssq = (const float*)(p.ws + OFF_SSQ);
  char* dout = (char*)p.out;
  for (int tile = blockIdx.x; tile < 128 * 14; tile += gridDim.x) {
    const int mt = tile / 14, j = tile % 14, m0 = mt * 256;
    f32x16 acc[2][2];
    zero_acc(acc);
    if (j < 6) {
      gemm_kloop((const bf16_t*)(dout + OO_BQ) + (size_t)m0 * 384, 384, (const bf16_t*)(p.ws + OFF_WQUP) + (size_t)j * 128 * 384, 384, 6, acc, lds);
#pragma unroll
      for (int ti = 0; ti < 2; ++ti) {
        const int tok = m0 + wm * 64 + ti * 32 + r32;
        const int t = pos_of(tok);
        const float rn = rsqrtf(ssq[tok] * (1.0f / 384.0f) + EPS) * PS_B;
#pragma unroll
        for (int fi = 0; fi < 2; ++fi) {
          const int blk = j * 4 + wn * 2 + fi;
          bf16_t* d = (bf16_t*)(p.ws + OFF_QB) + (size_t)tok * 768 + blk * 32;
          if (blk % 3 == 2) epi_rope32(acc[fi][ti], rn, t, tabB, d, hi);
          else epi_plain32(acc[fi][ti], rn, d, hi);
        }
      }
    } else {
      const int jn = j - 6;
      gemm_kloop((const bf16_t*)(dout + OO_BKV) + (size_t)m0 * 256, 256, (const bf16_t*)(p.ws + OFF_WKVUP) + (size_t)jn * 128 * 256, 256, 4, acc, lds);
#pragma unroll
      for (int ti = 0; ti < 2; ++ti) {
        const int tok = m0 + wm * 64 + ti * 32 + r32;
        const float rn = rsqrtf(ssq[T + tok] * (1.0f / 256.0f) + EPS);
        bf16_t* d = (bf16_t*)(p.ws + (wn == 0 ? OFF_KBN : OFF_VB)) + (size_t)tok * 512 + jn * 64;
        epi_plain32(acc[0][ti], rn, d, hi); epi_plain32(acc[1][ti], rn, d + 32, hi);
      }
    }
  }
}

__device__ __forceinline__ void phase_g3(const Params& p, char* lds) {
  const int tid = threadIdx.x, wid = tid >> 6, lane = tid & 63, r32 = lane & 31, hi = lane >> 5, wm = wid & 3, wn = wid >> 2;
  char* dout = (char*)p.out;
  const bf16_t* H = (const bf16_t*)(p.ws + OFF_H);
  const bf16_t* WIN = (const bf16_t*)(p.ws + OFF_WIN);
  bf16_t* MG = (bf16_t*)(dout + OO_MERGED);
  for (int tile = blockIdx.x; tile < 128 * 8; tile += gridDim.x) {
    const int mt = tile >> 3, nt = tile & 7, m0 = mt * 256;
    for (int s = 0; s < 2; ++s) {
      f32x16 acc[2][2];
      zero_acc(acc);
      const bf16_t* Y = s == 0 ? (const bf16_t*)(p.ws + OFF_QA) : (const bf16_t*)(dout + OO_YB);
      const bf16_t* WOUT = (const bf16_t*)(p.ws + (s == 0 ? OFF_WAOUT : OFF_WBOUT));
      gemm_kloop(H + (size_t)m0 * DM, DM, WIN + (size_t)(2560 + s * 1024 + nt * 128) * DM, DM, 16, acc, lds);
      unsigned gpk[2][2][8];
#pragma unroll
      for (int fi = 0; fi < 2; ++fi)
#pragma unroll
        for (int ti = 0; ti < 2; ++ti)
#pragma unroll
          for (int q = 0; q < 8; ++q) gpk[fi][ti][q] = cvtpk(sigmoidf_(acc[fi][ti][2 * q]), sigmoidf_(acc[fi][ti][2 * q + 1]));
      zero_acc(acc);
      gemm_kloop(Y + (size_t)m0 * 512, 512, WOUT + (size_t)nt * 128 * 512, 512, 8, acc, lds);
#pragma unroll
      for (int ti = 0; ti < 2; ++ti) {
        const int tok = m0 + wm * 64 + ti * 32 + r32;
#pragma unroll
        for (int fi = 0; fi < 2; ++fi) {
          bf16_t* d = MG + (size_t)tok * DM + nt * 128 + wn * 64 + fi * 32;
#pragma unroll
          for (int g = 0; g < 4; ++g) {
            const unsigned g01 = gpk[fi][ti][2 * g], g23 = gpk[fi][ti][2 * g + 1];
            float v0 = __uint_as_float(g01 << 16) * acc[fi][ti][4 * g], v1 = __uint_as_float(g01 & 0xffff0000u) * acc[fi][ti][4 * g + 1];
            float v2 = __uint_as_float(g23 << 16) * acc[fi][ti][4 * g + 2], v3 = __uint_as_float(g23 & 0xffff0000u) * acc[fi][ti][4 * g + 3];
            bf16_t* dd = d + 8 * g + 4 * hi;
            if (s == 1) {
              const u32x2 o = *(const u32x2*)dd;
              v0 += __uint_as_float(o.x << 16); v1 += __uint_as_float(o.x & 0xffff0000u); v2 += __uint_as_float(o.y << 16); v3 += __uint_as_float(o.y & 0xffff0000u);
            }
            st4(dd, v0, v1, v2, v3);
          }
        }
      }
    }
  }
}

__device__ __forceinline__ void phase_g4(const Params& p, char* lds) {
  const int tid = threadIdx.x, wid = tid >> 6, lane = tid & 63, r32 = lane & 31, hi = lane >> 5, wm = wid & 3, wn = wid >> 2;
  char* dout = (char*)p.out;
  const bf16_t* MG = (const bf16_t*)(dout + OO_MERGED);
  bf16_t* Z = (bf16_t*)(p.ws + OFF_H);
  float* ssq = (float*)(p.ws + OFF_SSQ) + 2 * T;
  for (int tile = blockIdx.x; tile < 128 * 8; tile += gridDim.x) {
    const int mt = tile >> 3, nt = tile & 7, m0 = mt * 256;
    f32x16 acc[2][2];
    zero_acc(acc);
    gemm_kloop(MG + (size_t)m0 * DM, DM, (const bf16_t*)(p.ws + OFF_WO) + (size_t)nt * 128 * DM, DM, 16, acc, lds);
#pragma unroll
    for (int ti = 0; ti < 2; ++ti) {
      const int tok = m0 + wm * 64 + ti * 32 + r32;
      bf16_t* d = Z + (size_t)tok * DM + nt * 128 + wn * 64;
      epi_plain32(acc[0][ti], 1.0f, d, hi); epi_plain32(acc[1][ti], 1.0f, d + 32, hi);
      float s = sumsq16(acc[0][ti]) + sumsq16(acc[1][ti]); s += __shfl_xor(s, 32);
      if (hi == 0) atomicAdd(ssq + tok, s);
    }
  }
}

__device__ __forceinline__ void phase5(const Params& p) {
  const int tid = threadIdx.x, wid = tid >> 6, lane = tid & 63;
  const float* mod = (const float*)(p.ws + OFF_MOD);
  const bf16_t* Z = (const bf16_t*)(p.ws + OFF_H);
  const float* ssq = (const float*)(p.ws + OFF_SSQ) + 2 * T;
  for (int row = blockIdx.x * 8 + wid; row < T; row += gridDim.x * 8) {
    const float* xr = xrow_ptr(p, row);
    const int b = batch_of(row);
    const float rn = rsqrtf(ssq[row] * (1.0f / 1024.0f) + EPS);
    float* o = p.out + (size_t)row * DM;
#pragma unroll
    for (int i = 0; i < 4; ++i) {
      const int col = i * 256 + lane * 4;
      const float4 xv = *(const float4*)(xr + col);
      const u32x2 zz = *(const u32x2*)(Z + (size_t)row * DM + col);
      const float4 g = *(const float4*)(p.post_g + col);
      const float4 gt = *(const float4*)(mod + b * 3072 + 2048 + col);
      float4 r;
      r.x = xv.x + gt.x * (__uint_as_float(zz.x << 16) * rn * g.x);
      r.y = xv.y + gt.y * (__uint_as_float(zz.x & 0xffff0000u) * rn * g.y);
      r.z = xv.z + gt.z * (__uint_as_float(zz.y << 16) * rn * g.z);
      r.w = xv.w + gt.w * (__uint_as_float(zz.y & 0xffff0000u) * rn * g.w);
      *(float4*)(o + col) = r;
    }
  }
}

#define SBAR() __builtin_amdgcn_sched_barrier(0)
constexpr float ATT_THR = 8.0f;
constexpr int SHM_V = 64 * 64 * 2;
template <int DK> struct KL { static constexpr int RB = DK == 64 ? 128 : 256; static constexpr int SHM_K = 64 * RB; };
template <int DK> __device__ __forceinline__ int kswz(int row, int c) {
  if (DK == 64) return row * 128 + ((c ^ ((row >> 1) & 7)) << 4);
  return row * 256 + ((c ^ (row & 15)) << 4);
}
__device__ __forceinline__ int v_st(int k, int c) {
  const int kk = (k & ~0xC) | ((k & 4) << 1) | ((k & 8) >> 1);
  return ((kk >> 3) * 2 + (c >> 5)) * 512 + ((kk & 7) * 32 + (c & 31)) * 2;
}
__device__ __forceinline__ int v_rd_base(int lane) { return ((lane & 3) << 3) | (((lane >> 2) & 3) << 6) | (((lane >> 4) & 1) << 5) | (((lane >> 5) & 1) << 8); }
constexpr int v_rd_off(int d0, int ks, int half) { return d0 * 512 + ks * 2048 + half * 1024; }
template <int OFF> __device__ __forceinline__ s16x4 tr_read(int vb) {
  s16x4 r; asm volatile("ds_read_b64_tr_b16 %0, %1 offset:%2" : "=&v"(r) : "v"(vb), "i"(OFF) : "memory"); return r;
}
template <int D0> __device__ __forceinline__ void pv_one(f32x16& od, int vb, bf16x8 pa0, bf16x8 pa1, bf16x8 pa2, bf16x8 pa3) {
  const s16x4 l0 = tr_read<v_rd_off(D0, 0, 0)>(vb), h0 = tr_read<v_rd_off(D0, 0, 1)>(vb), l1 = tr_read<v_rd_off(D0, 1, 0)>(vb), h1 = tr_read<v_rd_off(D0, 1, 1)>(vb);
  const s16x4 l2 = tr_read<v_rd_off(D0, 2, 0)>(vb), h2 = tr_read<v_rd_off(D0, 2, 1)>(vb), l3 = tr_read<v_rd_off(D0, 3, 0)>(vb), h3 = tr_read<v_rd_off(D0, 3, 1)>(vb);
  asm volatile("s_waitcnt lgkmcnt(0)" ::: "memory"); SBAR();
#define PK(L, Hh) (bf16x8){L[0], L[1], L[2], L[3], Hh[0], Hh[1], Hh[2], Hh[3]}
  od = __builtin_amdgcn_mfma_f32_32x32x16_bf16(pa0, PK(l0, h0), od, 0, 0, 0);
  od = __builtin_amdgcn_mfma_f32_32x32x16_bf16(pa1, PK(l1, h1), od, 0, 0, 0);
  od = __builtin_amdgcn_mfma_f32_32x32x16_bf16(pa2, PK(l2, h2), od, 0, 0, 0);
  od = __builtin_amdgcn_mfma_f32_32x32x16_bf16(pa3, PK(l3, h3), od, 0, 0, 0);
#undef PK
}
__device__ __forceinline__ void pv_all(f32x16* o, int vb, bf16x8 pa0, bf16x8 pa1, bf16x8 pa2, bf16x8 pa3) {
  pv_one<0>(o[0], vb, pa0, pa1, pa2, pa3); pv_one<1>(o[1], vb, pa0, pa1, pa2, pa3);
}
__device__ __forceinline__ void partialSM(f32x16& p0, f32x16& p1, float& m_reg, float& alpha) {
  float pmax = p0[0];
#pragma unroll
  for (int r = 1; r < 16; ++r) pmax = fmaxf(pmax, p0[r]);
#pragma unroll
  for (int r = 0; r < 16; ++r) pmax = fmaxf(pmax, p1[r]);
  { auto rr = __builtin_amdgcn_permlane32_swap(__float_as_uint(pmax), __float_as_uint(pmax), false, false);
    pmax = fmaxf(__uint_as_float(rr[0]), __uint_as_float(rr[1])); }
  float mn;
  if (__builtin_expect(__all(pmax - m_reg <= ATT_THR), 1)) { mn = m_reg; alpha = 1.f; }
  else { mn = fmaxf(m_reg, pmax); alpha = __builtin_amdgcn_exp2f(m_reg - mn); m_reg = mn; }
#pragma unroll
  for (int r = 0; r < 16; ++r) p0[r] -= mn;
#pragma unroll
  for (int r = 0; r < 16; ++r) p1[r] -= mn;
#pragma unroll
  for (int r = 0; r < 16; ++r) p0[r] = __builtin_amdgcn_exp2f(p0[r]);
}
__device__ __forceinline__ void finishSM(f32x16& p0, f32x16& p1, float alpha, float& l_reg, bf16x8& pa0, bf16x8& pa1, bf16x8& pa2, bf16x8& pa3) {
#pragma unroll
  for (int r = 0; r < 16; ++r) p1[r] = __builtin_amdgcn_exp2f(p1[r]);
  float ps = 0.f;
#pragma unroll
  for (int r = 0; r < 16; ++r) ps += p0[r];
#pragma unroll
  for (int r = 0; r < 16; ++r) ps += p1[r];
  { auto rr = __builtin_amdgcn_permlane32_swap(__float_as_uint(ps), __float_as_uint(ps), false, false);
    ps = __uint_as_float(rr[0]) + __uint_as_float(rr[1]); }
  l_reg = l_reg * alpha + ps;
#define PK4(P, BASE, OUT) do { unsigned a0 = cvtpk(P[BASE + 0], P[BASE + 1]), a1 = cvtpk(P[BASE + 2], P[BASE + 3]);   \
    unsigned b0 = cvtpk(P[BASE + 4], P[BASE + 5]), b1 = cvtpk(P[BASE + 6], P[BASE + 7]);                              \
    auto r0 = __builtin_amdgcn_permlane32_swap(a0, b0, false, false); auto r1 = __builtin_amdgcn_permlane32_swap(a1, b1, false, false); \
    u32x4 w = {r0[0], r1[0], r0[1], r1[1]}; OUT = *reinterpret_cast<bf16x8*>(&w); } while (0)
  PK4(p0, 0, pa0); PK4(p0, 8, pa1); PK4(p1, 0, pa2); PK4(p1, 8, pa3);
#undef PK4
}
template <int DK> __device__ __forceinline__ void qkt(f32x16& p0, f32x16& p1, const char* Ks, const bf16x8* qr, int r32, int hi) {
#pragma unroll
  for (int r = 0; r < 16; ++r) { p0[r] = 0.f; p1[r] = 0.f; }
#pragma unroll
  for (int d0 = 0; d0 < DK / 16; ++d0) {
    const int off = kswz<DK>(r32, 2 * d0 + hi);
    const bf16x8 b0 = *reinterpret_cast<const bf16x8*>(Ks + off);
    const bf16x8 b1 = *reinterpret_cast<const bf16x8*>(Ks + off + 32 * KL<DK>::RB);
    p0 = __builtin_amdgcn_mfma_f32_32x32x16_bf16(b0, qr[d0], p0, 0, 0, 0);
    p1 = __builtin_amdgcn_mfma_f32_32x32x16_bf16(b1, qr[d0], p1, 0, 0, 0);
  }
}

template <int DK>
__device__ __forceinline__ void attn_unit(const bf16_t* Qb, int ldq, const bf16_t* __restrict__ Kh, int ldk, const bf16_t* __restrict__ Krp,
                                          const bf16_t* __restrict__ Vh, int ldv, const bf16_t* Gb, bf16_t* Ob, int seq, char* lds) {
  constexpr int SHM_K = KL<DK>::SHM_K;
  const int tid = threadIdx.x, wid = tid >> 6, lane = tid & 63, r32 = lane & 31, hi = lane >> 5;
  char* V_lds = lds; char* K_lds = lds + 2 * SHM_V;
  float* ws = (float*)(lds + 2 * SHM_V + 2 * SHM_K) + wid * 64; float* li_l = ws; float* al_l = ws + 32;
  float m_reg = -1e30f, l_reg = 0.f; f32x16 o[2]; bf16x8 qr[DK / 16];
#pragma unroll
  for (int r = 0; r < 16; ++r) { o[0][r] = 0.f; o[1][r] = 0.f; }
  const bf16_t* Qw = Qb + (size_t)(wid * 32 + r32) * ldq + hi * 8;
#pragma unroll
  for (int d0 = 0; d0 < DK / 16; ++d0) qr[d0] = *reinterpret_cast<const bf16x8*>(Qw + d0 * 16);
  const int srow = tid >> 3, sc = tid & 7, vst = v_st(srow, sc * 8), kst = kswz<DK>(srow, sc);
  const int rrow = tid >> 2, rc = tid & 3, krst = kswz<DK>(rrow & 63, 8 + rc);
  const bool dor = (DK == 96) && (wid < 4);
  const int vb0 = (int)(uintptr_t)V_lds + v_rd_base(lane);
  struct { u32x4 v, k, r; } sr_[2];
  const unsigned voff0 = (unsigned)(srow * ldv + sc * 8) * 2u, koff0 = (unsigned)(srow * ldk + sc * 8) * 2u, roff0 = (unsigned)(rrow * 32 + rc * 8) * 2u;
#define SLOAD(i, k0) do { sr_[i].v = *(const u32x4*)((const char*)Vh + (voff0 + (unsigned)((k0) * ldv) * 2u)); sr_[i].k = *(const u32x4*)((const char*)Kh + (koff0 + (unsigned)((k0) * ldk) * 2u)); \
    if (dor) sr_[i].r = *(const u32x4*)((const char*)Krp + (roff0 + (unsigned)((k0) * 64))); } while (0)
#define SWRITE(b, i) do { *(u32x4*)(V_lds + (b) * SHM_V + vst) = sr_[i].v; *(u32x4*)(K_lds + (b) * SHM_K + kst) = sr_[i].k; \
    if (dor) *(u32x4*)(K_lds + (b) * SHM_K + krst) = sr_[i].r; } while (0)
#define RESC(a) do { if (__any((a) < 1.f)) { if (hi == 0) al_l[r32] = (a); asm volatile("s_waitcnt lgkmcnt(0)" ::: "memory"); \
    _Pragma("unroll") for (int d = 0; d < 2; ++d) _Pragma("unroll") for (int r = 0; r < 16; ++r) o[d][r] *= al_l[crow(r, hi)]; } } while (0)
  f32x16 pA0, pA1, pB0, pB1; float alA, alB; bf16x8 pa0, pa1, pa2, pa3; const int NT = seq / 64;
  __syncthreads();
  SLOAD(0, 0); SWRITE(0, 0); __syncthreads();
  qkt<DK>(pA0, pA1, K_lds, qr, r32, hi); partialSM(pA0, pA1, m_reg, alA);
  SLOAD(1, 64); if (2 < NT) SLOAD(0, 128);
  SWRITE(1, 1); __syncthreads();
  for (int j = 1; j + 1 < NT; j += 2) {
    SBAR(); qkt<DK>(pB0, pB1, K_lds + SHM_K, qr, r32, hi);
    finishSM(pA0, pA1, alA, l_reg, pa0, pa1, pa2, pa3); SBAR();
    SLOAD(1, (j + 2) * 64); SBAR();
    pv_all(o, vb0, pa0, pa1, pa2, pa3); partialSM(pB0, pB1, m_reg, alB);
    __syncthreads(); SWRITE(0, 0);
    RESC(alB); __syncthreads();
    SBAR(); qkt<DK>(pA0, pA1, K_lds, qr, r32, hi);
    finishSM(pB0, pB1, alB, l_reg, pa0, pa1, pa2, pa3); SBAR();
    if (j + 3 < NT) SLOAD(0, (j + 3) * 64); SBAR();
    pv_all(o, vb0 + SHM_V, pa0, pa1, pa2, pa3); partialSM(pA0, pA1, m_reg, alA);
    __syncthreads(); SWRITE(1, 1);
    RESC(alA); __syncthreads();
  }
  SBAR(); qkt<DK>(pB0, pB1, K_lds + SHM_K, qr, r32, hi);
  finishSM(pA0, pA1, alA, l_reg, pa0, pa1, pa2, pa3); SBAR();
  pv_all(o, vb0, pa0, pa1, pa2, pa3); partialSM(pB0, pB1, m_reg, alB);
  __syncthreads(); RESC(alB);
  finishSM(pB0, pB1, alB, l_reg, pa0, pa1, pa2, pa3); SBAR();
  pv_all(o, vb0 + SHM_V, pa0, pa1, pa2, pa3);
  if (hi == 0) li_l[r32] = l_reg; asm volatile("s_waitcnt lgkmcnt(0)" ::: "memory");
  float rli[16];
#pragma unroll
  for (int r = 0; r < 16; ++r) rli[r] = __builtin_amdgcn_rcpf(li_l[crow(r, hi)]);
#pragma unroll
  for (int r = 0; r < 16; ++r) {
    const size_t rowo = (size_t)(wid * 32 + crow(r, hi)) * 512;
#pragma unroll
    for (int d0 = 0; d0 < 2; ++d0) {
      const size_t idx = rowo + d0 * 32 + r32;
      const float g = bf2f(Gb[idx]);
      Ob[idx] = (bf16_t)(cvtpk(o[d0][r] * rli[r] * g, 0.f) & 0xffffu);
    }
  }
#undef SLOAD
#undef SWRITE
#undef RESC
}

__device__ __forceinline__ void phase_attn(const Params& p, char* lds) {
  char* dout = (char*)p.out;
  for (int u = blockIdx.x; u < 2048; u += gridDim.x) {
    const int i = u >> 8, v = u & 255, cls = i >> 1, sub = i & 1, head = v & 7, j = v >> 3;
    int seq0, seq, tok0;
    if (cls < 2) { seq0 = 0; seq = NP; tok0 = (2 * j + sub) * 256; }
    else { const int bi = j >> 3, qb = 2 * (j & 7) + sub; seq0 = NP + bi * NS; seq = NS; tok0 = seq0 + qb * 256; }
    if ((cls & 1) == 0) {
      bf16_t* QA = (bf16_t*)(p.ws + OFF_QA);
      attn_unit<64>(QA + (size_t)tok0 * 512 + head * 64, 512, (const bf16_t*)(p.ws + OFF_KA) + (size_t)seq0 * 128 + (head >> 2) * 64, 128, nullptr,
                    (const bf16_t*)(p.ws + OFF_VA) + (size_t)seq0 * 128 + (head >> 2) * 64, 128,
                    (const bf16_t*)(dout + OO_GA) + (size_t)tok0 * 512 + head * 64, QA + (size_t)tok0 * 512 + head * 64, seq, lds);
    } else {
      attn_unit<96>((const bf16_t*)(p.ws + OFF_QB) + (size_t)tok0 * 768 + head * 96, 768, (const bf16_t*)(p.ws + OFF_KBN) + (size_t)seq0 * 512 + head * 64, 512,
                    (const bf16_t*)(p.ws + OFF_KR) + (size_t)seq0 * 32, (const bf16_t*)(p.ws + OFF_VB) + (size_t)seq0 * 512 + head * 64, 512,
                    (const bf16_t*)(dout + OO_GB) + (size_t)tok0 * 512 + head * 64, (bf16_t*)(dout + OO_YB) + (size_t)tok0 * 512 + head * 64, seq, lds);
    }
  }
}

#if MK_SINGLE
__global__ void __launch_bounds__(512) fwd_kernel(Params p) {
  extern __shared__ __attribute__((aligned(16))) char lds[];
#define PHASE(k, call) if (PH_MASK & (1 << k)) { call; if (k < 7) cg::this_grid().sync(); }
  PHASE(0, phase0(p, lds))
  PHASE(1, phase1(p))
  PHASE(2, phase_g1(p, lds))
  PHASE(3, phase_g2(p, lds))
  PHASE(4, phase_attn(p, lds))
  PHASE(5, phase_g3(p, lds))
  PHASE(6, phase_g4(p, lds))
  PHASE(7, phase5(p))
#undef PHASE
}
#define MAIN_KERNEL fwd_kernel
#else
template <int PH>
__global__ void __launch_bounds__(512) ph_kernel(Params p) {
  extern __shared__ __attribute__((aligned(16))) char lds[];
  if (PH == 0) phase0(p, lds);
  if (PH == 1) phase1(p);
  if (PH == 2) phase_g1(p, lds);
  if (PH == 3) phase_g2(p, lds);
  if (PH == 4) phase_attn(p, lds);
  if (PH == 5) phase_g3(p, lds);
  if (PH == 6) phase_g4(p, lds);
  if (PH == 7) phase5(p);
}
#define MAIN_KERNEL ph_kernel<4>
#endif

extern "C" void kernel_launch(void* const* d_in, const int* in_sizes, int n_in, void* d_out, int out_size, void* d_ws, size_t ws_size,
                              hipStream_t stream) {
  Params p{};
  p.x_prompt = (const float*)d_in[0]; p.x_sample = (const float*)d_in[1]; p.c_prompt = (const float*)d_in[2]; p.c_sample = (const float*)d_in[3];
  p.ada_w = (const float*)d_in[4]; p.ada_b = (const float*)d_in[5]; p.pre_g = (const float*)d_in[6]; p.post_g = (const float*)d_in[7];
  p.w_in = (const float*)d_in[8]; p.a_q_g = (const float*)d_in[9]; p.a_k_g = (const float*)d_in[10]; p.b_q_g = (const float*)d_in[11];
  p.b_q_up = (const float*)d_in[12]; p.b_kv_g = (const float*)d_in[13]; p.b_kv_up = (const float*)d_in[14]; p.a_out = (const float*)d_in[15];
  p.b_out = (const float*)d_in[16]; p.w_o = (const float*)d_in[17];
  p.out = (float*)d_out; p.ws = (char*)d_ws;
  static int grid_blocks = 0;
  if (!grid_blocks) {
    int dev = 0, cus = 0, per_cu = 0;
    (void)hipGetDevice(&dev);
    (void)hipDeviceGetAttribute(&cus, hipDeviceAttributeMultiprocessorCount, dev);
    (void)hipFuncSetAttribute((const void*)MAIN_KERNEL, hipFuncAttributeMaxDynamicSharedMemorySize, LDS_BYTES);
    (void)hipOccupancyMaxActiveBlocksPerMultiprocessor(&per_cu, MAIN_KERNEL, 512, LDS_BYTES);
    if (per_cu < 1) per_cu = 1;
    if (per_cu > 1) per_cu = 1;
    grid_blocks = cus * per_cu;
    if (grid_blocks <= 0) grid_blocks = 256;
  }
#if MK_SINGLE
  void* args[] = {&p};
  hipError_t err = hipLaunchCooperativeKernel((const void*)fwd_kernel, dim3(grid_blocks), dim3(512), args, LDS_BYTES, stream);
  if (err != hipSuccess) fprintf(stderr, "cooperative launch failed: %s (grid %d)\n", hipGetErrorString(err), grid_blocks);
#else
  static bool attr_set = false;
  if (!attr_set) {
    (void)hipFuncSetAttribute((const void*)ph_kernel<0>, hipFuncAttributeMaxDynamicSharedMemorySize, LDS_BYTES);
    (void)hipFuncSetAttribute((const void*)ph_kernel<2>, hipFuncAttributeMaxDynamicSharedMemorySize, LDS_BYTES);
    (void)hipFuncSetAttribute((const void*)ph_kernel<3>, hipFuncAttributeMaxDynamicSharedMemorySize, LDS_BYTES);
    (void)hipFuncSetAttribute((const void*)ph_kernel<5>, hipFuncAttributeMaxDynamicSharedMemorySize, LDS_BYTES);
    (void)hipFuncSetAttribute((const void*)ph_kernel<6>, hipFuncAttributeMaxDynamicSharedMemorySize, LDS_BYTES);
    attr_set = true;
  }
  hipLaunchKernelGGL(ph_kernel<0>, dim3(grid_blocks), dim3(512), LDS_BYTES, stream, p);
  hipLaunchKernelGGL(ph_kernel<1>, dim3(grid_blocks), dim3(512), LDS_BYTES, stream, p);
  hipLaunchKernelGGL(ph_kernel<2>, dim3(grid_blocks), dim3(512), LDS_BYTES, stream, p);
  hipLaunchKernelGGL(ph_kernel<3>, dim3(grid_blocks), dim3(512), LDS_BYTES, stream, p);
  hipLaunchKernelGGL(ph_kernel<4>, dim3(grid_blocks), dim3(512), LDS_BYTES, stream, p);
  hipLaunchKernelGGL(ph_kernel<5>, dim3(grid_blocks), dim3(512), LDS_BYTES, stream, p);
  hipLaunchKernelGGL(ph_kernel<6>, dim3(grid_blocks), dim3(512), LDS_BYTES, stream, p);
  hipLaunchKernelGGL(ph_kernel<7>, dim3(grid_blocks), dim3(512), LDS_BYTES, stream, p);
#endif
}
```

```cpp
#include <hip/hip_runtime.h>
#include <hip/hip_cooperative_groups.h>
#include <stdint.h>
#include <cstdio>
namespace cg = cooperative_groups;

#ifndef MK_SINGLE
#define MK_SINGLE 1
#endif
#ifndef QKT_SB
#define QKT_SB 0
#endif
#ifndef ATT_SAFE
#define ATT_SAFE 1
#endif
#ifndef PH_MASK
#define PH_MASK 255
#endif

typedef unsigned short bf16_t;
typedef short bf16x8 __attribute__((ext_vector_type(8)));
typedef short s16x4 __attribute__((ext_vector_type(4)));
typedef float f32x16 __attribute__((ext_vector_type(16)));
typedef unsigned u32x4 __attribute__((ext_vector_type(4)));
typedef unsigned u32x2 __attribute__((ext_vector_type(2)));

constexpr int T = 32768, NP = 16384, NS = 4096, DM = 1024;
constexpr float EPS = 1e-6f;
constexpr float LOG2E = 1.4426950408889634f;
constexpr float PS_A = 0.125f * LOG2E;
constexpr float PS_B = 0.10206207261596575f * LOG2E;

constexpr size_t U = 67108864ull;
constexpr size_t OFF_H = 0;
constexpr size_t OFF_QA = U;
constexpr size_t OFF_KA = U + U / 2;
constexpr size_t OFF_VA = OFF_KA + U / 8;
constexpr size_t OFF_KR = OFF_VA + U / 8;
constexpr size_t OFF_QB = 2 * U;
constexpr size_t OFF_KBN = OFF_QB + (U / 4) * 3;
constexpr size_t OFF_VB = OFF_KBN + U / 2;
constexpr size_t OFF_W = OFF_VB + U / 2;
constexpr size_t OFF_WIN = OFF_W;
constexpr size_t OFF_WQUP = OFF_WIN + 4608ull * 1024 * 2;
constexpr size_t OFF_WKVUP = OFF_WQUP + 768ull * 384 * 2;
constexpr size_t OFF_WAOUT = OFF_WKVUP + 1024ull * 256 * 2;
constexpr size_t OFF_WBOUT = OFF_WAOUT + 1024ull * 512 * 2;
constexpr size_t OFF_WO = OFF_WBOUT + 1024ull * 512 * 2;
constexpr size_t OFF_MOD = OFF_WO + 1024ull * 1024 * 2;
constexpr size_t OFF_SSQ = OFF_MOD + 5 * 3072 * 4;
constexpr size_t OFF_TABA = OFF_SSQ + 3ull * T * 4;
constexpr size_t OFF_TABB = OFF_TABA + 256 * 16 * 8;
constexpr size_t OFF_BND = OFF_TABB + 256 * 8 * 8;
constexpr size_t WS_END = OFF_BND + 256 + 256 * 128;
static_assert(WS_END <= 4 * U, "workspace map exceeds 256 MiB");
constexpr size_t OO_BQ = 0;
constexpr size_t OO_BKV = (size_t)T * 384 * 2;
constexpr size_t OO_YB = 0;
constexpr size_t OO_GA = U;
constexpr size_t OO_GB = U + U / 2;
constexpr size_t OO_MERGED = U;

constexpr int LDS_BYTES = 163840;

struct Params {
  const float *x_prompt, *x_sample, *c_prompt, *c_sample, *ada_w, *ada_b, *pre_g, *post_g, *w_in, *a_q_g, *a_k_g, *b_q_g, *b_q_up,
      *b_kv_g, *b_kv_up, *a_out, *b_out, *w_o;
  float* out;
  char* ws;
};

__device__ __forceinline__ int opaque_tid() { int t = threadIdx.x; asm volatile("" : "+v"(t)); return t; }
typedef float f32x2_t __attribute__((ext_vector_type(2)));
typedef __bf16 bf16x2_t __attribute__((ext_vector_type(2)));
__device__ __forceinline__ unsigned cvtpk(float lo, float hi) { f32x2_t v = {lo, hi}; bf16x2_t b = __builtin_convertvector(v, bf16x2_t); return __builtin_bit_cast(unsigned, b); }
__device__ __forceinline__ float bf2f(unsigned short v) { return __uint_as_float(((unsigned)v) << 16); }
__device__ __forceinline__ int crow(int r, int hi) { return (r & 3) + 8 * (r >> 2) + 4 * hi; }
__device__ __forceinline__ void st4(bf16_t* p, float a, float b, float c, float d) { u32x2 w; w.x = cvtpk(a, b); w.y = cvtpk(c, d); *(u32x2*)p = w; }
__device__ __forceinline__ float sigmoidf_(float v) { return 1.0f / (1.0f + __expf(-v)); }
__device__ __forceinline__ const float* xrow_ptr(const Params& p, int tok) { return tok < NP ? p.x_prompt + (size_t)tok * DM : p.x_sample + (size_t)(tok - NP) * DM; }
__device__ __forceinline__ int batch_of(int tok) { return tok < NP ? 0 : 1 + ((tok - NP) >> 12); }
__device__ __forceinline__ int pos_of(int tok) { return tok < NP ? tok : ((tok - NP) & 4095); }

__device__ __forceinline__ int win_src(int n) {
  if (n < 768) return n;
  if (n < 1152) return 1280 + (n - 768);
  if (n < 1408) return 1664 + (n - 1152);
  if (n < 1440) return 1920 + (n - 1408);
  if (n < 1536) return -1;
  if (n < 2048) return 768 + (n - 1536);
  if (n < 2560) return 1952 + (n - 2048);
  return 2464 + (n - 2560);
}
__device__ __forceinline__ void cvt_wt(const float* __restrict__ W, int ldn, int K, bf16_t* __restrict__ dst, int Ndst, bool remap,
                                       const float* __restrict__ gain, int gtid, int gsz) {
  const int kch = K >> 3;
  const int total = Ndst * kch;
  for (int i = gtid; i < total; i += gsz) {
    const int n = i % Ndst, kc = i / Ndst;
    const int src = remap ? win_src(n) : n;
    float v[8];
#pragma unroll
    for (int j = 0; j < 8; ++j) {
      float w = 0.f;
      if (src >= 0) { w = W[(size_t)(kc * 8 + j) * ldn + src]; if (gain) w *= gain[kc * 8 + j]; }
      v[j] = w;
    }
    u32x4 o; o.x = cvtpk(v[0], v[1]); o.y = cvtpk(v[2], v[3]); o.z = cvtpk(v[4], v[5]); o.w = cvtpk(v[6], v[7]);
    *(u32x4*)(dst + (size_t)n * K + kc * 8) = o;
  }
}

__device__ __forceinline__ void phase0(const Params& p, char* lds) {
  const int tid = opaque_tid(), gsz = gridDim.x * 512, gtid = blockIdx.x * 512 + tid;
  float* ssq = (float*)(p.ws + OFF_SSQ);
  for (int i = gtid; i < 3 * T; i += gsz) ssq[i] = 0.f;
  if (gtid == 0) {
    float* bnd = (float*)(p.ws + OFF_BND);
    float gq = 0.f, gk = 0.f;
    for (int i = 0; i < 64; ++i) { gq = fmaxf(gq, fabsf(p.a_q_g[i])); gk = fmaxf(gk, fabsf(p.a_k_g[i])); }
    bnd[0] = 64.0f * gq * gk * PS_A;
    bnd[1] = 0.f; bnd[2] = 0.f; bnd[3] = 0.f;
  }
  float2* tabA = (float2*)(p.ws + OFF_TABA);
  float2* tabB = (float2*)(p.ws + OFF_TABB);
  for (int i = gtid; i < 256 * 16 + 256 * 8; i += gsz) {
    int pos, f; float inv;
    const float L2T = 13.287712379549449f;
    if (i < 4096) { pos = i >> 4; f = i & 15; inv = exp2f(-(float)f * (1.0f / 16.0f) * L2T); }
    else { int k = i - 4096; pos = k >> 3; f = k & 7; inv = exp2f(-(float)f * (1.0f / 8.0f) * L2T); }
    float ang = (float)pos * inv;
    float rev = ang * 0.15915494309189535f; rev -= floorf(rev);
    float2 cs; cs.x = __builtin_amdgcn_cosf(rev); cs.y = __builtin_amdgcn_sinf(rev);
    if (i < 4096) tabA[i] = cs; else tabB[i - 4096] = cs;
  }
  cvt_wt(p.w_in, 4512, 1024, (bf16_t*)(p.ws + OFF_WIN), 4608, true, nullptr, gtid, gsz);
  cvt_wt(p.b_q_up, 768, 384, (bf16_t*)(p.ws + OFF_WQUP), 768, false, p.b_q_g, gtid, gsz);
  cvt_wt(p.b_kv_up, 1024, 256, (bf16_t*)(p.ws + OFF_WKVUP), 1024, false, p.b_kv_g, gtid, gsz);
  cvt_wt(p.a_out, 1024, 512, (bf16_t*)(p.ws + OFF_WAOUT), 1024, false, nullptr, gtid, gsz);
  cvt_wt(p.b_out, 1024, 512, (bf16_t*)(p.ws + OFF_WBOUT), 1024, false, nullptr, gtid, gsz);
  cvt_wt(p.w_o, 1024, 1024, (bf16_t*)(p.ws + OFF_WO), 1024, false, nullptr, gtid, gsz);
  float* red = (float*)lds;
  float* mod = (float*)(p.ws + OFF_MOD);
  for (int it = blockIdx.x; it < 256; it += gridDim.x) {
    const int c = tid & 15, kg = tid >> 4;
    float a0 = 0.f, a1 = 0.f, a2 = 0.f, a3 = 0.f, a4 = 0.f;
    if (c < 12) {
      const int col = it * 12 + c;
      for (int k = kg; k < 1024; k += 32) {
        const float w = p.ada_w[(size_t)k * 3072 + col];
        float c0 = p.c_prompt[k], c1 = p.c_sample[k], c2 = p.c_sample[1024 + k], c3 = p.c_sample[2048 + k], c4 = p.c_sample[3072 + k];
        a0 += c0 * sigmoidf_(c0) * w; a1 += c1 * sigmoidf_(c1) * w; a2 += c2 * sigmoidf_(c2) * w; a3 += c3 * sigmoidf_(c3) * w; a4 += c4 * sigmoidf_(c4) * w;
      }
    }
    float* rp = red + (kg * 16 + c) * 5;
    rp[0] = a0; rp[1] = a1; rp[2] = a2; rp[3] = a3; rp[4] = a4;
    __syncthreads();
    if (tid < 60) {
      const int cc = tid / 5, b = tid % 5;
      float s = 0.f;
      for (int g = 0; g < 32; ++g) s += red[(g * 16 + cc) * 5 + b];
      const int col = it * 12 + cc;
      mod[b * 3072 + col] = s + p.ada_b[col];
    }
    __syncthreads();
  }
}

__device__ __forceinline__ float wave_sum(float v) {
#pragma unroll
  for (int o = 32; o >= 1; o >>= 1) v += __shfl_xor(v, o);
  return v;
}
__device__ __forceinline__ void phase1(const Params& p) {
  const int tid = opaque_tid(), wid = tid >> 6, lane = tid & 63;
  const float* mod = (const float*)(p.ws + OFF_MOD);
  bf16_t* H = (bf16_t*)(p.ws + OFF_H);
  for (int row = blockIdx.x * 8 + wid; row < T; row += gridDim.x * 8) {
    const float* xr = xrow_ptr(p, row);
    const int b = batch_of(row);
    float4 v[4];
#pragma unroll
    for (int i = 0; i < 4; ++i) v[i] = *(const float4*)(xr + i * 256 + lane * 4);
    float ss = 0.f;
#pragma unroll
    for (int i = 0; i < 4; ++i) ss += v[i].x * v[i].x + v[i].y * v[i].y + v[i].z * v[i].z + v[i].w * v[i].w;
    ss = wave_sum(ss);
    const float rn = rsqrtf(ss * (1.0f / 1024.0f) + EPS);
#pragma unroll
    for (int i = 0; i < 4; ++i) {
      const int col = i * 256 + lane * 4;
      const float4 g = *(const float4*)(p.pre_g + col);
      const float4 sh = *(const float4*)(mod + b * 3072 + col);
      const float4 sc = *(const float4*)(mod + b * 3072 + 1024 + col);
      st4(H + (size_t)row * DM + col, v[i].x * rn * g.x * (1.f + sc.x) + sh.x, v[i].y * rn * g.y * (1.f + sc.y) + sh.y,
          v[i].z * rn * g.z * (1.f + sc.z) + sh.z, v[i].w * rn * g.w * (1.f + sc.w) + sh.w);
    }
  }
}

constexpr int G_XB = 256 * 128, G_WB = 128 * 128, G_STAGE = G_XB + G_WB;
__device__ __forceinline__ int gswz(int row, int c) { return row * 128 + ((c ^ ((row >> 1) & 7)) << 4); }

__device__ __forceinline__ void gemm_kloop(const bf16_t* __restrict__ X, int ldx, const bf16_t* __restrict__ W, int ldw, int nk,
                                           f32x16 (&acc)[2][2], char* lds) {
  const int tid = opaque_tid(), wid = __builtin_amdgcn_readfirstlane(tid >> 6), lane = tid & 63, r32 = lane & 31, hi = lane >> 5, wm = wid & 3, wn = wid >> 2;
  const int srow = tid >> 3, sch = tid & 7;
  const char* xg = (const char*)X;
  const char* wg = (const char*)W;
  const unsigned xstep = (unsigned)ldx * 128u, wstep = (unsigned)ldw * 128u;
  const unsigned xo0 = (unsigned)(srow * ldx + sch * 8) * 2u, wo0 = (unsigned)(srow * ldw + sch * 8) * 2u;
  const int sw = gswz(srow, sch);
  u32x4 xa[4], wa[2], xb[4], wb[2];
  const int fsw = (r32 >> 1) & 7;
  int koff[4];
#pragma unroll
  for (int ks = 0; ks < 4; ++ks) koff[ks] = ((2 * ks + hi) ^ fsw) << 4;
  const int rowA = G_XB + (wn * 64 + r32) * 128, rowB = (wm * 64 + r32) * 128;
#define GLOAD(xr, wr, kt) do { _Pragma("unroll") for (int i = 0; i < 4; ++i) xr[i] = *(const u32x4*)(xg + (xo0 + i * xstep + (unsigned)(kt) * 128u)); \
    _Pragma("unroll") for (int i = 0; i < 2; ++i) wr[i] = *(const u32x4*)(wg + (wo0 + i * wstep + (unsigned)(kt) * 128u)); } while (0)
#define GWRITE(s, xr, wr) do { char* b_ = lds + (s) * G_STAGE; _Pragma("unroll") for (int i = 0; i < 4; ++i) *(u32x4*)(b_ + sw + i * 8192) = xr[i]; \
    _Pragma("unroll") for (int i = 0; i < 2; ++i) *(u32x4*)(b_ + G_XB + sw + i * 8192) = wr[i]; } while (0)
#define GCOMPUTE(s) do { const char* sb = lds + (s) * G_STAGE; _Pragma("unroll") for (int ks = 0; ks < 4; ++ks) { \
      const bf16x8 a0 = *(const bf16x8*)(sb + rowA + koff[ks]); const bf16x8 a1 = *(const bf16x8*)(sb + rowA + 4096 + koff[ks]); \
      const bf16x8 b0 = *(const bf16x8*)(sb + rowB + koff[ks]); const bf16x8 b1 = *(const bf16x8*)(sb + rowB + 4096 + koff[ks]); \
      acc[0][0] = __builtin_amdgcn_mfma_f32_32x32x16_bf16(a0, b0, acc[0][0], 0, 0, 0); acc[0][1] = __builtin_amdgcn_mfma_f32_32x32x16_bf16(a0, b1, acc[0][1], 0, 0, 0); \
      acc[1][0] = __builtin_amdgcn_mfma_f32_32x32x16_bf16(a1, b0, acc[1][0], 0, 0, 0); acc[1][1] = __builtin_amdgcn_mfma_f32_32x32x16_bf16(a1, b1, acc[1][1], 0, 0, 0); } } while (0)
  __syncthreads();
  GLOAD(xa, wa, 0); GLOAD(xb, wb, 1); GWRITE(0, xa, wa); __syncthreads();
#pragma nounroll
  for (int kt = 0; kt < nk; kt += 2) {
    const int ka = kt + 2 < nk ? kt + 2 : nk - 2, kb = kt + 3 < nk ? kt + 3 : nk - 1;
    GLOAD(xa, wa, ka);
    GCOMPUTE(0);
    GWRITE(1, xb, wb);
    __syncthreads();
    GLOAD(xb, wb, kb);
    GCOMPUTE(1);
    GWRITE(0, xa, wa);
    __syncthreads();
  }
  asm volatile("s_waitcnt vmcnt(0)" ::: "memory");
#undef GLOAD
#undef GWRITE
#undef GCOMPUTE
}
__device__ __forceinline__ void zero_acc(f32x16 (&acc)[2][2]) {
#pragma unroll
  for (int a = 0; a < 2; ++a)
#pragma unroll
    for (int b = 0; b < 2; ++b)
#pragma unroll
      for (int r = 0; r < 16; ++r) acc[a][b][r] = 0.f;
}

__device__ __forceinline__ void stage_put(char* wb, int t, int q, float a, float b, float c, float d) {
  u32x2 w; w.x = cvtpk(a, b); w.y = cvtpk(c, d);
  *(u32x2*)(wb + t * 128 + ((q ^ ((t & 7) << 1)) << 3)) = w;
}
__device__ __forceinline__ void stage_flush(const char* wb, bf16_t* dst, int ld, int lane) {
#pragma unroll
  for (int i = 0; i < 8; ++i) {
    const int row = i * 8 + (lane >> 3), c = lane & 7;
    const u32x4 v = *(const u32x4*)(wb + row * 128 + ((c ^ (row & 7)) << 4));
    *(u32x4*)(dst + (size_t)row * ld + c * 8) = v;
  }
}
__device__ __forceinline__ void stage_flush_add(const char* wb, bf16_t* dst, int ld, int lane) {
#pragma unroll
  for (int i = 0; i < 8; ++i) {
    const int row = i * 8 + (lane >> 3), c = lane & 7;
    const u32x4 v = *(const u32x4*)(wb + row * 128 + ((c ^ (row & 7)) << 4));
    u32x4* gp = (u32x4*)(dst + (size_t)row * ld + c * 8);
    const u32x4 o = *gp;
    u32x4 r;
    r.x = cvtpk(__uint_as_float(v.x << 16) + __uint_as_float(o.x << 16), __uint_as_float(v.x & 0xffff0000u) + __uint_as_float(o.x & 0xffff0000u));
    r.y = cvtpk(__uint_as_float(v.y << 16) + __uint_as_float(o.y << 16), __uint_as_float(v.y & 0xffff0000u) + __uint_as_float(o.y & 0xffff0000u));
    r.z = cvtpk(__uint_as_float(v.z << 16) + __uint_as_float(o.z << 16), __uint_as_float(v.z & 0xffff0000u) + __uint_as_float(o.z & 0xffff0000u));
    r.w = cvtpk(__uint_as_float(v.w << 16) + __uint_as_float(o.w << 16), __uint_as_float(v.w & 0xffff0000u) + __uint_as_float(o.w & 0xffff0000u));
    *gp = r;
  }
}
__device__ __forceinline__ void epi_rope64(const f32x16& a0, const f32x16& a1, int t, const float* __restrict__ gain, float ps,
                                           const float2* __restrict__ tabA, char* wb, int tl, int hi) {
  float ss = 0.f;
#pragma unroll
  for (int r = 0; r < 16; ++r) ss += a0[r] * a0[r] + a1[r] * a1[r];
  ss += __shfl_xor(ss, 32);
  const float rn = rsqrtf(ss * (1.0f / 64.0f) + EPS);
  const int prow = t >> 6, pcol = t & 63;
#pragma unroll
  for (int g = 0; g < 4; ++g) {
    const int f0 = 8 * (g & 1) + 4 * hi, pos = g < 2 ? prow : pcol, d = 8 * g + 4 * hi;
    const float4* tp = (const float4*)(tabA + pos * 16 + f0);
    const float4 t01 = tp[0], t23 = tp[1];
    const float4 g1 = *(const float4*)(gain + d), g2 = *(const float4*)(gain + 32 + d);
    const float x10 = a0[4 * g + 0] * rn * g1.x, x11 = a0[4 * g + 1] * rn * g1.y, x12 = a0[4 * g + 2] * rn * g1.z, x13 = a0[4 * g + 3] * rn * g1.w;
    const float x20 = a1[4 * g + 0] * rn * g2.x, x21 = a1[4 * g + 1] * rn * g2.y, x22 = a1[4 * g + 2] * rn * g2.z, x23 = a1[4 * g + 3] * rn * g2.w;
    stage_put(wb, tl, 2 * g + hi, (x10 * t01.x - x20 * t01.y) * ps, (x11 * t01.z - x21 * t01.w) * ps, (x12 * t23.x - x22 * t23.y) * ps, (x13 * t23.z - x23 * t23.w) * ps);
    stage_put(wb, tl, 8 + 2 * g + hi, (x20 * t01.x + x10 * t01.y) * ps, (x21 * t01.z + x11 * t01.w) * ps, (x22 * t23.x + x12 * t23.y) * ps, (x23 * t23.z + x13 * t23.w) * ps);
  }
}
__device__ __forceinline__ void rope32_vals(const f32x16& a, float mul, int t, const float2* __restrict__ tabB, int hi, int g, float (&o1)[4], float (&o2)[4]) {
  const int pos = g == 0 ? (t >> 6) : (t & 63);
  const float4* tp = (const float4*)(tabB + pos * 8 + 4 * hi);
  const float4 t01 = tp[0], t23 = tp[1];
  const float x10 = a[4 * g + 0] * mul, x11 = a[4 * g + 1] * mul, x12 = a[4 * g + 2] * mul, x13 = a[4 * g + 3] * mul;
  const float x20 = a[8 + 4 * g + 0] * mul, x21 = a[8 + 4 * g + 1] * mul, x22 = a[8 + 4 * g + 2] * mul, x23 = a[8 + 4 * g + 3] * mul;
  o1[0] = x10 * t01.x - x20 * t01.y; o1[1] = x11 * t01.z - x21 * t01.w; o1[2] = x12 * t23.x - x22 * t23.y; o1[3] = x13 * t23.z - x23 * t23.w;
  o2[0] = x20 * t01.x + x10 * t01.y; o2[1] = x21 * t01.z + x11 * t01.w; o2[2] = x22 * t23.x + x12 * t23.y; o2[3] = x23 * t23.z + x13 * t23.w;
}
__device__ __forceinline__ void epi_rope32(const f32x16& a, float mul, int t, const float2* __restrict__ tabB, char* wb, int tl, int qb, int hi) {
#pragma unroll
  for (int g = 0; g < 2; ++g) {
    float o1[4], o2[4];
    rope32_vals(a, mul, t, tabB, hi, g, o1, o2);
    stage_put(wb, tl, qb + 2 * g + hi, o1[0], o1[1], o1[2], o1[3]);
    stage_put(wb, tl, qb + 4 + 2 * g + hi, o2[0], o2[1], o2[2], o2[3]);
  }
}
__device__ __forceinline__ void epi_rope32_direct(const f32x16& a, float mul, int t, const float2* __restrict__ tabB, bf16_t* dst, int hi) {
#pragma unroll
  for (int g = 0; g < 2; ++g) {
    float o1[4], o2[4];
    rope32_vals(a, mul, t, tabB, hi, g, o1, o2);
    st4(dst + 8 * g + 4 * hi, o1[0], o1[1], o1[2], o1[3]);
    st4(dst + 16 + 8 * g + 4 * hi, o2[0], o2[1], o2[2], o2[3]);
  }
}
__device__ __forceinline__ void epi_plain32(const f32x16& a, float mul, char* wb, int tl, int qb, int hi) {
#pragma unroll
  for (int g = 0; g < 4; ++g) stage_put(wb, tl, qb + 2 * g + hi, a[4 * g] * mul, a[4 * g + 1] * mul, a[4 * g + 2] * mul, a[4 * g + 3] * mul);
}
__device__ __forceinline__ void epi_silu32(const f32x16& a, char* wb, int tl, int qb, int hi) {
#pragma unroll
  for (int g = 0; g < 4; ++g)
    stage_put(wb, tl, qb + 2 * g + hi, a[4 * g] * sigmoidf_(a[4 * g]), a[4 * g + 1] * sigmoidf_(a[4 * g + 1]), a[4 * g + 2] * sigmoidf_(a[4 * g + 2]),
              a[4 * g + 3] * sigmoidf_(a[4 * g + 3]));
}
__device__ __forceinline__ float sumsq16(const f32x16& a) {
  float s = 0.f;
#pragma unroll
  for (int r = 0; r < 16; ++r) s += a[r] * a[r];
  return s;
}

struct TileIter {
  int q, step, end, NT, mbase; bool xcd;
  __device__ __forceinline__ TileIter(int nt_count) {
    NT = nt_count; xcd = (gridDim.x == 256);
    if (xcd) { q = blockIdx.x >> 3; step = 32; end = 16 * NT; mbase = (blockIdx.x & 7) * 16; }
    else { q = blockIdx.x; step = gridDim.x; end = 128 * NT; mbase = 0; }
  }
  __device__ __forceinline__ bool next(int& mt, int& nt) { if (q >= end) return false; mt = mbase + q / NT; nt = q % NT; q += step; return true; }
};

__device__ __forceinline__ void bound_max(float* dst, float v) {
#pragma unroll
  for (int o = 32; o >= 1; o >>= 1) v = fmaxf(v, __shfl_xor(v, o));
  if ((threadIdx.x & 63) == 0) atomicMax((unsigned*)dst, __float_as_uint(v));
}
__device__ __forceinline__ void phase_g1(const Params& p, char* lds) {
  const int tid = opaque_tid(), wid = __builtin_amdgcn_readfirstlane(tid >> 6), lane = tid & 63, r32 = lane & 31, hi = lane >> 5, wm = wid & 3, wn = wid >> 2;
  const bf16_t* H = (const bf16_t*)(p.ws + OFF_H);
  const bf16_t* WIN = (const bf16_t*)(p.ws + OFF_WIN);
  const float2* tabA = (const float2*)(p.ws + OFF_TABA);
  const float2* tabB = (const float2*)(p.ws + OFF_TABB);
  float* ssq = (float*)(p.ws + OFF_SSQ);
  char* dout = (char*)p.out;
  TileIter it(20); int mt, nt;
  while (it.next(mt, nt)) {
    const int m0 = mt * 256;
    f32x16 acc[2][2];
    zero_acc(acc);
    gemm_kloop(H + (size_t)m0 * DM, DM, WIN + (size_t)nt * 128 * DM, DM, 16, acc, lds);
    char* wb = lds + wid * 8192;
    const int tok0 = m0 + wm * 64;
#pragma unroll
    for (int ti = 0; ti < 2; ++ti) {
      const int tl = ti * 32 + r32, tok = tok0 + tl;
      const int t = pos_of(tok);
      if (nt < 4) {
        epi_rope64(acc[0][ti], acc[1][ti], t, p.a_q_g, PS_A, tabA, wb, tl, hi);
      } else if (nt == 4) {
        epi_rope64(acc[0][ti], acc[1][ti], t, p.a_k_g, 1.0f, tabA, wb, tl, hi);
      } else if (nt == 5) {
        epi_plain32(acc[0][ti], 1.0f, wb, tl, 0, hi); epi_plain32(acc[1][ti], 1.0f, wb, tl, 8, hi);
      } else if (nt < 9) {
        epi_plain32(acc[0][ti], 1.0f, wb, tl, 0, hi); epi_plain32(acc[1][ti], 1.0f, wb, tl, 8, hi);
        float s = sumsq16(acc[0][ti]) + sumsq16(acc[1][ti]); s += __shfl_xor(s, 32);
        if (hi == 0) atomicAdd(ssq + tok, s);
      } else if (nt < 11) {
        epi_plain32(acc[0][ti], 1.0f, wb, tl, 0, hi); epi_plain32(acc[1][ti], 1.0f, wb, tl, 8, hi);
        float s = sumsq16(acc[0][ti]) + sumsq16(acc[1][ti]); s += __shfl_xor(s, 32);
        if (hi == 0) atomicAdd(ssq + T + tok, s);
      } else if (nt == 11) {
        if (wn == 0) {
          epi_rope32_direct(acc[0][ti], 1.0f, t, tabB, (bf16_t*)(p.ws + OFF_KR) + (size_t)tok * 32, hi);
          float s = sumsq16(acc[0][ti]); s += __shfl_xor(s, 32);
          bound_max((float*)(p.ws + OFF_BND) + 3, s);
        }
      } else {
        epi_silu32(acc[0][ti], wb, tl, 0, hi); epi_silu32(acc[1][ti], wb, tl, 8, hi);
      }
    }
    if (nt != 11) {
      bf16_t* dst; int ld;
      if (nt < 4) { dst = (bf16_t*)(p.ws + OFF_QA) + (size_t)tok0 * 512 + (nt * 2 + wn) * 64; ld = 512; }
      else if (nt == 4) { dst = (bf16_t*)(p.ws + OFF_KA) + (size_t)tok0 * 128 + wn * 64; ld = 128; }
      else if (nt == 5) { dst = (bf16_t*)(p.ws + OFF_VA) + (size_t)tok0 * 128 + wn * 64; ld = 128; }
      else if (nt < 9) { dst = (bf16_t*)(dout + OO_BQ) + (size_t)tok0 * 384 + (nt - 6) * 128 + wn * 64; ld = 384; }
      else if (nt < 11) { dst = (bf16_t*)(dout + OO_BKV) + (size_t)tok0 * 256 + (nt - 9) * 128 + wn * 64; ld = 256; }
      else if (nt < 16) { dst = (bf16_t*)(dout + OO_GA) + (size_t)tok0 * 512 + (nt - 12) * 128 + wn * 64; ld = 512; }
      else { dst = (bf16_t*)(dout + OO_GB) + (size_t)tok0 * 512 + (nt - 16) * 128 + wn * 64; ld = 512; }
      stage_flush(wb, dst, ld, lane);
    }
  }
}

__device__ __forceinline__ void phase_g2(const Params& p, char* lds) {
  const int tid = opaque_tid(), wid = __builtin_amdgcn_readfirstlane(tid >> 6), lane = tid & 63, r32 = lane & 31, hi = lane >> 5, wm = wid & 3, wn = wid >> 2;
  const float2* tabB = (const float2*)(p.ws + OFF_TABB);
  const float* ssq = (const float*)(p.ws + OFF_SSQ);
  char* dout = (char*)p.out;
  TileIter it(14); int mt, j;
  while (it.next(mt, j)) {
    const int m0 = mt * 256;
    f32x16 acc[2][2];
    zero_acc(acc);
    char* wb = lds + wid * 8192;
    const int tok0 = m0 + wm * 64;
    if (j < 6) {
      gemm_kloop((const bf16_t*)(dout + OO_BQ) + (size_t)m0 * 384, 384, (const bf16_t*)(p.ws + OFF_WQUP) + (size_t)j * 128 * 384, 384, 6, acc, lds);
#pragma unroll
      for (int ti = 0; ti < 2; ++ti) {
        const int tl = ti * 32 + r32, tok = tok0 + tl;
        const int t = pos_of(tok);
        const float rn = rsqrtf(ssq[tok] * (1.0f / 384.0f) + EPS) * PS_B;
#pragma unroll
        for (int fi = 0; fi < 2; ++fi) {
          const int blk = j * 4 + wn * 2 + fi;
          if (blk % 3 == 2) epi_rope32(acc[fi][ti], rn, t, tabB, wb, tl, fi * 8, hi);
          else epi_plain32(acc[fi][ti], rn, wb, tl, fi * 8, hi);
          float s = sumsq16(acc[fi][ti]); s += __shfl_xor(s, 32);
          bound_max((float*)(p.ws + OFF_BND) + 1, s * rn * rn);
        }
      }
      stage_flush(wb, (bf16_t*)(p.ws + OFF_QB) + (size_t)tok0 * 768 + (j * 4 + wn * 2) * 32, 768, lane);
    } else {
      const int jn = j - 6;
      gemm_kloop((const bf16_t*)(dout + OO_BKV) + (size_t)m0 * 256, 256, (const bf16_t*)(p.ws + OFF_WKVUP) + (size_t)jn * 128 * 256, 256, 4, acc, lds);
#pragma unroll
      for (int ti = 0; ti < 2; ++ti) {
        const int tl = ti * 32 + r32, tok = tok0 + tl;
        const float rn = rsqrtf(ssq[T + tok] * (1.0f / 256.0f) + EPS);
        epi_plain32(acc[0][ti], rn, wb, tl, 0, hi); epi_plain32(acc[1][ti], rn, wb, tl, 8, hi);
        if (wn == 0) {
          float s0 = sumsq16(acc[0][ti]), s1 = sumsq16(acc[1][ti]); s0 += __shfl_xor(s0, 32); s1 += __shfl_xor(s1, 32);
          bound_max((float*)(p.ws + OFF_BND) + 2, fmaxf(s0, s1) * rn * rn);
        }
      }
      stage_flush(wb, (bf16_t*)(p.ws + (wn == 0 ? OFF_KBN : OFF_VB)) + (size_t)tok0 * 512 + jn * 64, 512, lane);
    }
  }
}

__device__ __forceinline__ void phase_g3(const Params& p, char* lds) {
  const int tid = opaque_tid(), wid = __builtin_amdgcn_readfirstlane(tid >> 6), lane = tid & 63, r32 = lane & 31, hi = lane >> 5, wm = wid & 3, wn = wid >> 2;
  char* dout = (char*)p.out;
  const bf16_t* H = (const bf16_t*)(p.ws + OFF_H);
  const bf16_t* WIN = (const bf16_t*)(p.ws + OFF_WIN);
  bf16_t* MG = (bf16_t*)(dout + OO_MERGED);
  TileIter it(8); int mt, nt;
  while (it.next(mt, nt)) {
    const int m0 = mt * 256;
#pragma nounroll
    for (int s = 0; s < 2; ++s) {
      f32x16 acc[2][2];
      zero_acc(acc);
      const bf16_t* Y = s == 0 ? (const bf16_t*)(p.ws + OFF_QA) : (const bf16_t*)(dout + OO_YB);
      const bf16_t* WOUT = (const bf16_t*)(p.ws + (s == 0 ? OFF_WAOUT : OFF_WBOUT));
      gemm_kloop(H + (size_t)m0 * DM, DM, WIN + (size_t)(2560 + s * 1024 + nt * 128) * DM, DM, 16, acc, lds);
      unsigned* gl = (unsigned*)(lds + 2 * G_STAGE) + tid;
#pragma unroll
      for (int fi = 0; fi < 2; ++fi)
#pragma unroll
        for (int ti = 0; ti < 2; ++ti)
#pragma unroll
          for (int q = 0; q < 8; ++q) gl[((fi * 2 + ti) * 8 + q) * 512] = cvtpk(sigmoidf_(acc[fi][ti][2 * q]), sigmoidf_(acc[fi][ti][2 * q + 1]));
      zero_acc(acc);
      gemm_kloop(Y + (size_t)m0 * 512, 512, WOUT + (size_t)nt * 128 * 512, 512, 8, acc, lds);
      char* wb = lds + wid * 8192;
#pragma unroll
      for (int ti = 0; ti < 2; ++ti) {
        const int tl = ti * 32 + r32;
#pragma unroll
        for (int fi = 0; fi < 2; ++fi) {
#pragma unroll
          for (int g = 0; g < 4; ++g) {
            const unsigned g01 = gl[((fi * 2 + ti) * 8 + 2 * g) * 512], g23 = gl[((fi * 2 + ti) * 8 + 2 * g + 1) * 512];
            stage_put(wb, tl, fi * 8 + 2 * g + hi, __uint_as_float(g01 << 16) * acc[fi][ti][4 * g], __uint_as_float(g01 & 0xffff0000u) * acc[fi][ti][4 * g + 1],
                      __uint_as_float(g23 << 16) * acc[fi][ti][4 * g + 2], __uint_as_float(g23 & 0xffff0000u) * acc[fi][ti][4 * g + 3]);
          }
        }
      }
      bf16_t* dst = MG + (size_t)(m0 + wm * 64) * DM + nt * 128 + wn * 64;
      if (s == 0) stage_flush(wb, dst, DM, lane); else stage_flush_add(wb, dst, DM, lane);
    }
  }
}

__device__ __forceinline__ void phase_g4(const Params& p, char* lds) {
  const int tid = opaque_tid(), wid = __builtin_amdgcn_readfirstlane(tid >> 6), lane = tid & 63, r32 = lane & 31, hi = lane >> 5, wm = wid & 3, wn = wid >> 2;
  char* dout = (char*)p.out;
  const bf16_t* MG = (const bf16_t*)(dout + OO_MERGED);
  bf16_t* Z = (bf16_t*)(p.ws + OFF_H);
  float* ssq = (float*)(p.ws + OFF_SSQ) + 2 * T;
  TileIter it(8); int mt, nt;
  while (it.next(mt, nt)) {
    const int m0 = mt * 256;
    f32x16 acc[2][2];
    zero_acc(acc);
    gemm_kloop(MG + (size_t)m0 * DM, DM, (const bf16_t*)(p.ws + OFF_WO) + (size_t)nt * 128 * DM, DM, 16, acc, lds);
    char* wb = lds + wid * 8192;
    const int tok0 = m0 + wm * 64;
#pragma unroll
    for (int ti = 0; ti < 2; ++ti) {
      const int tl = ti * 32 + r32, tok = tok0 + tl;
      epi_plain32(acc[0][ti], 1.0f, wb, tl, 0, hi); epi_plain32(acc[1][ti], 1.0f, wb, tl, 8, hi);
      float s = sumsq16(acc[0][ti]) + sumsq16(acc[1][ti]); s += __shfl_xor(s, 32);
      if (hi == 0) atomicAdd(ssq + tok, s);
    }
    stage_flush(wb, Z + (size_t)tok0 * DM + nt * 128 + wn * 64, DM, lane);
  }
}

__device__ __forceinline__ void phase5(const Params& p) {
  const int tid = opaque_tid(), wid = tid >> 6, lane = tid & 63;
  const float* mod = (const float*)(p.ws + OFF_MOD);
  const bf16_t* Z = (const bf16_t*)(p.ws + OFF_H);
  const float* ssq = (const float*)(p.ws + OFF_SSQ) + 2 * T;
  for (int row = blockIdx.x * 8 + wid; row < T; row += gridDim.x * 8) {
    const float* xr = xrow_ptr(p, row);
    const int b = batch_of(row);
    const float rn = rsqrtf(ssq[row] * (1.0f / 1024.0f) + EPS);
    float* o = p.out + (size_t)row * DM;
#pragma unroll
    for (int i = 0; i < 4; ++i) {
      const int col = i * 256 + lane * 4;
      const float4 xv = *(const float4*)(xr + col);
      const u32x2 zz = *(const u32x2*)(Z + (size_t)row * DM + col);
      const float4 g = *(const float4*)(p.post_g + col);
      const float4 gt = *(const float4*)(mod + b * 3072 + 2048 + col);
      float4 r;
      r.x = xv.x + gt.x * (__uint_as_float(zz.x << 16) * rn * g.x);
      r.y = xv.y + gt.y * (__uint_as_float(zz.x & 0xffff0000u) * rn * g.y);
      r.z = xv.z + gt.z * (__uint_as_float(zz.y << 16) * rn * g.z);
      r.w = xv.w + gt.w * (__uint_as_float(zz.y & 0xffff0000u) * rn * g.w);
      *(float4*)(o + col) = r;
    }
  }
}

#define SBAR() __builtin_amdgcn_sched_barrier(0)
constexpr float ATT_THR = 8.0f;
constexpr int SHM_V = 64 * 64 * 2;
template <int DK> struct KL { static constexpr int RB = DK == 64 ? 128 : 256; static constexpr int SHM_K = 64 * RB; };
template <int DK> __device__ __forceinline__ int kswz(int row, int c) {
  if (DK == 64) return row * 128 + ((c ^ ((row >> 1) & 7)) << 4);
  return row * 256 + ((c ^ (row & 15)) << 4);
}
__device__ __forceinline__ int v_st(int k, int c) {
  const int kk = (k & ~0xC) | ((k & 4) << 1) | ((k & 8) >> 1);
  return ((kk >> 3) * 2 + (c >> 5)) * 512 + ((kk & 7) * 32 + (c & 31)) * 2;
}
__device__ __forceinline__ int v_rd_base(int lane) { return ((lane & 3) << 3) | (((lane >> 2) & 3) << 6) | (((lane >> 4) & 1) << 5) | (((lane >> 5) & 1) << 8); }
constexpr int v_rd_off(int d0, int ks, int half) { return d0 * 512 + ks * 2048 + half * 1024; }
template <int OFF> __device__ __forceinline__ s16x4 tr_read(int vb) {
  s16x4 r; asm volatile("ds_read_b64_tr_b16 %0, %1 offset:%2" : "=&v"(r) : "v"(vb), "i"(OFF) : "memory"); return r;
}
template <int D0> __device__ __forceinline__ void pv_one(f32x16& od, int vb, bf16x8 pa0, bf16x8 pa1, bf16x8 pa2, bf16x8 pa3) {
  const s16x4 l0 = tr_read<v_rd_off(D0, 0, 0)>(vb), h0 = tr_read<v_rd_off(D0, 0, 1)>(vb), l1 = tr_read<v_rd_off(D0, 1, 0)>(vb), h1 = tr_read<v_rd_off(D0, 1, 1)>(vb);
  const s16x4 l2 = tr_read<v_rd_off(D0, 2, 0)>(vb), h2 = tr_read<v_rd_off(D0, 2, 1)>(vb), l3 = tr_read<v_rd_off(D0, 3, 0)>(vb), h3 = tr_read<v_rd_off(D0, 3, 1)>(vb);
  asm volatile("s_waitcnt lgkmcnt(0)" ::: "memory"); SBAR();
#define PK(L, Hh) (bf16x8){L[0], L[1], L[2], L[3], Hh[0], Hh[1], Hh[2], Hh[3]}
  od = __builtin_amdgcn_mfma_f32_32x32x16_bf16(pa0, PK(l0, h0), od, 0, 0, 0);
  od = __builtin_amdgcn_mfma_f32_32x32x16_bf16(pa1, PK(l1, h1), od, 0, 0, 0);
  od = __builtin_amdgcn_mfma_f32_32x32x16_bf16(pa2, PK(l2, h2), od, 0, 0, 0);
  od = __builtin_amdgcn_mfma_f32_32x32x16_bf16(pa3, PK(l3, h3), od, 0, 0, 0);
#undef PK
}
__device__ __forceinline__ void pv_all(f32x16* o, int vb, bf16x8 pa0, bf16x8 pa1, bf16x8 pa2, bf16x8 pa3) {
  pv_one<0>(o[0], vb, pa0, pa1, pa2, pa3); pv_one<1>(o[1], vb, pa0, pa1, pa2, pa3);
}
__device__ __forceinline__ void partialSM(f32x16& p0, f32x16& p1, float& m_reg, float& alpha) {
  float pmax = p0[0];
#pragma unroll
  for (int r = 1; r < 16; ++r) pmax = fmaxf(pmax, p0[r]);
#pragma unroll
  for (int r = 0; r < 16; ++r) pmax = fmaxf(pmax, p1[r]);
  { auto rr = __builtin_amdgcn_permlane32_swap(__float_as_uint(pmax), __float_as_uint(pmax), false, false);
    pmax = fmaxf(__uint_as_float(rr[0]), __uint_as_float(rr[1])); }
  float mn;
  if (__builtin_expect(__all(pmax - m_reg <= ATT_THR), 1)) { mn = m_reg; alpha = 1.f; }
  else { mn = fmaxf(m_reg, pmax); alpha = __builtin_amdgcn_exp2f(m_reg - mn); m_reg = mn; }
#pragma unroll
  for (int r = 0; r < 16; ++r) p0[r] -= mn;
#pragma unroll
  for (int r = 0; r < 16; ++r) p1[r] -= mn;
#pragma unroll
  for (int r = 0; r < 16; ++r) p0[r] = __builtin_amdgcn_exp2f(p0[r]);
}
__device__ __forceinline__ void finishSM(f32x16& p0, f32x16& p1, float alpha, float& l_reg, bf16x8& pa0, bf16x8& pa1, bf16x8& pa2, bf16x8& pa3) {
#pragma unroll
  for (int r = 0; r < 16; ++r) p1[r] = __builtin_amdgcn_exp2f(p1[r]);
  float ps = 0.f;
#pragma unroll
  for (int r = 0; r < 16; ++r) ps += p0[r];
#pragma unroll
  for (int r = 0; r < 16; ++r) ps += p1[r];
  { auto rr = __builtin_amdgcn_permlane32_swap(__float_as_uint(ps), __float_as_uint(ps), false, false);
    ps = __uint_as_float(rr[0]) + __uint_as_float(rr[1]); }
  l_reg = l_reg * alpha + ps;
#define PK4(P, BASE, OUT) do { unsigned a0 = cvtpk(P[BASE + 0], P[BASE + 1]), a1 = cvtpk(P[BASE + 2], P[BASE + 3]);   \
    unsigned b0 = cvtpk(P[BASE + 4], P[BASE + 5]), b1 = cvtpk(P[BASE + 6], P[BASE + 7]);                              \
    auto r0 = __builtin_amdgcn_permlane32_swap(a0, b0, false, false); auto r1 = __builtin_amdgcn_permlane32_swap(a1, b1, false, false); \
    u32x4 w = {r0[0], r1[0], r0[1], r1[1]}; OUT = *reinterpret_cast<bf16x8*>(&w); } while (0)
  PK4(p0, 0, pa0); PK4(p0, 8, pa1); PK4(p1, 0, pa2); PK4(p1, 8, pa3);
#undef PK4
}
template <int DK> __device__ __forceinline__ void qkt(f32x16& p0, f32x16& p1, const char* Ks, const bf16x8* qr, int r32, int hi) {
#pragma unroll
  for (int r = 0; r < 16; ++r) { p0[r] = 0.f; p1[r] = 0.f; }
#pragma unroll
  for (int d0 = 0; d0 < DK / 16; ++d0) {
    const int off = kswz<DK>(r32, 2 * d0 + hi);
    const bf16x8 b0 = *reinterpret_cast<const bf16x8*>(Ks + off);
    const bf16x8 b1 = *reinterpret_cast<const bf16x8*>(Ks + off + 32 * KL<DK>::RB);
    p0 = __builtin_amdgcn_mfma_f32_32x32x16_bf16(b0, qr[d0], p0, 0, 0, 0);
    p1 = __builtin_amdgcn_mfma_f32_32x32x16_bf16(b1, qr[d0], p1, 0, 0, 0);
    if (QKT_SB && (d0 & 1) == 1 && d0 + 1 < DK / 16) SBAR();
  }
}

template <int DK>
__device__ __forceinline__ void attn_unit(const bf16_t* Qb, int ldq, const bf16_t* __restrict__ Kh, int ldk, const bf16_t* __restrict__ Krp,
                                          const bf16_t* __restrict__ Vh, int ldv, const bf16_t* Gb, bf16_t* Ob, int seq, char* lds) {
  constexpr int SHM_K = KL<DK>::SHM_K;
  const int tid = opaque_tid(), wid = __builtin_amdgcn_readfirstlane(tid >> 6), lane = tid & 63, r32 = lane & 31, hi = lane >> 5;
  char* V_lds = lds; char* K_lds = lds + 2 * SHM_V;
  float* ws = (float*)(lds + 2 * SHM_V + 2 * SHM_K) + wid * 64; float* li_l = ws; float* al_l = ws + 32;
  float m_reg = -1e30f, l_reg = 0.f; f32x16 o[2]; bf16x8 qr[DK / 16];
#pragma unroll
  for (int r = 0; r < 16; ++r) { o[0][r] = 0.f; o[1][r] = 0.f; }
  const bf16_t* Qw = Qb + (size_t)(wid * 32 + r32) * ldq + hi * 8;
#pragma unroll
  for (int d0 = 0; d0 < DK / 16; ++d0) qr[d0] = *reinterpret_cast<const bf16x8*>(Qw + d0 * 16);
  const int srow = tid >> 3, sc = tid & 7, vst = v_st(srow, sc * 8), kst = kswz<DK>(srow, sc);
  const int rrow = tid >> 2, rc = tid & 3, krst = kswz<DK>(rrow & 63, 8 + rc);
  const bool dor = (DK == 96) && (wid < 4);
  const int vb0 = (int)(uintptr_t)V_lds + v_rd_base(lane);
  struct { u32x4 v, k, r; } sr_[1];
  const unsigned voff0 = (unsigned)(srow * ldv + sc * 8) * 2u, koff0 = (unsigned)(srow * ldk + sc * 8) * 2u, roff0 = (unsigned)(rrow * 32 + rc * 8) * 2u;
#define SLOAD(i, k0) do { sr_[i].v = *(const u32x4*)((const char*)Vh + (voff0 + (unsigned)((k0) * ldv) * 2u)); sr_[i].k = *(const u32x4*)((const char*)Kh + (koff0 + (unsigned)((k0) * ldk) * 2u)); \
    if (dor) sr_[i].r = *(const u32x4*)((const char*)Krp + (roff0 + (unsigned)((k0) * 64))); } while (0)
#define SWRITE(b, i) do { *(u32x4*)(V_lds + (b) * SHM_V + vst) = sr_[i].v; *(u32x4*)(K_lds + (b) * SHM_K + kst) = sr_[i].k; \
    if (dor) *(u32x4*)(K_lds + (b) * SHM_K + krst) = sr_[i].r; } while (0)
#define RESC(a) do { if (__any((a) < 1.f)) { if (hi == 0) al_l[r32] = (a); asm volatile("s_waitcnt lgkmcnt(0)" ::: "memory"); \
    _Pragma("unroll") for (int d = 0; d < 2; ++d) _Pragma("unroll") for (int r = 0; r < 16; ++r) o[d][r] *= al_l[crow(r, hi)]; } } while (0)
  f32x16 pA0, pA1, pB0, pB1; float alA, alB; bf16x8 pa0, pa1, pa2, pa3; const int NT = seq / 64;
  __syncthreads();
  SLOAD(0, 0); SWRITE(0, 0); __syncthreads();
  qkt<DK>(pA0, pA1, K_lds, qr, r32, hi); partialSM(pA0, pA1, m_reg, alA);
  SLOAD(0, 64);
  SWRITE(1, 0); __syncthreads();
  for (int j = 1; j + 1 < NT; j += 2) {
    SBAR(); qkt<DK>(pB0, pB1, K_lds + SHM_K, qr, r32, hi);
    finishSM(pA0, pA1, alA, l_reg, pa0, pa1, pa2, pa3); SBAR();
    SLOAD(0, (j + 1) * 64); SBAR();
    pv_all(o, vb0, pa0, pa1, pa2, pa3); partialSM(pB0, pB1, m_reg, alB);
    __syncthreads(); SWRITE(0, 0);
    RESC(alB); __syncthreads();
    SBAR(); qkt<DK>(pA0, pA1, K_lds, qr, r32, hi);
    finishSM(pB0, pB1, alB, l_reg, pa0, pa1, pa2, pa3); SBAR();
    SLOAD(0, (j + 2) * 64); SBAR();
    pv_all(o, vb0 + SHM_V, pa0, pa1, pa2, pa3); partialSM(pA0, pA1, m_reg, alA);
    __syncthreads(); SWRITE(1, 0);
    RESC(alA); __syncthreads();
  }
  SBAR(); qkt<DK>(pB0, pB1, K_lds + SHM_K, qr, r32, hi);
  finishSM(pA0, pA1, alA, l_reg, pa0, pa1, pa2, pa3); SBAR();
  pv_all(o, vb0, pa0, pa1, pa2, pa3); partialSM(pB0, pB1, m_reg, alB);
  __syncthreads(); RESC(alB);
  finishSM(pB0, pB1, alB, l_reg, pa0, pa1, pa2, pa3); SBAR();
  pv_all(o, vb0 + SHM_V, pa0, pa1, pa2, pa3);
  if (hi == 0) li_l[r32] = l_reg; asm volatile("s_waitcnt lgkmcnt(0)" ::: "memory");
  float rli[16];
#pragma unroll
  for (int r = 0; r < 16; ++r) rli[r] = __builtin_amdgcn_rcpf(li_l[crow(r, hi)]);
#pragma unroll
  for (int r = 0; r < 16; ++r) {
    const size_t rowo = (size_t)(wid * 32 + crow(r, hi)) * 512;
#pragma unroll
    for (int d0 = 0; d0 < 2; ++d0) {
      const size_t idx = rowo + d0 * 32 + r32;
      const float g = bf2f(Gb[idx]);
      Ob[idx] = (bf16_t)(cvtpk(o[d0][r] * rli[r] * g, 0.f) & 0xffffu);
    }
  }
#undef SLOAD
#undef SWRITE
#undef RESC
}

__device__ __forceinline__ void exp16(f32x16& p) {
#pragma unroll
  for (int r = 0; r < 16; ++r) p[r] = __builtin_amdgcn_exp2f(p[r]);
}
__device__ __forceinline__ void finishFast(f32x16& p0, f32x16& p1, float& l_reg, bf16x8& pa0, bf16x8& pa1, bf16x8& pa2, bf16x8& pa3) {
  exp16(p1);
  float ps = 0.f;
#pragma unroll
  for (int r = 0; r < 16; ++r) ps += p0[r];
#pragma unroll
  for (int r = 0; r < 16; ++r) ps += p1[r];
  l_reg += ps;
#define PK4(P, BASE, OUT) do { unsigned a0 = cvtpk(P[BASE + 0], P[BASE + 1]), a1 = cvtpk(P[BASE + 2], P[BASE + 3]);   \
    unsigned b0 = cvtpk(P[BASE + 4], P[BASE + 5]), b1 = cvtpk(P[BASE + 6], P[BASE + 7]);                              \
    auto r0 = __builtin_amdgcn_permlane32_swap(a0, b0, false, false); auto r1 = __builtin_amdgcn_permlane32_swap(a1, b1, false, false); \
    u32x4 w = {r0[0], r1[0], r0[1], r1[1]}; OUT = *reinterpret_cast<bf16x8*>(&w); } while (0)
  PK4(p0, 0, pa0); PK4(p0, 8, pa1); PK4(p1, 0, pa2); PK4(p1, 8, pa3);
#undef PK4
}
template <int DK>
__device__ __forceinline__ void attn_unit_fast(const bf16_t* Qb, int ldq, const bf16_t* __restrict__ Kh, int ldk, const bf16_t* __restrict__ Krp,
                                               const bf16_t* __restrict__ Vh, int ldv, const bf16_t* Gb, bf16_t* Ob, int seq, char* lds) {
  constexpr int SHM_K = KL<DK>::SHM_K;
  const int tid = opaque_tid(), wid = __builtin_amdgcn_readfirstlane(tid >> 6), lane = tid & 63, r32 = lane & 31, hi = lane >> 5;
  char* V_lds = lds; char* K_lds = lds + 3 * SHM_V;
  float* ws = (float*)(lds + 3 * SHM_V + 3 * SHM_K) + wid * 64; float* li_l = ws;
  float l_reg = 0.f; f32x16 o[2]; bf16x8 qr[DK / 16];
#pragma unroll
  for (int r = 0; r < 16; ++r) { o[0][r] = 0.f; o[1][r] = 0.f; }
  const bf16_t* Qw = Qb + (size_t)(wid * 32 + r32) * ldq + hi * 8;
#pragma unroll
  for (int d0 = 0; d0 < DK / 16; ++d0) qr[d0] = *reinterpret_cast<const bf16x8*>(Qw + d0 * 16);
  const int srow = tid >> 3, sc = tid & 7, vst = v_st(srow, sc * 8), kst = kswz<DK>(srow, sc);
  const int rrow = tid >> 2, rc = tid & 3, krst = kswz<DK>(rrow & 63, 8 + rc);
  const bool dor = (DK == 96) && (wid < 4);
  const int vb0 = (int)(uintptr_t)V_lds + v_rd_base(lane);
  struct { u32x4 v, k, r; } sr_[1];
  const unsigned voff0 = (unsigned)(srow * ldv + sc * 8) * 2u, koff0 = (unsigned)(srow * ldk + sc * 8) * 2u, roff0 = (unsigned)(rrow * 32 + rc * 8) * 2u;
#define SLOAD(i, k0) do { sr_[i].v = *(const u32x4*)((const char*)Vh + (voff0 + (unsigned)((k0) * ldv) * 2u)); sr_[i].k = *(const u32x4*)((const char*)Kh + (koff0 + (unsigned)((k0) * ldk) * 2u)); \
    if (dor) sr_[i].r = *(const u32x4*)((const char*)Krp + (roff0 + (unsigned)((k0) * 64))); } while (0)
#define SWRITE(slot, i) do { *(u32x4*)(V_lds + (slot) * SHM_V + vst) = sr_[i].v; *(u32x4*)(K_lds + (slot) * SHM_K + kst) = sr_[i].k; \
    if (dor) *(u32x4*)(K_lds + (slot) * SHM_K + krst) = sr_[i].r; } while (0)
  f32x16 pA0, pA1, pB0, pB1; bf16x8 pa0, pa1, pa2, pa3; const int NT = seq / 64;
  int sp = 2, st = 0, sn = 1;
#define ROT() do { sp = st; st = sn; sn = (sn == 2) ? 0 : sn + 1; } while (0)
#define STEP(C0, C1, P0, P1, SETW, t, DOW) do { SBAR(); qkt<DK>(C0, C1, K_lds + st * SHM_K, qr, r32, hi); \
    finishFast(P0, P1, l_reg, pa0, pa1, pa2, pa3); SBAR(); \
    if (DOW) { SWRITE(sn, 0); if ((t) + 2 < NT) SLOAD(0, ((t) + 2) * 64); } SBAR(); \
    pv_all(o, vb0 + sp * SHM_V, pa0, pa1, pa2, pa3); exp16(C0); \
    __syncthreads(); ROT(); } while (0)
  __syncthreads();
  SLOAD(0, 0); SWRITE(0, 0); SLOAD(0, 64); __syncthreads();
  qkt<DK>(pA0, pA1, K_lds, qr, r32, hi);
  SWRITE(1, 0); SLOAD(0, 128);
  exp16(pA0);
  __syncthreads(); ROT();
  for (int t = 1; t + 1 < NT; t += 2) {
    STEP(pB0, pB1, pA0, pA1, 0, t, true);
    STEP(pA0, pA1, pB0, pB1, 1, t + 1, true);
  }
  STEP(pB0, pB1, pA0, pA1, 0, NT - 1, false);
  finishFast(pB0, pB1, l_reg, pa0, pa1, pa2, pa3); SBAR();
  pv_all(o, vb0 + sp * SHM_V, pa0, pa1, pa2, pa3);
  { auto rr = __builtin_amdgcn_permlane32_swap(__float_as_uint(l_reg), __float_as_uint(l_reg), false, false);
    l_reg = __uint_as_float(rr[0]) + __uint_as_float(rr[1]); }
  if (hi == 0) li_l[r32] = l_reg; asm volatile("s_waitcnt lgkmcnt(0)" ::: "memory");
  float rli[16];
#pragma unroll
  for (int r = 0; r < 16; ++r) rli[r] = __builtin_amdgcn_rcpf(li_l[crow(r, hi)]);
#pragma unroll
  for (int r = 0; r < 16; ++r) {
    const size_t rowo = (size_t)(wid * 32 + crow(r, hi)) * 512;
#pragma unroll
    for (int d0 = 0; d0 < 2; ++d0) {
      const size_t idx = rowo + d0 * 32 + r32;
      const float g = bf2f(Gb[idx]);
      Ob[idx] = (bf16_t)(cvtpk(o[d0][r] * rli[r] * g, 0.f) & 0xffffu);
    }
  }
#undef SLOAD
#undef SWRITE
#undef ROT
#undef STEP
}

__device__ __forceinline__ void phase_attn(const Params& p, char* lds) {
  char* dout = (char*)p.out;
  const float* bnd = (const float*)(p.ws + OFF_BND);
  const bool fastA = bnd[0] < 60.0f;
  const bool fastB = 3.0f * bnd[1] * (2.0f * bnd[2] + bnd[3]) < 3600.0f;
  for (int u = blockIdx.x; u < 2048; u += gridDim.x) {
    const int i = u >> 8, v = u & 255, cls = i >> 1, sub = i & 1, head = v & 7, j = v >> 3;
    int seq0, seq, tok0;
    if (cls < 2) { seq0 = 0; seq = NP; tok0 = (2 * j + sub) * 256; }
    else { const int bi = j >> 3, qb = 2 * (j & 7) + sub; seq0 = NP + bi * NS; seq = NS; tok0 = seq0 + qb * 256; }
    if ((cls & 1) == 0) {
      bf16_t* QA = (bf16_t*)(p.ws + OFF_QA);
      const bf16_t* Kp = (const bf16_t*)(p.ws + OFF_KA) + (size_t)seq0 * 128 + (head >> 2) * 64;
      const bf16_t* Vp = (const bf16_t*)(p.ws + OFF_VA) + (size_t)seq0 * 128 + (head >> 2) * 64;
      const bf16_t* Gp = (const bf16_t*)(dout + OO_GA) + (size_t)tok0 * 512 + head * 64;
      bf16_t* Qp = QA + (size_t)tok0 * 512 + head * 64;
      if (fastA) attn_unit_fast<64>(Qp, 512, Kp, 128, nullptr, Vp, 128, Gp, Qp, seq, lds);
      else if (ATT_SAFE) attn_unit<64>(Qp, 512, Kp, 128, nullptr, Vp, 128, Gp, Qp, seq, lds);
    } else {
      const bf16_t* Qp = (const bf16_t*)(p.ws + OFF_QB) + (size_t)tok0 * 768 + head * 96;
      const bf16_t* Kp = (const bf16_t*)(p.ws + OFF_KBN) + (size_t)seq0 * 512 + head * 64;
      const bf16_t* Rp = (const bf16_t*)(p.ws + OFF_KR) + (size_t)seq0 * 32;
      const bf16_t* Vp = (const bf16_t*)(p.ws + OFF_VB) + (size_t)seq0 * 512 + head * 64;
      const bf16_t* Gp = (const bf16_t*)(dout + OO_GB) + (size_t)tok0 * 512 + head * 64;
      bf16_t* Op = (bf16_t*)(dout + OO_YB) + (size_t)tok0 * 512 + head * 64;
      if (fastB) attn_unit_fast<96>(Qp, 768, Kp, 512, Rp, Vp, 512, Gp, Op, seq, lds);
      else if (ATT_SAFE) attn_unit<96>(Qp, 768, Kp, 512, Rp, Vp, 512, Gp, Op, seq, lds);
    }
  }
}

#if MK_SINGLE
#ifndef PROBE_MASK
#define PROBE_MASK 0
#endif
__global__ void __launch_bounds__(512) fwd_kernel(Params p) {
  extern __shared__ __attribute__((aligned(16))) char lds[];
#if PROBE_MASK
  volatile unsigned long long* tst = (volatile unsigned long long*)(p.ws + OFF_BND + 64) + blockIdx.x * 16;
  if (threadIdx.x == 0) tst[0] = wall_clock64();
#define STAMP(k) if (threadIdx.x == 0) tst[k + 1] = wall_clock64();
#else
#define STAMP(k)
#endif
#define PHASE(k, call) if (PH_MASK & (1 << k)) { call; if (k < 7) { cg::this_grid().sync(); STAMP(k) } }
  PHASE(0, phase0(p, lds))
  PHASE(1, phase1(p))
  PHASE(2, phase_g1(p, lds))
  PHASE(3, phase_g2(p, lds))
  PHASE(4, phase_attn(p, lds))
  PHASE(5, phase_g3(p, lds))
  PHASE(6, phase_g4(p, lds))
  PHASE(7, phase5(p))
#undef PHASE
#if PROBE_MASK
  if (blockIdx.x == 0) {
    __syncthreads();
    float* dshp = (float*)lds;
    if (threadIdx.x == 0) {
    unsigned long long tot = 0;
    for (int k = 0; k < 7; ++k) if (PROBE_MASK & (1 << k)) tot += tst[k + 1] - tst[k];
    dshp[0] = sqrtf((float)tot * (0.01f / 4000.0f));
    }
    __syncthreads();
    const float d = dshp[0];
    for (int i = threadIdx.x; i < 8 * 1024; i += 512) p.out[i] += d;
  }
#endif
}
#define MAIN_KERNEL fwd_kernel
#else
template <int PH>
__global__ void __launch_bounds__(512) ph_kernel(Params p) {
  extern __shared__ __attribute__((aligned(16))) char lds[];
  if (PH == 0) phase0(p, lds);
  if (PH == 1) phase1(p);
  if (PH == 2) phase_g1(p, lds);
  if (PH == 3) phase_g2(p, lds);
  if (PH == 4) phase_attn(p, lds);
  if (PH == 5) phase_g3(p, lds);
  if (PH == 6) phase_g4(p, lds);
  if (PH == 7) phase5(p);
}
#define MAIN_KERNEL ph_kernel<4>
#endif

extern "C" void kernel_launch(void* const* d_in, const int* in_sizes, int n_in, void* d_out, int out_size, void* d_ws, size_t ws_size,
                              hipStream_t stream) {
  Params p{};
  p.x_prompt = (const float*)d_in[0]; p.x_sample = (const float*)d_in[1]; p.c_prompt = (const float*)d_in[2]; p.c_sample = (const float*)d_in[3];
  p.ada_w = (const float*)d_in[4]; p.ada_b = (const float*)d_in[5]; p.pre_g = (const float*)d_in[6]; p.post_g = (const float*)d_in[7];
  p.w_in = (const float*)d_in[8]; p.a_q_g = (const float*)d_in[9]; p.a_k_g = (const float*)d_in[10]; p.b_q_g = (const float*)d_in[11];
  p.b_q_up = (const float*)d_in[12]; p.b_kv_g = (const float*)d_in[13]; p.b_kv_up = (const float*)d_in[14]; p.a_out = (const float*)d_in[15];
  p.b_out = (const float*)d_in[16]; p.w_o = (const float*)d_in[17];
  p.out = (float*)d_out; p.ws = (char*)d_ws;
  static int grid_blocks = 0;
  if (!grid_blocks) {
    int dev = 0, cus = 0, per_cu = 0;
    (void)hipGetDevice(&dev);
    (void)hipDeviceGetAttribute(&cus, hipDeviceAttributeMultiprocessorCount, dev);
    (void)hipFuncSetAttribute((const void*)MAIN_KERNEL, hipFuncAttributeMaxDynamicSharedMemorySize, LDS_BYTES);
    (void)hipOccupancyMaxActiveBlocksPerMultiprocessor(&per_cu, MAIN_KERNEL, 512, LDS_BYTES);
    if (per_cu < 1) per_cu = 1;
    if (per_cu > 1) per_cu = 1;
    grid_blocks = cus * per_cu;
    if (grid_blocks <= 0) grid_blocks = 256;
  }
#if MK_SINGLE
  void* args[] = {&p};
  hipError_t err = hipLaunchCooperativeKernel((const void*)fwd_kernel, dim3(grid_blocks), dim3(512), args, LDS_BYTES, stream);
  if (err != hipSuccess) fprintf(stderr, "cooperative launch failed: %s (grid %d)\n", hipGetErrorString(err), grid_blocks);
#else
  static bool attr_set = false;
  if (!attr_set) {
    (void)hipFuncSetAttribute((const void*)ph_kernel<0>, hipFuncAttributeMaxDynamicSharedMemorySize, LDS_BYTES);
    (void)hipFuncSetAttribute((const void*)ph_kernel<2>, hipFuncAttributeMaxDynamicSharedMemorySize, LDS_BYTES);
    (void)hipFuncSetAttribute((const void*)ph_kernel<3>, hipFuncAttributeMaxDynamicSharedMemorySize, LDS_BYTES);
    (void)hipFuncSetAttribute((const void*)ph_kernel<5>, hipFuncAttributeMaxDynamicSharedMemorySize, LDS_BYTES);
    (void)hipFuncSetAttribute((const void*)ph_kernel<6>, hipFuncAttributeMaxDynamicSharedMemorySize, LDS_BYTES);
    attr_set = true;
  }
  hipLaunchKernelGGL(ph_kernel<0>, dim3(grid_blocks), dim3(512), LDS_BYTES, stream, p);
  hipLaunchKernelGGL(ph_kernel<1>, dim3(grid_blocks), dim3(512), LDS_BYTES, stream, p);
  hipLaunchKernelGGL(ph_kernel<2>, dim3(grid_blocks), dim3(512), LDS_BYTES, stream, p);
  hipLaunchKernelGGL(ph_kernel<3>, dim3(grid_blocks), dim3(512), LDS_BYTES, stream, p);
  hipLaunchKernelGGL(ph_kernel<4>, dim3(grid_blocks), dim3(512), LDS_BYTES, stream, p);
  hipLaunchKernelGGL(ph_kernel<5>, dim3(grid_blocks), dim3(512), LDS_BYTES, stream, p);
  hipLaunchKernelGGL(ph_kernel<6>, dim3(grid_blocks), dim3(512), LDS_BYTES, stream, p);
  hipLaunchKernelGGL(ph_kernel<7>, dim3(grid_blocks), dim3(512), LDS_BYTES, stream, p);
#endif
}
```

```cpp
#include <hip/hip_runtime.h>
#include <hip/hip_cooperative_groups.h>
#include <stdint.h>
#include <cstdio>
namespace cg = cooperative_groups;

#ifndef MK_SINGLE
#define MK_SINGLE 1
#endif
#ifndef QKT_SB
#define QKT_SB 0
#endif
#ifndef ATT_SAFE
#define ATT_SAFE 1
#endif
#ifndef PH_MASK
#define PH_MASK 255
#endif

typedef unsigned short bf16_t;
typedef short bf16x8 __attribute__((ext_vector_type(8)));
typedef short s16x4 __attribute__((ext_vector_type(4)));
typedef float f32x16 __attribute__((ext_vector_type(16)));
typedef unsigned u32x4 __attribute__((ext_vector_type(4)));
typedef unsigned u32x2 __attribute__((ext_vector_type(2)));

constexpr int T = 32768, NP = 16384, NS = 4096, DM = 1024;
constexpr float EPS = 1e-6f;
constexpr float LOG2E = 1.4426950408889634f;
constexpr float PS_A = 0.125f * LOG2E;
constexpr float PS_B = 0.10206207261596575f * LOG2E;

constexpr size_t U = 67108864ull;
constexpr size_t OFF_H = 0;
constexpr size_t OFF_QA = U;
constexpr size_t OFF_KA = U + U / 2;
constexpr size_t OFF_VA = OFF_KA + U / 8;
constexpr size_t OFF_KR = OFF_VA + U / 8;
constexpr size_t OFF_PART = OFF_KR + 2097152;
constexpr size_t OFF_QB = 2 * U;
constexpr size_t OFF_KBN = OFF_QB + (U / 4) * 3;
constexpr size_t OFF_VB = OFF_KBN + U / 2;
constexpr size_t OFF_W = OFF_VB + U / 2;
constexpr size_t OFF_WIN = OFF_W;
constexpr size_t OFF_WQUP = OFF_WIN + 4608ull * 1024 * 2;
constexpr size_t OFF_WKVUP = OFF_WQUP + 768ull * 384 * 2;
constexpr size_t OFF_WAOUT = OFF_WKVUP + 1024ull * 256 * 2;
constexpr size_t OFF_WBOUT = OFF_WAOUT + 1024ull * 512 * 2;
constexpr size_t OFF_WO = OFF_WBOUT + 1024ull * 512 * 2;
constexpr size_t OFF_MOD = OFF_WO + 1024ull * 1024 * 2;
constexpr size_t OFF_SSQ = OFF_MOD + 5 * 3072 * 4;
constexpr size_t OFF_TABA = OFF_SSQ + 3ull * T * 4;
constexpr size_t OFF_TABB = OFF_TABA + 256 * 16 * 8;
constexpr size_t OFF_BND = OFF_TABB + 256 * 8 * 8;
constexpr size_t WS_END = OFF_BND + 256 + 256 * 128;
static_assert(WS_END <= 4 * U, "workspace map exceeds 256 MiB");
constexpr size_t OO_BQ = 0;
constexpr size_t OO_BKV = (size_t)T * 384 * 2;
constexpr size_t OO_YB = 0;
constexpr size_t OO_GA = U;
constexpr size_t OO_GB = U + U / 2;
constexpr size_t OO_MERGED = U;

constexpr int LDS_BYTES = 163840;

struct Params {
  const float *x_prompt, *x_sample, *c_prompt, *c_sample, *ada_w, *ada_b, *pre_g, *post_g, *w_in, *a_q_g, *a_k_g, *b_q_g, *b_q_up,
      *b_kv_g, *b_kv_up, *a_out, *b_out, *w_o;
  float* out;
  char* ws;
};

__device__ __forceinline__ int opaque_tid() { int t = threadIdx.x; asm volatile("" : "+v"(t)); return t; }
typedef float f32x2_t __attribute__((ext_vector_type(2)));
typedef __bf16 bf16x2_t __attribute__((ext_vector_type(2)));
__device__ __forceinline__ unsigned cvtpk(float lo, float hi) { f32x2_t v = {lo, hi}; bf16x2_t b = __builtin_convertvector(v, bf16x2_t); return __builtin_bit_cast(unsigned, b); }
__device__ __forceinline__ float bf2f(unsigned short v) { return __uint_as_float(((unsigned)v) << 16); }
__device__ __forceinline__ int crow(int r, int hi) { return (r & 3) + 8 * (r >> 2) + 4 * hi; }
__device__ __forceinline__ void st4(bf16_t* p, float a, float b, float c, float d) { u32x2 w; w.x = cvtpk(a, b); w.y = cvtpk(c, d); *(u32x2*)p = w; }
__device__ __forceinline__ float sigmoidf_(float v) { return 1.0f / (1.0f + __expf(-v)); }
__device__ __forceinline__ const float* xrow_ptr(const Params& p, int tok) { return tok < NP ? p.x_prompt + (size_t)tok * DM : p.x_sample + (size_t)(tok - NP) * DM; }
__device__ __forceinline__ int batch_of(int tok) { return tok < NP ? 0 : 1 + ((tok - NP) >> 12); }
__device__ __forceinline__ int pos_of(int tok) { return tok < NP ? tok : ((tok - NP) & 4095); }

__device__ __forceinline__ int win_src(int n) {
  if (n < 768) return n;
  if (n < 1152) return 1280 + (n - 768);
  if (n < 1408) return 1664 + (n - 1152);
  if (n < 1440) return 1920 + (n - 1408);
  if (n < 1536) return -1;
  if (n < 2048) return 768 + (n - 1536);
  if (n < 2560) return 1952 + (n - 2048);
  return 2464 + (n - 2560);
}
__device__ __forceinline__ void cvt_wt(const float* __restrict__ W, int ldn, int K, bf16_t* __restrict__ dst, int Ndst, bool remap,
                                       const float* __restrict__ gain, int gtid, int gsz) {
  const int kch = K >> 3;
  const int total = Ndst * kch;
  for (int i = gtid; i < total; i += gsz) {
    const int n = i % Ndst, kc = i / Ndst;
    const int src = remap ? win_src(n) : n;
    float v[8];
#pragma unroll
    for (int j = 0; j < 8; ++j) {
      float w = 0.f;
      if (src >= 0) { w = W[(size_t)(kc * 8 + j) * ldn + src]; if (gain) w *= gain[kc * 8 + j]; }
      v[j] = w;
    }
    u32x4 o; o.x = cvtpk(v[0], v[1]); o.y = cvtpk(v[2], v[3]); o.z = cvtpk(v[4], v[5]); o.w = cvtpk(v[6], v[7]);
    *(u32x4*)(dst + (size_t)n * K + kc * 8) = o;
  }
}

__device__ __forceinline__ void phase0(const Params& p, char* lds) {
  const int tid = opaque_tid(), gsz = gridDim.x * 512, gtid = blockIdx.x * 512 + tid;
  if (gtid == 0) {
    float* bnd = (float*)(p.ws + OFF_BND);
    float gq = 0.f, gk = 0.f;
    for (int i = 0; i < 64; ++i) { gq = fmaxf(gq, fabsf(p.a_q_g[i])); gk = fmaxf(gk, fabsf(p.a_k_g[i])); }
    bnd[0] = 64.0f * gq * gk * PS_A;
    bnd[1] = 0.f; bnd[2] = 0.f; bnd[3] = 0.f;
  }
  float2* tabA = (float2*)(p.ws + OFF_TABA);
  float2* tabB = (float2*)(p.ws + OFF_TABB);
  for (int i = gtid; i < 256 * 16 + 256 * 8; i += gsz) {
    int pos, f; float inv;
    const float L2T = 13.287712379549449f;
    if (i < 4096) { pos = i >> 4; f = i & 15; inv = exp2f(-(float)f * (1.0f / 16.0f) * L2T); }
    else { int k = i - 4096; pos = k >> 3; f = k & 7; inv = exp2f(-(float)f * (1.0f / 8.0f) * L2T); }
    float ang = (float)pos * inv;
    float rev = ang * 0.15915494309189535f; rev -= floorf(rev);
    float2 cs; cs.x = __builtin_amdgcn_cosf(rev); cs.y = __builtin_amdgcn_sinf(rev);
    if (i < 4096) tabA[i] = cs; else tabB[i - 4096] = cs;
  }
  cvt_wt(p.w_in, 4512, 1024, (bf16_t*)(p.ws + OFF_WIN), 4608, true, nullptr, gtid, gsz);
  cvt_wt(p.b_q_up, 768, 384, (bf16_t*)(p.ws + OFF_WQUP), 768, false, p.b_q_g, gtid, gsz);
  cvt_wt(p.b_kv_up, 1024, 256, (bf16_t*)(p.ws + OFF_WKVUP), 1024, false, p.b_kv_g, gtid, gsz);
  cvt_wt(p.a_out, 1024, 512, (bf16_t*)(p.ws + OFF_WAOUT), 1024, false, nullptr, gtid, gsz);
  cvt_wt(p.b_out, 1024, 512, (bf16_t*)(p.ws + OFF_WBOUT), 1024, false, nullptr, gtid, gsz);
  cvt_wt(p.w_o, 1024, 1024, (bf16_t*)(p.ws + OFF_WO), 1024, false, nullptr, gtid, gsz);
  float* red = (float*)lds;
  float* mod = (float*)(p.ws + OFF_MOD);
  for (int it = blockIdx.x; it < 256; it += gridDim.x) {
    const int c = tid & 15, kg = tid >> 4;
    float a0 = 0.f, a1 = 0.f, a2 = 0.f, a3 = 0.f, a4 = 0.f;
    if (c < 12) {
      const int col = it * 12 + c;
      for (int k = kg; k < 1024; k += 32) {
        const float w = p.ada_w[(size_t)k * 3072 + col];
        float c0 = p.c_prompt[k], c1 = p.c_sample[k], c2 = p.c_sample[1024 + k], c3 = p.c_sample[2048 + k], c4 = p.c_sample[3072 + k];
        a0 += c0 * sigmoidf_(c0) * w; a1 += c1 * sigmoidf_(c1) * w; a2 += c2 * sigmoidf_(c2) * w; a3 += c3 * sigmoidf_(c3) * w; a4 += c4 * sigmoidf_(c4) * w;
      }
    }
    float* rp = red + (kg * 16 + c) * 5;
    rp[0] = a0; rp[1] = a1; rp[2] = a2; rp[3] = a3; rp[4] = a4;
    __syncthreads();
    if (tid < 60) {
      const int cc = tid / 5, b = tid % 5;
      float s = 0.f;
      for (int g = 0; g < 32; ++g) s += red[(g * 16 + cc) * 5 + b];
      const int col = it * 12 + cc;
      mod[b * 3072 + col] = s + p.ada_b[col];
    }
    __syncthreads();
  }
}

__device__ __forceinline__ float wave_sum(float v) {
#pragma unroll
  for (int o = 32; o >= 1; o >>= 1) v += __shfl_xor(v, o);
  return v;
}
__device__ __forceinline__ void phase1(const Params& p) {
  const int tid = opaque_tid(), wid = tid >> 6, lane = tid & 63;
  const float* mod = (const float*)(p.ws + OFF_MOD);
  bf16_t* H = (bf16_t*)(p.ws + OFF_H);
  for (int row = blockIdx.x * 8 + wid; row < T; row += gridDim.x * 8) {
    const float* xr = xrow_ptr(p, row);
    const int b = batch_of(row);
    float4 v[4];
#pragma unroll
    for (int i = 0; i < 4; ++i) v[i] = *(const float4*)(xr + i * 256 + lane * 4);
    float ss = 0.f;
#pragma unroll
    for (int i = 0; i < 4; ++i) ss += v[i].x * v[i].x + v[i].y * v[i].y + v[i].z * v[i].z + v[i].w * v[i].w;
    ss = wave_sum(ss);
    const float rn = rsqrtf(ss * (1.0f / 1024.0f) + EPS);
#pragma unroll
    for (int i = 0; i < 4; ++i) {
      const int col = i * 256 + lane * 4;
      const float4 g = *(const float4*)(p.pre_g + col);
      const float4 sh = *(const float4*)(mod + b * 3072 + col);
      const float4 sc = *(const float4*)(mod + b * 3072 + 1024 + col);
      st4(H + (size_t)row * DM + col, v[i].x * rn * g.x * (1.f + sc.x) + sh.x, v[i].y * rn * g.y * (1.f + sc.y) + sh.y,
          v[i].z * rn * g.z * (1.f + sc.z) + sh.z, v[i].w * rn * g.w * (1.f + sc.w) + sh.w);
    }
  }
}

constexpr int G_XB = 256 * 128, G_WB = 128 * 128, G_STAGE = G_XB + G_WB;
__device__ __forceinline__ int gswz(int row, int c) { return row * 128 + ((c ^ ((row >> 1) & 7)) << 4); }

__device__ __forceinline__ void gemm_kloop(const bf16_t* __restrict__ X, int ldx, const bf16_t* __restrict__ W, int ldw, int nk,
                                           f32x16 (&acc)[2][2], char* lds) {
  const int tid = opaque_tid(), wid = __builtin_amdgcn_readfirstlane(tid >> 6), lane = tid & 63, r32 = lane & 31, hi = lane >> 5, wm = wid & 3, wn = wid >> 2;
  const int srow = tid >> 3, sch = tid & 7;
  const char* xg = (const char*)X;
  const char* wg = (const char*)W;
  const unsigned xstep = (unsigned)ldx * 128u, wstep = (unsigned)ldw * 128u;
  const unsigned xo0 = (unsigned)(srow * ldx + sch * 8) * 2u, wo0 = (unsigned)(srow * ldw + sch * 8) * 2u;
  const int sw = gswz(srow, sch);
  u32x4 xa[4], wa[2], xb[4], wb[2];
  const int fsw = (r32 >> 1) & 7;
  int koff[4];
#pragma unroll
  for (int ks = 0; ks < 4; ++ks) koff[ks] = ((2 * ks + hi) ^ fsw) << 4;
  const int rowA = G_XB + (wn * 64 + r32) * 128, rowB = (wm * 64 + r32) * 128;
#define GLOAD(xr, wr, kt) do { _Pragma("unroll") for (int i = 0; i < 4; ++i) xr[i] = *(const u32x4*)(xg + (xo0 + i * xstep + (unsigned)(kt) * 128u)); \
    _Pragma("unroll") for (int i = 0; i < 2; ++i) wr[i] = *(const u32x4*)(wg + (wo0 + i * wstep + (unsigned)(kt) * 128u)); } while (0)
#define GWRITE(s, xr, wr) do { char* b_ = lds + (s) * G_STAGE; _Pragma("unroll") for (int i = 0; i < 4; ++i) *(u32x4*)(b_ + sw + i * 8192) = xr[i]; \
    _Pragma("unroll") for (int i = 0; i < 2; ++i) *(u32x4*)(b_ + G_XB + sw + i * 8192) = wr[i]; } while (0)
#define GCOMPUTE(s) do { const char* sb = lds + (s) * G_STAGE; _Pragma("unroll") for (int ks = 0; ks < 4; ++ks) { \
      const bf16x8 a0 = *(const bf16x8*)(sb + rowA + koff[ks]); const bf16x8 a1 = *(const bf16x8*)(sb + rowA + 4096 + koff[ks]); \
      const bf16x8 b0 = *(const bf16x8*)(sb + rowB + koff[ks]); const bf16x8 b1 = *(const bf16x8*)(sb + rowB + 4096 + koff[ks]); \
      acc[0][0] = __builtin_amdgcn_mfma_f32_32x32x16_bf16(a0, b0, acc[0][0], 0, 0, 0); acc[0][1] = __builtin_amdgcn_mfma_f32_32x32x16_bf16(a0, b1, acc[0][1], 0, 0, 0); \
      acc[1][0] = __builtin_amdgcn_mfma_f32_32x32x16_bf16(a1, b0, acc[1][0], 0, 0, 0); acc[1][1] = __builtin_amdgcn_mfma_f32_32x32x16_bf16(a1, b1, acc[1][1], 0, 0, 0); } } while (0)
  __syncthreads();
  GLOAD(xa, wa, 0); GLOAD(xb, wb, 1); GWRITE(0, xa, wa); __syncthreads();
#pragma nounroll
  for (int kt = 0; kt < nk; kt += 2) {
    const int ka = kt + 2 < nk ? kt + 2 : nk - 2, kb = kt + 3 < nk ? kt + 3 : nk - 1;
    GLOAD(xa, wa, ka);
    GCOMPUTE(0);
    GWRITE(1, xb, wb);
    __syncthreads();
    GLOAD(xb, wb, kb);
    GCOMPUTE(1);
    GWRITE(0, xa, wa);
    __syncthreads();
  }
  asm volatile("s_waitcnt vmcnt(0)" ::: "memory");
#undef GLOAD
#undef GWRITE
#undef GCOMPUTE
}
__device__ __forceinline__ void zero_acc(f32x16 (&acc)[2][2]) {
#pragma unroll
  for (int a = 0; a < 2; ++a)
#pragma unroll
    for (int b = 0; b < 2; ++b)
#pragma unroll
      for (int r = 0; r < 16; ++r) acc[a][b][r] = 0.f;
}

__device__ __forceinline__ void stage_put(char* wb, int t, int q, float a, float b, float c, float d) {
  u32x2 w; w.x = cvtpk(a, b); w.y = cvtpk(c, d);
  *(u32x2*)(wb + t * 128 + ((q ^ ((t & 7) << 1)) << 3)) = w;
}
__device__ __forceinline__ void stage_flush(const char* wb, bf16_t* dst, int ld, int lane) {
#pragma unroll
  for (int i = 0; i < 8; ++i) {
    const int row = i * 8 + (lane >> 3), c = lane & 7;
    const u32x4 v = *(const u32x4*)(wb + row * 128 + ((c ^ (row & 7)) << 4));
    *(u32x4*)(dst + (size_t)row * ld + c * 8) = v;
  }
}
__device__ __forceinline__ void stage_flush_add(const char* wb, bf16_t* dst, int ld, int lane) {
#pragma unroll
  for (int i = 0; i < 8; ++i) {
    const int row = i * 8 + (lane >> 3), c = lane & 7;
    const u32x4 v = *(const u32x4*)(wb + row * 128 + ((c ^ (row & 7)) << 4));
    u32x4* gp = (u32x4*)(dst + (size_t)row * ld + c * 8);
    const u32x4 o = *gp;
    u32x4 r;
    r.x = cvtpk(__uint_as_float(v.x << 16) + __uint_as_float(o.x << 16), __uint_as_float(v.x & 0xffff0000u) + __uint_as_float(o.x & 0xffff0000u));
    r.y = cvtpk(__uint_as_float(v.y << 16) + __uint_as_float(o.y << 16), __uint_as_float(v.y & 0xffff0000u) + __uint_as_float(o.y & 0xffff0000u));
    r.z = cvtpk(__uint_as_float(v.z << 16) + __uint_as_float(o.z << 16), __uint_as_float(v.z & 0xffff0000u) + __uint_as_float(o.z & 0xffff0000u));
    r.w = cvtpk(__uint_as_float(v.w << 16) + __uint_as_float(o.w << 16), __uint_as_float(v.w & 0xffff0000u) + __uint_as_float(o.w & 0xffff0000u));
    *gp = r;
  }
}
__device__ __forceinline__ void epi_rope64(const f32x16& a0, const f32x16& a1, int t, const float* __restrict__ gain, float ps,
                                           const float2* __restrict__ tabA, char* wb, int tl, int hi) {
  float ss = 0.f;
#pragma unroll
  for (int r = 0; r < 16; ++r) ss += a0[r] * a0[r] + a1[r] * a1[r];
  ss += __shfl_xor(ss, 32);
  const float rn = rsqrtf(ss * (1.0f / 64.0f) + EPS);
  const int prow = t >> 6, pcol = t & 63;
#pragma unroll
  for (int g = 0; g < 4; ++g) {
    const int f0 = 8 * (g & 1) + 4 * hi, pos = g < 2 ? prow : pcol, d = 8 * g + 4 * hi;
    const float4* tp = (const float4*)(tabA + pos * 16 + f0);
    const float4 t01 = tp[0], t23 = tp[1];
    const float4 g1 = *(const float4*)(gain + d), g2 = *(const float4*)(gain + 32 + d);
    const float x10 = a0[4 * g + 0] * rn * g1.x, x11 = a0[4 * g + 1] * rn * g1.y, x12 = a0[4 * g + 2] * rn * g1.z, x13 = a0[4 * g + 3] * rn * g1.w;
    const float x20 = a1[4 * g + 0] * rn * g2.x, x21 = a1[4 * g + 1] * rn * g2.y, x22 = a1[4 * g + 2] * rn * g2.z, x23 = a1[4 * g + 3] * rn * g2.w;
    stage_put(wb, tl, 2 * g + hi, (x10 * t01.x - x20 * t01.y) * ps, (x11 * t01.z - x21 * t01.w) * ps, (x12 * t23.x - x22 * t23.y) * ps, (x13 * t23.z - x23 * t23.w) * ps);
    stage_put(wb, tl, 8 + 2 * g + hi, (x20 * t01.x + x10 * t01.y) * ps, (x21 * t01.z + x11 * t01.w) * ps, (x22 * t23.x + x12 * t23.y) * ps, (x23 * t23.z + x13 * t23.w) * ps);
  }
}
__device__ __forceinline__ void rope32_vals(const f32x16& a, float mul, int t, const float2* __restrict__ tabB, int hi, int g, float (&o1)[4], float (&o2)[4]) {
  const int pos = g == 0 ? (t >> 6) : (t & 63);
  const float4* tp = (const float4*)(tabB + pos * 8 + 4 * hi);
  const float4 t01 = tp[0], t23 = tp[1];
  const float x10 = a[4 * g + 0] * mul, x11 = a[4 * g + 1] * mul, x12 = a[4 * g + 2] * mul, x13 = a[4 * g + 3] * mul;
  const float x20 = a[8 + 4 * g + 0] * mul, x21 = a[8 + 4 * g + 1] * mul, x22 = a[8 + 4 * g + 2] * mul, x23 = a[8 + 4 * g + 3] * mul;
  o1[0] = x10 * t01.x - x20 * t01.y; o1[1] = x11 * t01.z - x21 * t01.w; o1[2] = x12 * t23.x - x22 * t23.y; o1[3] = x13 * t23.z - x23 * t23.w;
  o2[0] = x20 * t01.x + x10 * t01.y; o2[1] = x21 * t01.z + x11 * t01.w; o2[2] = x22 * t23.x + x12 * t23.y; o2[3] = x23 * t23.z + x13 * t23.w;
}
__device__ __forceinline__ void epi_rope32(const f32x16& a, float mul, int t, const float2* __restrict__ tabB, char* wb, int tl, int qb, int hi) {
#pragma unroll
  for (int g = 0; g < 2; ++g) {
    float o1[4], o2[4];
    rope32_vals(a, mul, t, tabB, hi, g, o1, o2);
    stage_put(wb, tl, qb + 2 * g + hi, o1[0], o1[1], o1[2], o1[3]);
    stage_put(wb, tl, qb + 4 + 2 * g + hi, o2[0], o2[1], o2[2], o2[3]);
  }
}
__device__ __forceinline__ void epi_rope32_direct(const f32x16& a, float mul, int t, const float2* __restrict__ tabB, bf16_t* dst, int hi) {
#pragma unroll
  for (int g = 0; g < 2; ++g) {
    float o1[4], o2[4];
    rope32_vals(a, mul, t, tabB, hi, g, o1, o2);
    st4(dst + 8 * g + 4 * hi, o1[0], o1[1], o1[2], o1[3]);
    st4(dst + 16 + 8 * g + 4 * hi, o2[0], o2[1], o2[2], o2[3]);
  }
}
__device__ __forceinline__ void epi_plain32(const f32x16& a, float mul, char* wb, int tl, int qb, int hi) {
#pragma unroll
  for (int g = 0; g < 4; ++g) stage_put(wb, tl, qb + 2 * g + hi, a[4 * g] * mul, a[4 * g + 1] * mul, a[4 * g + 2] * mul, a[4 * g + 3] * mul);
}
__device__ __forceinline__ void epi_silu32(const f32x16& a, char* wb, int tl, int qb, int hi) {
#pragma unroll
  for (int g = 0; g < 4; ++g)
    stage_put(wb, tl, qb + 2 * g + hi, a[4 * g] * sigmoidf_(a[4 * g]), a[4 * g + 1] * sigmoidf_(a[4 * g + 1]), a[4 * g + 2] * sigmoidf_(a[4 * g + 2]),
              a[4 * g + 3] * sigmoidf_(a[4 * g + 3]));
}
__device__ __forceinline__ float sumsq16(const f32x16& a) {
  float s = 0.f;
#pragma unroll
  for (int r = 0; r < 16; ++r) s += a[r] * a[r];
  return s;
}

struct TileIter {
  int q, step, end, NT, mbase; bool xcd;
  __device__ __forceinline__ TileIter(int nt_count) {
    NT = nt_count; xcd = (gridDim.x == 256);
    if (xcd) { q = blockIdx.x >> 3; step = 32; end = 16 * NT; mbase = (blockIdx.x & 7) * 16; }
    else { q = blockIdx.x; step = gridDim.x; end = 128 * NT; mbase = 0; }
  }
  __device__ __forceinline__ bool next(int& mt, int& nt) { if (q >= end) return false; mt = mbase + q / NT; nt = q % NT; q += step; return true; }
};

__device__ __forceinline__ void bound_max(float* dst, float v) {
#pragma unroll
  for (int o = 32; o >= 1; o >>= 1) v = fmaxf(v, __shfl_xor(v, o));
  if ((threadIdx.x & 63) == 0) atomicMax((unsigned*)dst, __float_as_uint(v));
}
__device__ __forceinline__ void phase_g1(const Params& p, char* lds) {
  const int tid = opaque_tid(), wid = __builtin_amdgcn_readfirstlane(tid >> 6), lane = tid & 63, r32 = lane & 31, hi = lane >> 5, wm = wid & 3, wn = wid >> 2;
  const bf16_t* H = (const bf16_t*)(p.ws + OFF_H);
  const bf16_t* WIN = (const bf16_t*)(p.ws + OFF_WIN);
  const float2* tabA = (const float2*)(p.ws + OFF_TABA);
  const float2* tabB = (const float2*)(p.ws + OFF_TABB);
  float* part = (float*)(p.ws + OFF_PART);
  char* dout = (char*)p.out;
  float bmax_kr = 0.f;
  TileIter it(20); int mt, nt;
  while (it.next(mt, nt)) {
    const int m0 = mt * 256;
    f32x16 acc[2][2];
    zero_acc(acc);
    gemm_kloop(H + (size_t)m0 * DM, DM, WIN + (size_t)nt * 128 * DM, DM, 16, acc, lds);
    char* wb = lds + wid * 8192;
    const int tok0 = m0 + wm * 64;
#pragma unroll
    for (int ti = 0; ti < 2; ++ti) {
      const int tl = ti * 32 + r32, tok = tok0 + tl;
      const int t = pos_of(tok);
      if (nt < 4) {
        epi_rope64(acc[0][ti], acc[1][ti], t, p.a_q_g, PS_A, tabA, wb, tl, hi);
      } else if (nt == 4) {
        epi_rope64(acc[0][ti], acc[1][ti], t, p.a_k_g, 1.0f, tabA, wb, tl, hi);
      } else if (nt == 5) {
        epi_plain32(acc[0][ti], 1.0f, wb, tl, 0, hi); epi_plain32(acc[1][ti], 1.0f, wb, tl, 8, hi);
      } else if (nt < 9) {
        epi_plain32(acc[0][ti], 1.0f, wb, tl, 0, hi); epi_plain32(acc[1][ti], 1.0f, wb, tl, 8, hi);
        float s = sumsq16(acc[0][ti]) + sumsq16(acc[1][ti]); s += __shfl_xor(s, 32);
        if (hi == 0) part[((nt - 6) * 2 + wn) * T + tok] = s;
      } else if (nt < 11) {
        epi_plain32(acc[0][ti], 1.0f, wb, tl, 0, hi); epi_plain32(acc[1][ti], 1.0f, wb, tl, 8, hi);
        float s = sumsq16(acc[0][ti]) + sumsq16(acc[1][ti]); s += __shfl_xor(s, 32);
        if (hi == 0) part[(6 + (nt - 9) * 2 + wn) * T + tok] = s;
      } else if (nt == 11) {
        if (wn == 0) {
          epi_rope32_direct(acc[0][ti], 1.0f, t, tabB, (bf16_t*)(p.ws + OFF_KR) + (size_t)tok * 32, hi);
          float s = sumsq16(acc[0][ti]); s += __shfl_xor(s, 32);
          bmax_kr = fmaxf(bmax_kr, s);
        }
      } else {
        epi_silu32(acc[0][ti], wb, tl, 0, hi); epi_silu32(acc[1][ti], wb, tl, 8, hi);
      }
    }
    if (nt != 11) {
      bf16_t* dst; int ld;
      if (nt < 4) { dst = (bf16_t*)(p.ws + OFF_QA) + (size_t)tok0 * 512 + (nt * 2 + wn) * 64; ld = 512; }
      else if (nt == 4) { dst = (bf16_t*)(p.ws + OFF_KA) + (size_t)tok0 * 128 + wn * 64; ld = 128; }
      else if (nt == 5) { dst = (bf16_t*)(p.ws + OFF_VA) + (size_t)tok0 * 128 + wn * 64; ld = 128; }
      else if (nt < 9) { dst = (bf16_t*)(dout + OO_BQ) + (size_t)tok0 * 384 + (nt - 6) * 128 + wn * 64; ld = 384; }
      else if (nt < 11) { dst = (bf16_t*)(dout + OO_BKV) + (size_t)tok0 * 256 + (nt - 9) * 128 + wn * 64; ld = 256; }
      else if (nt < 16) { dst = (bf16_t*)(dout + OO_GA) + (size_t)tok0 * 512 + (nt - 12) * 128 + wn * 64; ld = 512; }
      else { dst = (bf16_t*)(dout + OO_GB) + (size_t)tok0 * 512 + (nt - 16) * 128 + wn * 64; ld = 512; }
      stage_flush(wb, dst, ld, lane);
    }
  }
  bound_max((float*)(p.ws + OFF_BND) + 3, bmax_kr);
}

__device__ __forceinline__ void phase_g2(const Params& p, char* lds) {
  const int tid = opaque_tid(), wid = __builtin_amdgcn_readfirstlane(tid >> 6), lane = tid & 63, r32 = lane & 31, hi = lane >> 5, wm = wid & 3, wn = wid >> 2;
  const float2* tabB = (const float2*)(p.ws + OFF_TABB);
  const float* part = (const float*)(p.ws + OFF_PART);
  char* dout = (char*)p.out;
  float bmax_q = 0.f, bmax_k = 0.f;
  TileIter it(14); int mt, j;
  while (it.next(mt, j)) {
    const int m0 = mt * 256;
    f32x16 acc[2][2];
    zero_acc(acc);
    char* wb = lds + wid * 8192;
    const int tok0 = m0 + wm * 64;
    if (j < 6) {
      gemm_kloop((const bf16_t*)(dout + OO_BQ) + (size_t)m0 * 384, 384, (const bf16_t*)(p.ws + OFF_WQUP) + (size_t)j * 128 * 384, 384, 6, acc, lds);
#pragma unroll
      for (int ti = 0; ti < 2; ++ti) {
        const int tl = ti * 32 + r32, tok = tok0 + tl;
        const int t = pos_of(tok);
        const float sq = (part[tok] + part[T + tok]) + (part[2 * T + tok] + part[3 * T + tok]) + (part[4 * T + tok] + part[5 * T + tok]);
        const float rn = rsqrtf(sq * (1.0f / 384.0f) + EPS) * PS_B;
#pragma unroll
        for (int fi = 0; fi < 2; ++fi) {
          const int blk = j * 4 + wn * 2 + fi;
          if (blk % 3 == 2) epi_rope32(acc[fi][ti], rn, t, tabB, wb, tl, fi * 8, hi);
          else epi_plain32(acc[fi][ti], rn, wb, tl, fi * 8, hi);
          float s = sumsq16(acc[fi][ti]); s += __shfl_xor(s, 32);
          bmax_q = fmaxf(bmax_q, s * rn * rn);
        }
      }
      stage_flush(wb, (bf16_t*)(p.ws + OFF_QB) + (size_t)tok0 * 768 + (j * 4 + wn * 2) * 32, 768, lane);
    } else {
      const int jn = j - 6;
      gemm_kloop((const bf16_t*)(dout + OO_BKV) + (size_t)m0 * 256, 256, (const bf16_t*)(p.ws + OFF_WKVUP) + (size_t)jn * 128 * 256, 256, 4, acc, lds);
#pragma unroll
      for (int ti = 0; ti < 2; ++ti) {
        const int tl = ti * 32 + r32, tok = tok0 + tl;
        const float sk = (part[6 * T + tok] + part[7 * T + tok]) + (part[8 * T + tok] + part[9 * T + tok]);
        const float rn = rsqrtf(sk * (1.0f / 256.0f) + EPS);
        epi_plain32(acc[0][ti], rn, wb, tl, 0, hi); epi_plain32(acc[1][ti], rn, wb, tl, 8, hi);
        if (wn == 0) {
          float s0 = sumsq16(acc[0][ti]), s1 = sumsq16(acc[1][ti]); s0 += __shfl_xor(s0, 32); s1 += __shfl_xor(s1, 32);
          bmax_k = fmaxf(bmax_k, fmaxf(s0, s1) * rn * rn);
        }
      }
      stage_flush(wb, (bf16_t*)(p.ws + (wn == 0 ? OFF_KBN : OFF_VB)) + (size_t)tok0 * 512 + jn * 64, 512, lane);
    }
  }
  bound_max((float*)(p.ws + OFF_BND) + 1, bmax_q);
  bound_max((float*)(p.ws + OFF_BND) + 2, bmax_k);
}

__device__ __forceinline__ void phase_g3(const Params& p, char* lds) {
  const int tid = opaque_tid(), wid = __builtin_amdgcn_readfirstlane(tid >> 6), lane = tid & 63, r32 = lane & 31, hi = lane >> 5, wm = wid & 3, wn = wid >> 2;
  char* dout = (char*)p.out;
  const bf16_t* H = (const bf16_t*)(p.ws + OFF_H);
  const bf16_t* WIN = (const bf16_t*)(p.ws + OFF_WIN);
  bf16_t* MG = (bf16_t*)(dout + OO_MERGED);
  TileIter it(8); int mt, nt;
  while (it.next(mt, nt)) {
    const int m0 = mt * 256;
#pragma nounroll
    for (int s = 0; s < 2; ++s) {
      f32x16 acc[2][2];
      zero_acc(acc);
      const bf16_t* Y = s == 0 ? (const bf16_t*)(p.ws + OFF_QA) : (const bf16_t*)(dout + OO_YB);
      const bf16_t* WOUT = (const bf16_t*)(p.ws + (s == 0 ? OFF_WAOUT : OFF_WBOUT));
      gemm_kloop(H + (size_t)m0 * DM, DM, WIN + (size_t)(2560 + s * 1024 + nt * 128) * DM, DM, 16, acc, lds);
      unsigned* gl = (unsigned*)(lds + 2 * G_STAGE) + tid;
#pragma unroll
      for (int fi = 0; fi < 2; ++fi)
#pragma unroll
        for (int ti = 0; ti < 2; ++ti)
#pragma unroll
          for (int q = 0; q < 8; ++q) gl[((fi * 2 + ti) * 8 + q) * 512] = cvtpk(sigmoidf_(acc[fi][ti][2 * q]), sigmoidf_(acc[fi][ti][2 * q + 1]));
      zero_acc(acc);
      gemm_kloop(Y + (size_t)m0 * 512, 512, WOUT + (size_t)nt * 128 * 512, 512, 8, acc, lds);
      char* wb = lds + wid * 8192;
#pragma unroll
      for (int ti = 0; ti < 2; ++ti) {
        const int tl = ti * 32 + r32;
#pragma unroll
        for (int fi = 0; fi < 2; ++fi) {
#pragma unroll
          for (int g = 0; g < 4; ++g) {
            const unsigned g01 = gl[((fi * 2 + ti) * 8 + 2 * g) * 512], g23 = gl[((fi * 2 + ti) * 8 + 2 * g + 1) * 512];
            stage_put(wb, tl, fi * 8 + 2 * g + hi, __uint_as_float(g01 << 16) * acc[fi][ti][4 * g], __uint_as_float(g01 & 0xffff0000u) * acc[fi][ti][4 * g + 1],
                      __uint_as_float(g23 << 16) * acc[fi][ti][4 * g + 2], __uint_as_float(g23 & 0xffff0000u) * acc[fi][ti][4 * g + 3]);
          }
        }
      }
      bf16_t* dst = MG + (size_t)(m0 + wm * 64) * DM + nt * 128 + wn * 64;
      if (s == 0) stage_flush(wb, dst, DM, lane); else stage_flush_add(wb, dst, DM, lane);
    }
  }
}

__device__ __forceinline__ void phase_g4(const Params& p, char* lds) {
  const int tid = opaque_tid(), wid = __builtin_amdgcn_readfirstlane(tid >> 6), lane = tid & 63, r32 = lane & 31, hi = lane >> 5, wm = wid & 3, wn = wid >> 2;
  char* dout = (char*)p.out;
  const bf16_t* MG = (const bf16_t*)(dout + OO_MERGED);
  bf16_t* Z = (bf16_t*)(p.ws + OFF_H);
  float* part = (float*)(p.ws + OFF_PART) + 10 * T;
  TileIter it(8); int mt, nt;
  while (it.next(mt, nt)) {
    const int m0 = mt * 256;
    f32x16 acc[2][2];
    zero_acc(acc);
    gemm_kloop(MG + (size_t)m0 * DM, DM, (const bf16_t*)(p.ws + OFF_WO) + (size_t)nt * 128 * DM, DM, 16, acc, lds);
    char* wb = lds + wid * 8192;
    const int tok0 = m0 + wm * 64;
#pragma unroll
    for (int ti = 0; ti < 2; ++ti) {
      const int tl = ti * 32 + r32, tok = tok0 + tl;
      epi_plain32(acc[0][ti], 1.0f, wb, tl, 0, hi); epi_plain32(acc[1][ti], 1.0f, wb, tl, 8, hi);
      float s = sumsq16(acc[0][ti]) + sumsq16(acc[1][ti]); s += __shfl_xor(s, 32);
      if (hi == 0) part[(nt * 2 + wn) * T + tok] = s;
    }
    stage_flush(wb, Z + (size_t)tok0 * DM + nt * 128 + wn * 64, DM, lane);
  }
}

__device__ __forceinline__ void phase5(const Params& p) {
  const int tid = opaque_tid(), wid = tid >> 6, lane = tid & 63;
  const float* mod = (const float*)(p.ws + OFF_MOD);
  const bf16_t* Z = (const bf16_t*)(p.ws + OFF_H);
  const float* part = (const float*)(p.ws + OFF_PART) + 10 * T;
  for (int row = blockIdx.x * 8 + wid; row < T; row += gridDim.x * 8) {
    const float* xr = xrow_ptr(p, row);
    const int b = batch_of(row);
    const float sz = wave_sum(lane < 16 ? part[lane * T + row] : 0.f);
    const float rn = rsqrtf(sz * (1.0f / 1024.0f) + EPS);
    float* o = p.out + (size_t)row * DM;
#pragma unroll
    for (int i = 0; i < 4; ++i) {
      const int col = i * 256 + lane * 4;
      const float4 xv = *(const float4*)(xr + col);
      const u32x2 zz = *(const u32x2*)(Z + (size_t)row * DM + col);
      const float4 g = *(const float4*)(p.post_g + col);
      const float4 gt = *(const float4*)(mod + b * 3072 + 2048 + col);
      float4 r;
      r.x = xv.x + gt.x * (__uint_as_float(zz.x << 16) * rn * g.x);
      r.y = xv.y + gt.y * (__uint_as_float(zz.x & 0xffff0000u) * rn * g.y);
      r.z = xv.z + gt.z * (__uint_as_float(zz.y << 16) * rn * g.z);
      r.w = xv.w + gt.w * (__uint_as_float(zz.y & 0xffff0000u) * rn * g.w);
      *(float4*)(o + col) = r;
    }
  }
}

#define SBAR() __builtin_amdgcn_sched_barrier(0)
constexpr float ATT_THR = 8.0f;
constexpr int SHM_V = 64 * 64 * 2;
template <int DK> struct KL { static constexpr int RB = DK == 64 ? 128 : 256; static constexpr int SHM_K = 64 * RB; };
template <int DK> __device__ __forceinline__ int kswz(int row, int c) {
  if (DK == 64) return row * 128 + ((c ^ ((row >> 1) & 7)) << 4);
  return row * 256 + ((c ^ (row & 15)) << 4);
}
__device__ __forceinline__ int v_st(int k, int c) {
  const int kk = (k & ~0xC) | ((k & 4) << 1) | ((k & 8) >> 1);
  return ((kk >> 3) * 2 + (c >> 5)) * 512 + ((kk & 7) * 32 + (c & 31)) * 2;
}
__device__ __forceinline__ int v_rd_base(int lane) { return ((lane & 3) << 3) | (((lane >> 2) & 3) << 6) | (((lane >> 4) & 1) << 5) | (((lane >> 5) & 1) << 8); }
constexpr int v_rd_off(int d0, int ks, int half) { return d0 * 512 + ks * 2048 + half * 1024; }
template <int OFF> __device__ __forceinline__ s16x4 tr_read(int vb) {
  s16x4 r; asm volatile("ds_read_b64_tr_b16 %0, %1 offset:%2" : "=&v"(r) : "v"(vb), "i"(OFF) : "memory"); return r;
}
template <int D0> __device__ __forceinline__ void pv_one(f32x16& od, int vb, bf16x8 pa0, bf16x8 pa1, bf16x8 pa2, bf16x8 pa3) {
  const s16x4 l0 = tr_read<v_rd_off(D0, 0, 0)>(vb), h0 = tr_read<v_rd_off(D0, 0, 1)>(vb), l1 = tr_read<v_rd_off(D0, 1, 0)>(vb), h1 = tr_read<v_rd_off(D0, 1, 1)>(vb);
  const s16x4 l2 = tr_read<v_rd_off(D0, 2, 0)>(vb), h2 = tr_read<v_rd_off(D0, 2, 1)>(vb), l3 = tr_read<v_rd_off(D0, 3, 0)>(vb), h3 = tr_read<v_rd_off(D0, 3, 1)>(vb);
  asm volatile("s_waitcnt lgkmcnt(0)" ::: "memory"); SBAR();
#define PK(L, Hh) (bf16x8){L[0], L[1], L[2], L[3], Hh[0], Hh[1], Hh[2], Hh[3]}
  od = __builtin_amdgcn_mfma_f32_32x32x16_bf16(pa0, PK(l0, h0), od, 0, 0, 0);
  od = __builtin_amdgcn_mfma_f32_32x32x16_bf16(pa1, PK(l1, h1), od, 0, 0, 0);
  od = __builtin_amdgcn_mfma_f32_32x32x16_bf16(pa2, PK(l2, h2), od, 0, 0, 0);
  od = __builtin_amdgcn_mfma_f32_32x32x16_bf16(pa3, PK(l3, h3), od, 0, 0, 0);
#undef PK
}
__device__ __forceinline__ void pv_all(f32x16* o, int vb, bf16x8 pa0, bf16x8 pa1, bf16x8 pa2, bf16x8 pa3) {
  pv_one<0>(o[0], vb, pa0, pa1, pa2, pa3); pv_one<1>(o[1], vb, pa0, pa1, pa2, pa3);
}
__device__ __forceinline__ void partialSM(f32x16& p0, f32x16& p1, float& m_reg, float& alpha) {
  float pmax = p0[0];
#pragma unroll
  for (int r = 1; r < 16; ++r) pmax = fmaxf(pmax, p0[r]);
#pragma unroll
  for (int r = 0; r < 16; ++r) pmax = fmaxf(pmax, p1[r]);
  { auto rr = __builtin_amdgcn_permlane32_swap(__float_as_uint(pmax), __float_as_uint(pmax), false, false);
    pmax = fmaxf(__uint_as_float(rr[0]), __uint_as_float(rr[1])); }
  float mn;
  if (__builtin_expect(__all(pmax - m_reg <= ATT_THR), 1)) { mn = m_reg; alpha = 1.f; }
  else { mn = fmaxf(m_reg, pmax); alpha = __builtin_amdgcn_exp2f(m_reg - mn); m_reg = mn; }
#pragma unroll
  for (int r = 0; r < 16; ++r) p0[r] -= mn;
#pragma unroll
  for (int r = 0; r < 16; ++r) p1[r] -= mn;
#pragma unroll
  for (int r = 0; r < 16; ++r) p0[r] = __builtin_amdgcn_exp2f(p0[r]);
}
__device__ __forceinline__ void finishSM(f32x16& p0, f32x16& p1, float alpha, float& l_reg, bf16x8& pa0, bf16x8& pa1, bf16x8& pa2, bf16x8& pa3) {
#pragma unroll
  for (int r = 0; r < 16; ++r) p1[r] = __builtin_amdgcn_exp2f(p1[r]);
  float ps = 0.f;
#pragma unroll
  for (int r = 0; r < 16; ++r) ps += p0[r];
#pragma unroll
  for (int r = 0; r < 16; ++r) ps += p1[r];
  { auto rr = __builtin_amdgcn_permlane32_swap(__float_as_uint(ps), __float_as_uint(ps), false, false);
    ps = __uint_as_float(rr[0]) + __uint_as_float(rr[1]); }
  l_reg = l_reg * alpha + ps;
#define PK4(P, BASE, OUT) do { unsigned a0 = cvtpk(P[BASE + 0], P[BASE + 1]), a1 = cvtpk(P[BASE + 2], P[BASE + 3]);   \
    unsigned b0 = cvtpk(P[BASE + 4], P[BASE + 5]), b1 = cvtpk(P[BASE + 6], P[BASE + 7]);                              \
    auto r0 = __builtin_amdgcn_permlane32_swap(a0, b0, false, false); auto r1 = __builtin_amdgcn_permlane32_swap(a1, b1, false, false); \
    u32x4 w = {r0[0], r1[0], r0[1], r1[1]}; OUT = *reinterpret_cast<bf16x8*>(&w); } while (0)
  PK4(p0, 0, pa0); PK4(p0, 8, pa1); PK4(p1, 0, pa2); PK4(p1, 8, pa3);
#undef PK4
}
template <int DK> __device__ __forceinline__ void qkt(f32x16& p0, f32x16& p1, const char* Ks, const bf16x8* qr, int r32, int hi) {
#pragma unroll
  for (int r = 0; r < 16; ++r) { p0[r] = 0.f; p1[r] = 0.f; }
#pragma unroll
  for (int d0 = 0; d0 < DK / 16; ++d0) {
    const int off = kswz<DK>(r32, 2 * d0 + hi);
    const bf16x8 b0 = *reinterpret_cast<const bf16x8*>(Ks + off);
    const bf16x8 b1 = *reinterpret_cast<const bf16x8*>(Ks + off + 32 * KL<DK>::RB);
    p0 = __builtin_amdgcn_mfma_f32_32x32x16_bf16(b0, qr[d0], p0, 0, 0, 0);
    p1 = __builtin_amdgcn_mfma_f32_32x32x16_bf16(b1, qr[d0], p1, 0, 0, 0);
    if (QKT_SB && (d0 & 1) == 1 && d0 + 1 < DK / 16) SBAR();
  }
}

template <int DK>
__device__ __forceinline__ void attn_unit(const bf16_t* Qb, int ldq, const bf16_t* __restrict__ Kh, int ldk, const bf16_t* __restrict__ Krp,
                                          const bf16_t* __restrict__ Vh, int ldv, const bf16_t* Gb, bf16_t* Ob, int seq, char* lds) {
  constexpr int SHM_K = KL<DK>::SHM_K;
  const int tid = opaque_tid(), wid = __builtin_amdgcn_readfirstlane(tid >> 6), lane = tid & 63, r32 = lane & 31, hi = lane >> 5;
  char* V_lds = lds; char* K_lds = lds + 2 * SHM_V;
  float* ws = (float*)(lds + 2 * SHM_V + 2 * SHM_K) + wid * 64; float* li_l = ws; float* al_l = ws + 32;
  float m_reg = -1e30f, l_reg = 0.f; f32x16 o[2]; bf16x8 qr[DK / 16];
#pragma unroll
  for (int r = 0; r < 16; ++r) { o[0][r] = 0.f; o[1][r] = 0.f; }
  const bf16_t* Qw = Qb + (size_t)(wid * 32 + r32) * ldq + hi * 8;
#pragma unroll
  for (int d0 = 0; d0 < DK / 16; ++d0) qr[d0] = *reinterpret_cast<const bf16x8*>(Qw + d0 * 16);
  const int srow = tid >> 3, sc = tid & 7, vst = v_st(srow, sc * 8), kst = kswz<DK>(srow, sc);
  const int rrow = tid >> 2, rc = tid & 3, krst = kswz<DK>(rrow & 63, 8 + rc);
  const bool dor = (DK == 96) && (wid < 4);
  const int vb0 = (int)(uintptr_t)V_lds + v_rd_base(lane);
  struct { u32x4 v, k, r; } sr_[1];
  const unsigned voff0 = (unsigned)(srow * ldv + sc * 8) * 2u, koff0 = (unsigned)(srow * ldk + sc * 8) * 2u, roff0 = (unsigned)(rrow * 32 + rc * 8) * 2u;
#define SLOAD(i, k0) do { sr_[i].v = *(const u32x4*)((const char*)Vh + (voff0 + (unsigned)((k0) * ldv) * 2u)); sr_[i].k = *(const u32x4*)((const char*)Kh + (koff0 + (unsigned)((k0) * ldk) * 2u)); \
    if (dor) sr_[i].r = *(const u32x4*)((const char*)Krp + (roff0 + (unsigned)((k0) * 64))); } while (0)
#define SWRITE(b, i) do { *(u32x4*)(V_lds + (b) * SHM_V + vst) = sr_[i].v; *(u32x4*)(K_lds + (b) * SHM_K + kst) = sr_[i].k; \
    if (dor) *(u32x4*)(K_lds + (b) * SHM_K + krst) = sr_[i].r; } while (0)
#define RESC(a) do { if (__any((a) < 1.f)) { if (hi == 0) al_l[r32] = (a); asm volatile("s_waitcnt lgkmcnt(0)" ::: "memory"); \
    _Pragma("unroll") for (int d = 0; d < 2; ++d) _Pragma("unroll") for (int r = 0; r < 16; ++r) o[d][r] *= al_l[crow(r, hi)]; } } while (0)
  f32x16 pA0, pA1, pB0, pB1; float alA, alB; bf16x8 pa0, pa1, pa2, pa3; const int NT = seq / 64;
  __syncthreads();
  SLOAD(0, 0); SWRITE(0, 0); __syncthreads();
  qkt<DK>(pA0, pA1, K_lds, qr, r32, hi); partialSM(pA0, pA1, m_reg, alA);
  SLOAD(0, 64);
  SWRITE(1, 0); __syncthreads();
  for (int j = 1; j + 1 < NT; j += 2) {
    SBAR(); qkt<DK>(pB0, pB1, K_lds + SHM_K, qr, r32, hi);
    finishSM(pA0, pA1, alA, l_reg, pa0, pa1, pa2, pa3); SBAR();
    SLOAD(0, (j + 1) * 64); SBAR();
    pv_all(o, vb0, pa0, pa1, pa2, pa3); partialSM(pB0, pB1, m_reg, alB);
    __syncthreads(); SWRITE(0, 0);
    RESC(alB); __syncthreads();
    SBAR(); qkt<DK>(pA0, pA1, K_lds, qr, r32, hi);
    finishSM(pB0, pB1, alB, l_reg, pa0, pa1, pa2, pa3); SBAR();
    SLOAD(0, (j + 2) * 64); SBAR();
    pv_all(o, vb0 + SHM_V, pa0, pa1, pa2, pa3); partialSM(pA0, pA1, m_reg, alA);
    __syncthreads(); SWRITE(1, 0);
    RESC(alA); __syncthreads();
  }
  SBAR(); qkt<DK>(pB0, pB1, K_lds + SHM_K, qr, r32, hi);
  finishSM(pA0, pA1, alA, l_reg, pa0, pa1, pa2, pa3); SBAR();
  pv_all(o, vb0, pa0, pa1, pa2, pa3); partialSM(pB0, pB1, m_reg, alB);
  __syncthreads(); RESC(alB);
  finishSM(pB0, pB1, alB, l_reg, pa0, pa1, pa2, pa3); SBAR();
  pv_all(o, vb0 + SHM_V, pa0, pa1, pa2, pa3);
  if (hi == 0) li_l[r32] = l_reg; asm volatile("s_waitcnt lgkmcnt(0)" ::: "memory");
  float rli[16];
#pragma unroll
  for (int r = 0; r < 16; ++r) rli[r] = __builtin_amdgcn_rcpf(li_l[crow(r, hi)]);
#pragma unroll
  for (int r = 0; r < 16; ++r) {
    const size_t rowo = (size_t)(wid * 32 + crow(r, hi)) * 512;
#pragma unroll
    for (int d0 = 0; d0 < 2; ++d0) {
      const size_t idx = rowo + d0 * 32 + r32;
      const float g = bf2f(Gb[idx]);
      Ob[idx] = (bf16_t)(cvtpk(o[d0][r] * rli[r] * g, 0.f) & 0xffffu);
    }
  }
#undef SLOAD
#undef SWRITE
#undef RESC
}

__device__ __forceinline__ void exp16(f32x16& p) {
#pragma unroll
  for (int r = 0; r < 16; ++r) p[r] = __builtin_amdgcn_exp2f(p[r]);
}
__device__ __forceinline__ void finishFast(f32x16& p0, f32x16& p1, float& l_reg, bf16x8& pa0, bf16x8& pa1, bf16x8& pa2, bf16x8& pa3) {
  exp16(p1);
  float ps = 0.f;
#pragma unroll
  for (int r = 0; r < 16; ++r) ps += p0[r];
#pragma unroll
  for (int r = 0; r < 16; ++r) ps += p1[r];
  l_reg += ps;
#define PK4(P, BASE, OUT) do { unsigned a0 = cvtpk(P[BASE + 0], P[BASE + 1]), a1 = cvtpk(P[BASE + 2], P[BASE + 3]);   \
    unsigned b0 = cvtpk(P[BASE + 4], P[BASE + 5]), b1 = cvtpk(P[BASE + 6], P[BASE + 7]);                              \
    auto r0 = __builtin_amdgcn_permlane32_swap(a0, b0, false, false); auto r1 = __builtin_amdgcn_permlane32_swap(a1, b1, false, false); \
    u32x4 w = {r0[0], r1[0], r0[1], r1[1]}; OUT = *reinterpret_cast<bf16x8*>(&w); } while (0)
  PK4(p0, 0, pa0); PK4(p0, 8, pa1); PK4(p1, 0, pa2); PK4(p1, 8, pa3);
#undef PK4
}
template <int DK>
__device__ __forceinline__ void attn_unit_fast(const bf16_t* Qb, int ldq, const bf16_t* __restrict__ Kh, int ldk, const bf16_t* __restrict__ Krp,
                                               const bf16_t* __restrict__ Vh, int ldv, const bf16_t* Gb, bf16_t* Ob, int seq, char* lds) {
  constexpr int SHM_K = KL<DK>::SHM_K;
  const int tid = opaque_tid(), wid = __builtin_amdgcn_readfirstlane(tid >> 6), lane = tid & 63, r32 = lane & 31, hi = lane >> 5;
  char* V_lds = lds; char* K_lds = lds + 3 * SHM_V;
  float* ws = (float*)(lds + 3 * SHM_V + 3 * SHM_K) + wid * 64; float* li_l = ws;
  float l_reg = 0.f; f32x16 o[2]; bf16x8 qr[DK / 16];
#pragma unroll
  for (int r = 0; r < 16; ++r) { o[0][r] = 0.f; o[1][r] = 0.f; }
  const bf16_t* Qw = Qb + (size_t)(wid * 32 + r32) * ldq + hi * 8;
#pragma unroll
  for (int d0 = 0; d0 < DK / 16; ++d0) qr[d0] = *reinterpret_cast<const bf16x8*>(Qw + d0 * 16);
  const int srow = tid >> 3, sc = tid & 7, vst = v_st(srow, sc * 8), kst = kswz<DK>(srow, sc);
  const int rrow = tid >> 2, rc = tid & 3, krst = kswz<DK>(rrow & 63, 8 + rc);
  const bool dor = (DK == 96) && (wid < 4);
  const int vb0 = (int)(uintptr_t)V_lds + v_rd_base(lane);
  struct { u32x4 v, k, r; } sr_[1];
  const unsigned voff0 = (unsigned)(srow * ldv + sc * 8) * 2u, koff0 = (unsigned)(srow * ldk + sc * 8) * 2u, roff0 = (unsigned)(rrow * 32 + rc * 8) * 2u;
#define SLOAD(i, k0) do { sr_[i].v = *(const u32x4*)((const char*)Vh + (voff0 + (unsigned)((k0) * ldv) * 2u)); sr_[i].k = *(const u32x4*)((const char*)Kh + (koff0 + (unsigned)((k0) * ldk) * 2u)); \
    if (dor) sr_[i].r = *(const u32x4*)((const char*)Krp + (roff0 + (unsigned)((k0) * 64))); } while (0)
#define SWRITE(slot, i) do { *(u32x4*)(V_lds + (slot) * SHM_V + vst) = sr_[i].v; *(u32x4*)(K_lds + (slot) * SHM_K + kst) = sr_[i].k; \
    if (dor) *(u32x4*)(K_lds + (slot) * SHM_K + krst) = sr_[i].r; } while (0)
  f32x16 pA0, pA1, pB0, pB1; bf16x8 pa0, pa1, pa2, pa3; const int NT = seq / 64;
  int sp = 2, st = 0, sn = 1;
#define ROT() do { sp = st; st = sn; sn = (sn == 2) ? 0 : sn + 1; } while (0)
#define STEP(C0, C1, P0, P1, SETW, t, DOW) do { SBAR(); qkt<DK>(C0, C1, K_lds + st * SHM_K, qr, r32, hi); \
    finishFast(P0, P1, l_reg, pa0, pa1, pa2, pa3); SBAR(); \
    if (DOW) { SWRITE(sn, 0); if ((t) + 2 < NT) SLOAD(0, ((t) + 2) * 64); } SBAR(); \
    pv_all(o, vb0 + sp * SHM_V, pa0, pa1, pa2, pa3); exp16(C0); \
    __syncthreads(); ROT(); } while (0)
  __syncthreads();
  SLOAD(0, 0); SWRITE(0, 0); SLOAD(0, 64); __syncthreads();
  qkt<DK>(pA0, pA1, K_lds, qr, r32, hi);
  SWRITE(1, 0); SLOAD(0, 128);
  exp16(pA0);
  __syncthreads(); ROT();
  for (int t = 1; t + 1 < NT; t += 2) {
    STEP(pB0, pB1, pA0, pA1, 0, t, true);
    STEP(pA0, pA1, pB0, pB1, 1, t + 1, true);
  }
  STEP(pB0, pB1, pA0, pA1, 0, NT - 1, false);
  finishFast(pB0, pB1, l_reg, pa0, pa1, pa2, pa3); SBAR();
  pv_all(o, vb0 + sp * SHM_V, pa0, pa1, pa2, pa3);
  { auto rr = __builtin_amdgcn_permlane32_swap(__float_as_uint(l_reg), __float_as_uint(l_reg), false, false);
    l_reg = __uint_as_float(rr[0]) + __uint_as_float(rr[1]); }
  if (hi == 0) li_l[r32] = l_reg; asm volatile("s_waitcnt lgkmcnt(0)" ::: "memory");
  float rli[16];
#pragma unroll
  for (int r = 0; r < 16; ++r) rli[r] = __builtin_amdgcn_rcpf(li_l[crow(r, hi)]);
#pragma unroll
  for (int r = 0; r < 16; ++r) {
    const size_t rowo = (size_t)(wid * 32 + crow(r, hi)) * 512;
#pragma unroll
    for (int d0 = 0; d0 < 2; ++d0) {
      const size_t idx = rowo + d0 * 32 + r32;
      const float g = bf2f(Gb[idx]);
      Ob[idx] = (bf16_t)(cvtpk(o[d0][r] * rli[r] * g, 0.f) & 0xffffu);
    }
  }
#undef SLOAD
#undef SWRITE
#undef ROT
#undef STEP
}

__device__ __forceinline__ void phase_attn(const Params& p, char* lds) {
  char* dout = (char*)p.out;
  const float* bnd = (const float*)(p.ws + OFF_BND);
  const bool fastA = bnd[0] < 60.0f;
  const bool fastB = 3.0f * bnd[1] * (2.0f * bnd[2] + bnd[3]) < 3600.0f;
  for (int u = blockIdx.x; u < 2048; u += gridDim.x) {
    const int i = u >> 8, v = u & 255, cls = i >> 1, sub = i & 1, head = v & 7, j = v >> 3;
    int seq0, seq, tok0;
    if (cls < 2) { seq0 = 0; seq = NP; tok0 = (2 * j + sub) * 256; }
    else { const int bi = j >> 3, qb = 2 * (j & 7) + sub; seq0 = NP + bi * NS; seq = NS; tok0 = seq0 + qb * 256; }
    if ((cls & 1) == 0) {
      bf16_t* QA = (bf16_t*)(p.ws + OFF_QA);
      const bf16_t* Kp = (const bf16_t*)(p.ws + OFF_KA) + (size_t)seq0 * 128 + (head >> 2) * 64;
      const bf16_t* Vp = (const bf16_t*)(p.ws + OFF_VA) + (size_t)seq0 * 128 + (head >> 2) * 64;
      const bf16_t* Gp = (const bf16_t*)(dout + OO_GA) + (size_t)tok0 * 512 + head * 64;
      bf16_t* Qp = QA + (size_t)tok0 * 512 + head * 64;
      if (fastA) attn_unit_fast<64>(Qp, 512, Kp, 128, nullptr, Vp, 128, Gp, Qp, seq, lds);
      else if (ATT_SAFE) attn_unit<64>(Qp, 512, Kp, 128, nullptr, Vp, 128, Gp, Qp, seq, lds);
    } else {
      const bf16_t* Qp = (const bf16_t*)(p.ws + OFF_QB) + (size_t)tok0 * 768 + head * 96;
      const bf16_t* Kp = (const bf16_t*)(p.ws + OFF_KBN) + (size_t)seq0 * 512 + head * 64;
      const bf16_t* Rp = (const bf16_t*)(p.ws + OFF_KR) + (size_t)seq0 * 32;
      const bf16_t* Vp = (const bf16_t*)(p.ws + OFF_VB) + (size_t)seq0 * 512 + head * 64;
      const bf16_t* Gp = (const bf16_t*)(dout + OO_GB) + (size_t)tok0 * 512 + head * 64;
      bf16_t* Op = (bf16_t*)(dout + OO_YB) + (size_t)tok0 * 512 + head * 64;
      if (fastB) attn_unit_fast<96>(Qp, 768, Kp, 512, Rp, Vp, 512, Gp, Op, seq, lds);
      else if (ATT_SAFE) attn_unit<96>(Qp, 768, Kp, 512, Rp, Vp, 512, Gp, Op, seq, lds);
    }
  }
}

#if MK_SINGLE
#ifndef PROBE_MASK
#define PROBE_MASK 0
#endif
__global__ void __launch_bounds__(512) fwd_kernel(Params p) {
  extern __shared__ __attribute__((aligned(16))) char lds[];
#if PROBE_MASK
  volatile unsigned long long* tst = (volatile unsigned long long*)(p.ws + OFF_BND + 64) + blockIdx.x * 16;
  if (threadIdx.x == 0) tst[0] = wall_clock64();
#define STAMP(k) if (threadIdx.x == 0) tst[k + 1] = wall_clock64();
#else
#define STAMP(k)
#endif
#define PHASE(k, call) if (PH_MASK & (1 << k)) { call; if (k < 7) { cg::this_grid().sync(); STAMP(k) } }
  PHASE(0, phase0(p, lds))
  PHASE(1, phase1(p))
  PHASE(2, phase_g1(p, lds))
  PHASE(3, phase_g2(p, lds))
  PHASE(4, phase_attn(p, lds))
  PHASE(5, phase_g3(p, lds))
  PHASE(6, phase_g4(p, lds))
  PHASE(7, phase5(p))
#undef PHASE
#if PROBE_MASK
  if (blockIdx.x == 0) {
    __syncthreads();
    float* dshp = (float*)lds;
    if (threadIdx.x == 0) {
    unsigned long long tot = 0;
    for (int k = 0; k < 7; ++k) if (PROBE_MASK & (1 << k)) tot += tst[k + 1] - tst[k];
    dshp[0] = sqrtf((float)tot * (0.01f / 4000.0f));
    }
    __syncthreads();
    const float d = dshp[0];
    for (int i = threadIdx.x; i < 8 * 1024; i += 512) p.out[i] += d;
  }
#endif
}
#define MAIN_KERNEL fwd_kernel
#else
template <int PH>
__global__ void __launch_bounds__(512) ph_kernel(Params p) {
  extern __shared__ __attribute__((aligned(16))) char lds[];
  if (PH == 0) phase0(p, lds);
  if (PH == 1) phase1(p);
  if (PH == 2) phase_g1(p, lds);
  if (PH == 3) phase_g2(p, lds);
  if (PH == 4) phase_attn(p, lds);
  if (PH == 5) phase_g3(p, lds);
  if (PH == 6) phase_g4(p, lds);
  if (PH == 7) phase5(p);
}
#define MAIN_KERNEL ph_kernel<4>
#endif

extern "C" void kernel_launch(void* const* d_in, const int* in_sizes, int n_in, void* d_out, int out_size, void* d_ws, size_t ws_size,
                              hipStream_t stream) {
  Params p{};
  p.x_prompt = (const float*)d_in[0]; p.x_sample = (const float*)d_in[1]; p.c_prompt = (const float*)d_in[2]; p.c_sample = (const float*)d_in[3];
  p.ada_w = (const float*)d_in[4]; p.ada_b = (const float*)d_in[5]; p.pre_g = (const float*)d_in[6]; p.post_g = (const float*)d_in[7];
  p.w_in = (const float*)d_in[8]; p.a_q_g = (const float*)d_in[9]; p.a_k_g = (const float*)d_in[10]; p.b_q_g = (const float*)d_in[11];
  p.b_q_up = (const float*)d_in[12]; p.b_kv_g = (const float*)d_in[13]; p.b_kv_up = (const float*)d_in[14]; p.a_out = (const float*)d_in[15];
  p.b_out = (const float*)d_in[16]; p.w_o = (const float*)d_in[17];
  p.out = (float*)d_out; p.ws = (char*)d_ws;
  static int grid_blocks = 0;
  if (!grid_blocks) {
    int dev = 0, cus = 0, per_cu = 0;
    (void)hipGetDevice(&dev);
    (void)hipDeviceGetAttribute(&cus, hipDeviceAttributeMultiprocessorCount, dev);
    (void)hipFuncSetAttribute((const void*)MAIN_KERNEL, hipFuncAttributeMaxDynamicSharedMemorySize, LDS_BYTES);
    (void)hipOccupancyMaxActiveBlocksPerMultiprocessor(&per_cu, MAIN_KERNEL, 512, LDS_BYTES);
    if (per_cu < 1) per_cu = 1;
    if (per_cu > 1) per_cu = 1;
    grid_blocks = cus * per_cu;
    if (grid_blocks <= 0) grid_blocks = 256;
  }
#if MK_SINGLE
  void* args[] = {&p};
  hipError_t err = hipLaunchCooperativeKernel((const void*)fwd_kernel, dim3(grid_blocks), dim3(512), args, LDS_BYTES, stream);
  if (err != hipSuccess) fprintf(stderr, "cooperative launch failed: %s (grid %d)\n", hipGetErrorString(err), grid_blocks);
#else
  static bool attr_set = false;
  if (!attr_set) {
    (void)hipFuncSetAttribute((const void*)ph_kernel<0>, hipFuncAttributeMaxDynamicSharedMemorySize, LDS_BYTES);
    (void)hipFuncSetAttribute((const void*)ph_kernel<2>, hipFuncAttributeMaxDynamicSharedMemorySize, LDS_BYTES);
    (void)hipFuncSetAttribute((const void*)ph_kernel<3>, hipFuncAttributeMaxDynamicSharedMemorySize, LDS_BYTES);
    (void)hipFuncSetAttribute((const void*)ph_kernel<5>, hipFuncAttributeMaxDynamicSharedMemorySize, LDS_BYTES);
    (void)hipFuncSetAttribute((const void*)ph_kernel<6>, hipFuncAttributeMaxDynamicSharedMemorySize, LDS_BYTES);
    attr_set = true;
  }
  hipLaunchKernelGGL(ph_kernel<0>, dim3(grid_blocks), dim3(512), LDS_BYTES, stream, p);
  hipLaunchKernelGGL(ph_kernel<1>, dim3(grid_blocks), dim3(512), LDS_BYTES, stream, p);
  hipLaunchKernelGGL(ph_kernel<2>, dim3(grid_blocks), dim3(512), LDS_BYTES, stream, p);
  hipLaunchKernelGGL(ph_kernel<3>, dim3(grid_blocks), dim3(512), LDS_BYTES, stream, p);
  hipLaunchKernelGGL(ph_kernel<4>, dim3(grid_blocks), dim3(512), LDS_BYTES, stream, p);
  hipLaunchKernelGGL(ph_kernel<5>, dim3(grid_blocks), dim3(512), LDS_BYTES, stream, p);
  hipLaunchKernelGGL(ph_kernel<6>, dim3(grid_blocks), dim3(512), LDS_BYTES, stream, p);
  hipLaunchKernelGGL(ph_kernel<7>, dim3(grid_blocks), dim3(512), LDS_BYTES, stream, p);
#endif
}
```

```cpp
#include <hip/hip_runtime.h>
#include <hip/hip_cooperative_groups.h>
#include <stdint.h>
#include <cstdio>
namespace cg = cooperative_groups;

#ifndef MK_SINGLE
#define MK_SINGLE 1
#endif
#ifndef QKT_SB
#define QKT_SB 0
#endif
#ifndef ATT_SAFE
#define ATT_SAFE 1
#endif
#ifndef PH_MASK
#define PH_MASK 255
#endif

typedef unsigned short bf16_t;
typedef short bf16x8 __attribute__((ext_vector_type(8)));
typedef short s16x4 __attribute__((ext_vector_type(4)));
typedef float f32x16 __attribute__((ext_vector_type(16)));
typedef unsigned u32x4 __attribute__((ext_vector_type(4)));
typedef unsigned u32x2 __attribute__((ext_vector_type(2)));

constexpr int T = 32768, NP = 16384, NS = 4096, DM = 1024;
constexpr float EPS = 1e-6f;
constexpr float LOG2E = 1.4426950408889634f;
constexpr float PS_A = 0.125f * LOG2E;
constexpr float PS_B = 0.10206207261596575f * LOG2E;

constexpr size_t U = 67108864ull;
constexpr size_t OFF_H = 0;
constexpr size_t OFF_QA = U;
constexpr size_t OFF_KA = U + U / 2;
constexpr size_t OFF_VA = OFF_KA + U / 8;
constexpr size_t OFF_KR = OFF_VA + U / 8;
constexpr size_t OFF_PART = OFF_KR + 2097152;
constexpr size_t OFF_QB = 2 * U;
constexpr size_t OFF_KBN = OFF_QB + (U / 4) * 3;
constexpr size_t OFF_VB = OFF_KBN + U / 2;
constexpr size_t OFF_W = OFF_VB + U / 2;
constexpr size_t OFF_WIN = OFF_W;
constexpr size_t OFF_WQUP = OFF_WIN + 4608ull * 1024 * 2;
constexpr size_t OFF_WKVUP = OFF_WQUP + 768ull * 384 * 2;
constexpr size_t OFF_WAOUT = OFF_WKVUP + 1024ull * 256 * 2;
constexpr size_t OFF_WBOUT = OFF_WAOUT + 1024ull * 512 * 2;
constexpr size_t OFF_WO = OFF_WBOUT + 1024ull * 512 * 2;
constexpr size_t OFF_MOD = OFF_WO + 1024ull * 1024 * 2;
constexpr size_t OFF_SSQ = OFF_MOD + 5 * 3072 * 4;
constexpr size_t OFF_TABA = OFF_SSQ + 3ull * T * 4;
constexpr size_t OFF_TABB = OFF_TABA + 256 * 16 * 8;
constexpr size_t OFF_BND = OFF_TABB + 256 * 8 * 8;
constexpr size_t WS_END = OFF_BND + 256 + 256 * 128;
static_assert(WS_END <= 4 * U, "workspace map exceeds 256 MiB");
constexpr size_t OO_BQ = 0;
constexpr size_t OO_BKV = (size_t)T * 384 * 2;
constexpr size_t OO_YB = 0;
constexpr size_t OO_GA = U;
constexpr size_t OO_GB = U + U / 2;
constexpr size_t OO_MERGED = U;

constexpr int LDS_BYTES = 163840;

struct Params {
  const float *x_prompt, *x_sample, *c_prompt, *c_sample, *ada_w, *ada_b, *pre_g, *post_g, *w_in, *a_q_g, *a_k_g, *b_q_g, *b_q_up,
      *b_kv_g, *b_kv_up, *a_out, *b_out, *w_o;
  float* out;
  char* ws;
};

__device__ __forceinline__ int opaque_tid() { int t = threadIdx.x; asm volatile("" : "+v"(t)); return t; }
typedef float f32x2_t __attribute__((ext_vector_type(2)));
typedef __bf16 bf16x2_t __attribute__((ext_vector_type(2)));
__device__ __forceinline__ unsigned cvtpk(float lo, float hi) { f32x2_t v = {lo, hi}; bf16x2_t b = __builtin_convertvector(v, bf16x2_t); return __builtin_bit_cast(unsigned, b); }
__device__ __forceinline__ float bf2f(unsigned short v) { return __uint_as_float(((unsigned)v) << 16); }
__device__ __forceinline__ int crow(int r, int hi) { return (r & 3) + 8 * (r >> 2) + 4 * hi; }
__device__ __forceinline__ void st4(bf16_t* p, float a, float b, float c, float d) { u32x2 w; w.x = cvtpk(a, b); w.y = cvtpk(c, d); *(u32x2*)p = w; }
__device__ __forceinline__ float sigmoidf_(float v) { return 1.0f / (1.0f + __expf(-v)); }
__device__ __forceinline__ const float* xrow_ptr(const Params& p, int tok) { return tok < NP ? p.x_prompt + (size_t)tok * DM : p.x_sample + (size_t)(tok - NP) * DM; }
__device__ __forceinline__ int batch_of(int tok) { return tok < NP ? 0 : 1 + ((tok - NP) >> 12); }
__device__ __forceinline__ int pos_of(int tok) { return tok < NP ? tok : ((tok - NP) & 4095); }

__device__ __forceinline__ int win_src(int n) {
  if (n < 768) return n;
  if (n < 1152) return 1280 + (n - 768);
  if (n < 1408) return 1664 + (n - 1152);
  if (n < 1440) return 1920 + (n - 1408);
  if (n < 1536) return -1;
  if (n < 2048) return 768 + (n - 1536);
  if (n < 2560) return 1952 + (n - 2048);
  return 2464 + (n - 2560);
}
__device__ __forceinline__ void cvt_tile(const float* __restrict__ W, int ldn, int K, bf16_t* __restrict__ dst, bool remap,
                                         const float* __restrict__ gain, int item, float* tl  , int tid) {
  const int ktiles = K >> 6, n0 = (item / ktiles) * 64, k0 = (item % ktiles) * 64;
  __syncthreads();
  {
    const int n4 = (tid & 15) * 4, kr = tid >> 4;
    const int nd = n0 + n4;
    const int src = remap ? win_src(nd) : nd;
#pragma unroll
    for (int i = 0; i < 2; ++i) {
      const int k = kr + 32 * i;
      float4 v = make_float4(0.f, 0.f, 0.f, 0.f);
      if (src >= 0) v = *(const float4*)(W + (size_t)(k0 + k) * ldn + src);
      if (gain) { const float g = gain[k0 + k]; v.x *= g; v.y *= g; v.z *= g; v.w *= g; }
      float* r = tl + k * 65 + n4;
      r[0] = v.x; r[1] = v.y; r[2] = v.z; r[3] = v.w;
    }
  }
  __syncthreads();
  {
    const int n = tid >> 3, kc = tid & 7;
    const float* c = tl + (kc * 8) * 65 + n;
    u32x4 o; o.x = cvtpk(c[0], c[65]); o.y = cvtpk(c[130], c[195]); o.z = cvtpk(c[260], c[325]); o.w = cvtpk(c[390], c[455]);
    *(u32x4*)(dst + (size_t)(n0 + n) * K + k0 + kc * 8) = o;
  }
}

__device__ __forceinline__ void phase0(const Params& p, char* lds) {
  const int tid = opaque_tid(), gsz = gridDim.x * 512, gtid = blockIdx.x * 512 + tid;
  if (gtid == 0) {
    float* bnd = (float*)(p.ws + OFF_BND);
    float gq = 0.f, gk = 0.f;
    for (int i = 0; i < 64; ++i) { gq = fmaxf(gq, fabsf(p.a_q_g[i])); gk = fmaxf(gk, fabsf(p.a_k_g[i])); }
    bnd[0] = 64.0f * gq * gk * PS_A;
    bnd[1] = 0.f; bnd[2] = 0.f; bnd[3] = 0.f;
  }
  float2* tabA = (float2*)(p.ws + OFF_TABA);
  float2* tabB = (float2*)(p.ws + OFF_TABB);
  for (int i = gtid; i < 256 * 16 + 256 * 8; i += gsz) {
    int pos, f; float inv;
    const float L2T = 13.287712379549449f;
    if (i < 4096) { pos = i >> 4; f = i & 15; inv = exp2f(-(float)f * (1.0f / 16.0f) * L2T); }
    else { int k = i - 4096; pos = k >> 3; f = k & 7; inv = exp2f(-(float)f * (1.0f / 8.0f) * L2T); }
    float ang = (float)pos * inv;
    float rev = ang * 0.15915494309189535f; rev -= floorf(rev);
    float2 cs; cs.x = __builtin_amdgcn_cosf(rev); cs.y = __builtin_amdgcn_sinf(rev);
    if (i < 4096) tabA[i] = cs; else tabB[i - 4096] = cs;
  }
  {
    float* tl = (float*)(lds + 16384);
    for (int it = blockIdx.x; it < 1800; it += gridDim.x) {
      if (it < 1152) cvt_tile(p.w_in, 4512, 1024, (bf16_t*)(p.ws + OFF_WIN), true, nullptr, it, tl, tid);
      else if (it < 1224) cvt_tile(p.b_q_up, 768, 384, (bf16_t*)(p.ws + OFF_WQUP), false, p.b_q_g, it - 1152, tl, tid);
      else if (it < 1288) cvt_tile(p.b_kv_up, 1024, 256, (bf16_t*)(p.ws + OFF_WKVUP), false, p.b_kv_g, it - 1224, tl, tid);
      else if (it < 1416) cvt_tile(p.a_out, 1024, 512, (bf16_t*)(p.ws + OFF_WAOUT), false, nullptr, it - 1288, tl, tid);
      else if (it < 1544) cvt_tile(p.b_out, 1024, 512, (bf16_t*)(p.ws + OFF_WBOUT), false, nullptr, it - 1416, tl, tid);
      else cvt_tile(p.w_o, 1024, 1024, (bf16_t*)(p.ws + OFF_WO), false, nullptr, it - 1544, tl, tid);
    }
  }
  float* red = (float*)lds;
  float* sl = (float*)(lds + 16384);
  float* mod = (float*)(p.ws + OFF_MOD);
  __syncthreads();
  for (int i = tid; i < 5 * 1024; i += 512) { const float cv = i < 1024 ? p.c_prompt[i] : p.c_sample[i - 1024]; sl[i] = cv * sigmoidf_(cv); }
  __syncthreads();
  for (int it = blockIdx.x; it < 256; it += gridDim.x) {
    const int c = tid & 15, kg = tid >> 4;
    float a0 = 0.f, a1 = 0.f, a2 = 0.f, a3 = 0.f, a4 = 0.f;
    if (c < 12) {
      const float* wp = p.ada_w + it * 12 + c;
#pragma unroll 8
      for (int k = kg; k < 1024; k += 32) {
        const float w = wp[(size_t)k * 3072];
        a0 += sl[k] * w; a1 += sl[1024 + k] * w; a2 += sl[2048 + k] * w; a3 += sl[3072 + k] * w; a4 += sl[4096 + k] * w;
      }
    }
    float* rp = red + (kg * 16 + c) * 5;
    rp[0] = a0; rp[1] = a1; rp[2] = a2; rp[3] = a3; rp[4] = a4;
    __syncthreads();
    if (tid < 60) {
      const int cc = tid / 5, b = tid % 5;
      float s = 0.f;
      for (int g = 0; g < 32; ++g) s += red[(g * 16 + cc) * 5 + b];
      const int col = it * 12 + cc;
      mod[b * 3072 + col] = s + p.ada_b[col];
    }
    __syncthreads();
  }
}

__device__ __forceinline__ float wave_sum(float v) {
#pragma unroll
  for (int o = 32; o >= 1; o >>= 1) v += __shfl_xor(v, o);
  return v;
}
__device__ __forceinline__ void phase1(const Params& p) {
  const int tid = opaque_tid(), wid = tid >> 6, lane = tid & 63;
  const float* mod = (const float*)(p.ws + OFF_MOD);
  bf16_t* H = (bf16_t*)(p.ws + OFF_H);
  for (int row = blockIdx.x * 8 + wid; row < T; row += gridDim.x * 8) {
    const float* xr = xrow_ptr(p, row);
    const int b = batch_of(row);
    float4 v[4];
#pragma unroll
    for (int i = 0; i < 4; ++i) v[i] = *(const float4*)(xr + i * 256 + lane * 4);
    float ss = 0.f;
#pragma unroll
    for (int i = 0; i < 4; ++i) ss += v[i].x * v[i].x + v[i].y * v[i].y + v[i].z * v[i].z + v[i].w * v[i].w;
    ss = wave_sum(ss);
    const float rn = rsqrtf(ss * (1.0f / 1024.0f) + EPS);
#pragma unroll
    for (int i = 0; i < 4; ++i) {
      const int col = i * 256 + lane * 4;
      const float4 g = *(const float4*)(p.pre_g + col);
      const float4 sh = *(const float4*)(mod + b * 3072 + col);
      const float4 sc = *(const float4*)(mod + b * 3072 + 1024 + col);
      st4(H + (size_t)row * DM + col, v[i].x * rn * g.x * (1.f + sc.x) + sh.x, v[i].y * rn * g.y * (1.f + sc.y) + sh.y,
          v[i].z * rn * g.z * (1.f + sc.z) + sh.z, v[i].w * rn * g.w * (1.f + sc.w) + sh.w);
    }
  }
}

constexpr int G_XB = 256 * 128, G_WB = 128 * 128, G_STAGE = G_XB + G_WB;
__device__ __forceinline__ int gswz(int row, int c) { return row * 128 + ((c ^ ((row >> 1) & 7)) << 4); }

__device__ __forceinline__ void gemm_kloop(const bf16_t* __restrict__ X, int ldx, const bf16_t* __restrict__ W, int ldw, int nk,
                                           f32x16 (&acc)[2][2], char* lds) {
  const int tid = opaque_tid(), wid = __builtin_amdgcn_readfirstlane(tid >> 6), lane = tid & 63, r32 = lane & 31, hi = lane >> 5, wm = wid & 3, wn = wid >> 2;
  const int srow = tid >> 3, sch = tid & 7;
  const char* xg = (const char*)X;
  const char* wg = (const char*)W;
  const unsigned xstep = (unsigned)ldx * 128u, wstep = (unsigned)ldw * 128u;
  const unsigned xo0 = (unsigned)(srow * ldx + sch * 8) * 2u, wo0 = (unsigned)(srow * ldw + sch * 8) * 2u;
  const int sw = gswz(srow, sch);
  u32x4 xa[4], wa[2], xb[4], wb[2];
  const int fsw = (r32 >> 1) & 7;
  int koff[4];
#pragma unroll
  for (int ks = 0; ks < 4; ++ks) koff[ks] = ((2 * ks + hi) ^ fsw) << 4;
  const int rowA = G_XB + (wn * 64 + r32) * 128, rowB = (wm * 64 + r32) * 128;
#define GLOAD(xr, wr, kt) do { _Pragma("unroll") for (int i = 0; i < 4; ++i) xr[i] = *(const u32x4*)(xg + (xo0 + i * xstep + (unsigned)(kt) * 128u)); \
    _Pragma("unroll") for (int i = 0; i < 2; ++i) wr[i] = *(const u32x4*)(wg + (wo0 + i * wstep + (unsigned)(kt) * 128u)); } while (0)
#define GWRITE(s, xr, wr) do { char* b_ = lds + (s) * G_STAGE; _Pragma("unroll") for (int i = 0; i < 4; ++i) *(u32x4*)(b_ + sw + i * 8192) = xr[i]; \
    _Pragma("unroll") for (int i = 0; i < 2; ++i) *(u32x4*)(b_ + G_XB + sw + i * 8192) = wr[i]; } while (0)
#define GCOMPUTE(s) do { const char* sb = lds + (s) * G_STAGE; _Pragma("unroll") for (int ks = 0; ks < 4; ++ks) { \
      const bf16x8 a0 = *(const bf16x8*)(sb + rowA + koff[ks]); const bf16x8 a1 = *(const bf16x8*)(sb + rowA + 4096 + koff[ks]); \
      const bf16x8 b0 = *(const bf16x8*)(sb + rowB + koff[ks]); const bf16x8 b1 = *(const bf16x8*)(sb + rowB + 4096 + koff[ks]); \
      acc[0][0] = __builtin_amdgcn_mfma_f32_32x32x16_bf16(a0, b0, acc[0][0], 0, 0, 0); acc[0][1] = __builtin_amdgcn_mfma_f32_32x32x16_bf16(a0, b1, acc[0][1], 0, 0, 0); \
      acc[1][0] = __builtin_amdgcn_mfma_f32_32x32x16_bf16(a1, b0, acc[1][0], 0, 0, 0); acc[1][1] = __builtin_amdgcn_mfma_f32_32x32x16_bf16(a1, b1, acc[1][1], 0, 0, 0); } } while (0)
  __syncthreads();
  GLOAD(xa, wa, 0); GLOAD(xb, wb, 1); GWRITE(0, xa, wa); __syncthreads();
#pragma nounroll
  for (int kt = 0; kt < nk; kt += 2) {
    const int ka = kt + 2 < nk ? kt + 2 : nk - 2, kb = kt + 3 < nk ? kt + 3 : nk - 1;
    GLOAD(xa, wa, ka);
    GCOMPUTE(0);
    GWRITE(1, xb, wb);
    __syncthreads();
    GLOAD(xb, wb, kb);
    GCOMPUTE(1);
    GWRITE(0, xa, wa);
    __syncthreads();
  }
  asm volatile("s_waitcnt vmcnt(0)" ::: "memory");
#undef GLOAD
#undef GWRITE
#undef GCOMPUTE
}
__device__ __forceinline__ void zero_acc(f32x16 (&acc)[2][2]) {
#pragma unroll
  for (int a = 0; a < 2; ++a)
#pragma unroll
    for (int b = 0; b < 2; ++b)
#pragma unroll
      for (int r = 0; r < 16; ++r) acc[a][b][r] = 0.f;
}

__device__ __forceinline__ void stage_put(char* wb, int t, int q, float a, float b, float c, float d) {
  u32x2 w; w.x = cvtpk(a, b); w.y = cvtpk(c, d);
  *(u32x2*)(wb + t * 128 + ((q ^ ((t & 7) << 1)) << 3)) = w;
}
__device__ __forceinline__ void stage_flush(const char* wb, bf16_t* dst, int ld, int lane) {
#pragma unroll
  for (int i = 0; i < 8; ++i) {
    const int row = i * 8 + (lane >> 3), c = lane & 7;
    const u32x4 v = *(const u32x4*)(wb + row * 128 + ((c ^ (row & 7)) << 4));
    *(u32x4*)(dst + (size_t)row * ld + c * 8) = v;
  }
}
__device__ __forceinline__ void stage_flush_add(const char* wb, bf16_t* dst, int ld, int lane) {
#pragma unroll
  for (int i = 0; i < 8; ++i) {
    const int row = i * 8 + (lane >> 3), c = lane & 7;
    const u32x4 v = *(const u32x4*)(wb + row * 128 + ((c ^ (row & 7)) << 4));
    u32x4* gp = (u32x4*)(dst + (size_t)row * ld + c * 8);
    const u32x4 o = *gp;
    u32x4 r;
    r.x = cvtpk(__uint_as_float(v.x << 16) + __uint_as_float(o.x << 16), __uint_as_float(v.x & 0xffff0000u) + __uint_as_float(o.x & 0xffff0000u));
    r.y = cvtpk(__uint_as_float(v.y << 16) + __uint_as_float(o.y << 16), __uint_as_float(v.y & 0xffff0000u) + __uint_as_float(o.y & 0xffff0000u));
    r.z = cvtpk(__uint_as_float(v.z << 16) + __uint_as_float(o.z << 16), __uint_as_float(v.z & 0xffff0000u) + __uint_as_float(o.z & 0xffff0000u));
    r.w = cvtpk(__uint_as_float(v.w << 16) + __uint_as_float(o.w << 16), __uint_as_float(v.w & 0xffff0000u) + __uint_as_float(o.w & 0xffff0000u));
    *gp = r;
  }
}
__device__ __forceinline__ void epi_rope64(const f32x16& a0, const f32x16& a1, int t, const float* __restrict__ gain, float ps,
                                           const float2* __restrict__ tabA, char* wb, int tl, int hi) {
  float ss = 0.f;
#pragma unroll
  for (int r = 0; r < 16; ++r) ss += a0[r] * a0[r] + a1[r] * a1[r];
  ss += __shfl_xor(ss, 32);
  const float rn = rsqrtf(ss * (1.0f / 64.0f) + EPS);
  const int prow = t >> 6, pcol = t & 63;
#pragma unroll
  for (int g = 0; g < 4; ++g) {
    const int f0 = 8 * (g & 1) + 4 * hi, pos = g < 2 ? prow : pcol, d = 8 * g + 4 * hi;
    const float4* tp = (const float4*)(tabA + pos * 16 + f0);
    const float4 t01 = tp[0], t23 = tp[1];
    const float4 g1 = *(const float4*)(gain + d), g2 = *(const float4*)(gain + 32 + d);
    const float x10 = a0[4 * g + 0] * rn * g1.x, x11 = a0[4 * g + 1] * rn * g1.y, x12 = a0[4 * g + 2] * rn * g1.z, x13 = a0[4 * g + 3] * rn * g1.w;
    const float x20 = a1[4 * g + 0] * rn * g2.x, x21 = a1[4 * g + 1] * rn * g2.y, x22 = a1[4 * g + 2] * rn * g2.z, x23 = a1[4 * g + 3] * rn * g2.w;
    stage_put(wb, tl, 2 * g + hi, (x10 * t01.x - x20 * t01.y) * ps, (x11 * t01.z - x21 * t01.w) * ps, (x12 * t23.x - x22 * t23.y) * ps, (x13 * t23.z - x23 * t23.w) * ps);
    stage_put(wb, tl, 8 + 2 * g + hi, (x20 * t01.x + x10 * t01.y) * ps, (x21 * t01.z + x11 * t01.w) * ps, (x22 * t23.x + x12 * t23.y) * ps, (x23 * t23.z + x13 * t23.w) * ps);
  }
}
__device__ __forceinline__ void rope32_vals(const f32x16& a, float mul, int t, const float2* __restrict__ tabB, int hi, int g, float (&o1)[4], float (&o2)[4]) {
  const int pos = g == 0 ? (t >> 6) : (t & 63);
  const float4* tp = (const float4*)(tabB + pos * 8 + 4 * hi);
  const float4 t01 = tp[0], t23 = tp[1];
  const float x10 = a[4 * g + 0] * mul, x11 = a[4 * g + 1] * mul, x12 = a[4 * g + 2] * mul, x13 = a[4 * g + 3] * mul;
  const float x20 = a[8 + 4 * g + 0] * mul, x21 = a[8 + 4 * g + 1] * mul, x22 = a[8 + 4 * g + 2] * mul, x23 = a[8 + 4 * g + 3] * mul;
  o1[0] = x10 * t01.x - x20 * t01.y; o1[1] = x11 * t01.z - x21 * t01.w; o1[2] = x12 * t23.x - x22 * t23.y; o1[3] = x13 * t23.z - x23 * t23.w;
  o2[0] = x20 * t01.x + x10 * t01.y; o2[1] = x21 * t01.z + x11 * t01.w; o2[2] = x22 * t23.x + x12 * t23.y; o2[3] = x23 * t23.z + x13 * t23.w;
}
__device__ __forceinline__ void epi_rope32(const f32x16& a, float mul, int t, const float2* __restrict__ tabB, char* wb, int tl, int qb, int hi) {
#pragma unroll
  for (int g = 0; g < 2; ++g) {
    float o1[4], o2[4];
    rope32_vals(a, mul, t, tabB, hi, g, o1, o2);
    stage_put(wb, tl, qb + 2 * g + hi, o1[0], o1[1], o1[2], o1[3]);
    stage_put(wb, tl, qb + 4 + 2 * g + hi, o2[0], o2[1], o2[2], o2[3]);
  }
}
__device__ __forceinline__ void epi_rope32_direct(const f32x16& a, float mul, int t, const float2* __restrict__ tabB, bf16_t* dst, int hi) {
#pragma unroll
  for (int g = 0; g < 2; ++g) {
    float o1[4], o2[4];
    rope32_vals(a, mul, t, tabB, hi, g, o1, o2);
    st4(dst + 8 * g + 4 * hi, o1[0], o1[1], o1[2], o1[3]);
    st4(dst + 16 + 8 * g + 4 * hi, o2[0], o2[1], o2[2], o2[3]);
  }
}
__device__ __forceinline__ void epi_plain32(const f32x16& a, float mul, char* wb, int tl, int qb, int hi) {
#pragma unroll
  for (int g = 0; g < 4; ++g) stage_put(wb, tl, qb + 2 * g + hi, a[4 * g] * mul, a[4 * g + 1] * mul, a[4 * g + 2] * mul, a[4 * g + 3] * mul);
}
__device__ __forceinline__ void epi_silu32(const f32x16& a, char* wb, int tl, int qb, int hi) {
#pragma unroll
  for (int g = 0; g < 4; ++g)
    stage_put(wb, tl, qb + 2 * g + hi, a[4 * g] * sigmoidf_(a[4 * g]), a[4 * g + 1] * sigmoidf_(a[4 * g + 1]), a[4 * g + 2] * sigmoidf_(a[4 * g + 2]),
              a[4 * g + 3] * sigmoidf_(a[4 * g + 3]));
}
__device__ __forceinline__ float sumsq16(const f32x16& a) {
  float s = 0.f;
#pragma unroll
  for (int r = 0; r < 16; ++r) s += a[r] * a[r];
  return s;
}

struct TileIter {
  int q, step, end, NT, mbase; bool xcd;
  __device__ __forceinline__ TileIter(int nt_count) {
    NT = nt_count; xcd = (gridDim.x == 256);
    if (xcd) { q = blockIdx.x >> 3; step = 32; end = 16 * NT; mbase = (blockIdx.x & 7) * 16; }
    else { q = blockIdx.x; step = gridDim.x; end = 128 * NT; mbase = 0; }
  }
  __device__ __forceinline__ bool next(int& mt, int& nt) { if (q >= end) return false; mt = mbase + q / NT; nt = q % NT; q += step; return true; }
};

__device__ __forceinline__ void bound_max(float* dst, float v) {
#pragma unroll
  for (int o = 32; o >= 1; o >>= 1) v = fmaxf(v, __shfl_xor(v, o));
  if ((threadIdx.x & 63) == 0) atomicMax((unsigned*)dst, __float_as_uint(v));
}
__device__ __forceinline__ void phase_g1(const Params& p, char* lds) {
  const int tid = opaque_tid(), wid = __builtin_amdgcn_readfirstlane(tid >> 6), lane = tid & 63, r32 = lane & 31, hi = lane >> 5, wm = wid & 3, wn = wid >> 2;
  const bf16_t* H = (const bf16_t*)(p.ws + OFF_H);
  const bf16_t* WIN = (const bf16_t*)(p.ws + OFF_WIN);
  const float2* tabA = (const float2*)(p.ws + OFF_TABA);
  const float2* tabB = (const float2*)(p.ws + OFF_TABB);
  float* part = (float*)(p.ws + OFF_PART);
  char* dout = (char*)p.out;
  float bmax_kr = 0.f;
  TileIter it(20); int mt, nt;
  while (it.next(mt, nt)) {
    const int m0 = mt * 256;
    f32x16 acc[2][2];
    zero_acc(acc);
    gemm_kloop(H + (size_t)m0 * DM, DM, WIN + (size_t)nt * 128 * DM, DM, 16, acc, lds);
    char* wb = lds + wid * 8192;
    const int tok0 = m0 + wm * 64;
#pragma unroll
    for (int ti = 0; ti < 2; ++ti) {
      const int tl = ti * 32 + r32, tok = tok0 + tl;
      const int t = pos_of(tok);
      if (nt < 4) {
        epi_rope64(acc[0][ti], acc[1][ti], t, p.a_q_g, PS_A, tabA, wb, tl, hi);
      } else if (nt == 4) {
        epi_rope64(acc[0][ti], acc[1][ti], t, p.a_k_g, 1.0f, tabA, wb, tl, hi);
      } else if (nt == 5) {
        epi_plain32(acc[0][ti], 1.0f, wb, tl, 0, hi); epi_plain32(acc[1][ti], 1.0f, wb, tl, 8, hi);
      } else if (nt < 9) {
        epi_plain32(acc[0][ti], 1.0f, wb, tl, 0, hi); epi_plain32(acc[1][ti], 1.0f, wb, tl, 8, hi);
        float s = sumsq16(acc[0][ti]) + sumsq16(acc[1][ti]); s += __shfl_xor(s, 32);
        if (hi == 0) part[((nt - 6) * 2 + wn) * T + tok] = s;
      } else if (nt < 11) {
        epi_plain32(acc[0][ti], 1.0f, wb, tl, 0, hi); epi_plain32(acc[1][ti], 1.0f, wb, tl, 8, hi);
        float s = sumsq16(acc[0][ti]) + sumsq16(acc[1][ti]); s += __shfl_xor(s, 32);
        if (hi == 0) part[(6 + (nt - 9) * 2 + wn) * T + tok] = s;
      } else if (nt == 11) {
        if (wn == 0) {
          epi_rope32_direct(acc[0][ti], 1.0f, t, tabB, (bf16_t*)(p.ws + OFF_KR) + (size_t)tok * 32, hi);
          float s = sumsq16(acc[0][ti]); s += __shfl_xor(s, 32);
          bmax_kr = fmaxf(bmax_kr, s);
        }
      } else {
        epi_silu32(acc[0][ti], wb, tl, 0, hi); epi_silu32(acc[1][ti], wb, tl, 8, hi);
      }
    }
    if (nt != 11) {
      bf16_t* dst; int ld;
      if (nt < 4) { dst = (bf16_t*)(p.ws + OFF_QA) + (size_t)tok0 * 512 + (nt * 2 + wn) * 64; ld = 512; }
      else if (nt == 4) { dst = (bf16_t*)(p.ws + OFF_KA) + (size_t)tok0 * 128 + wn * 64; ld = 128; }
      else if (nt == 5) { dst = (bf16_t*)(p.ws + OFF_VA) + (size_t)tok0 * 128 + wn * 64; ld = 128; }
      else if (nt < 9) { dst = (bf16_t*)(dout + OO_BQ) + (size_t)tok0 * 384 + (nt - 6) * 128 + wn * 64; ld = 384; }
      else if (nt < 11) { dst = (bf16_t*)(dout + OO_BKV) + (size_t)tok0 * 256 + (nt - 9) * 128 + wn * 64; ld = 256; }
      else if (nt < 16) { dst = (bf16_t*)(dout + OO_GA) + (size_t)tok0 * 512 + (nt - 12) * 128 + wn * 64; ld = 512; }
      else { dst = (bf16_t*)(dout + OO_GB) + (size_t)tok0 * 512 + (nt - 16) * 128 + wn * 64; ld = 512; }
      stage_flush(wb, dst, ld, lane);
    }
  }
  bound_max((float*)(p.ws + OFF_BND) + 3, bmax_kr);
}

__device__ __forceinline__ void phase_g2(const Params& p, char* lds) {
  const int tid = opaque_tid(), wid = __builtin_amdgcn_readfirstlane(tid >> 6), lane = tid & 63, r32 = lane & 31, hi = lane >> 5, wm = wid & 3, wn = wid >> 2;
  const float2* tabB = (const float2*)(p.ws + OFF_TABB);
  const float* part = (const float*)(p.ws + OFF_PART);
  char* dout = (char*)p.out;
  float bmax_q = 0.f, bmax_k = 0.f;
  TileIter it(14); int mt, j;
  while (it.next(mt, j)) {
    const int m0 = mt * 256;
    f32x16 acc[2][2];
    zero_acc(acc);
    char* wb = lds + wid * 8192;
    const int tok0 = m0 + wm * 64;
    if (j < 6) {
      gemm_kloop((const bf16_t*)(dout + OO_BQ) + (size_t)m0 * 384, 384, (const bf16_t*)(p.ws + OFF_WQUP) + (size_t)j * 128 * 384, 384, 6, acc, lds);
#pragma unroll
      for (int ti = 0; ti < 2; ++ti) {
        const int tl = ti * 32 + r32, tok = tok0 + tl;
        const int t = pos_of(tok);
        const float sq = (part[tok] + part[T + tok]) + (part[2 * T + tok] + part[3 * T + tok]) + (part[4 * T + tok] + part[5 * T + tok]);
        const float rn = rsqrtf(sq * (1.0f / 384.0f) + EPS) * PS_B;
#pragma unroll
        for (int fi = 0; fi < 2; ++fi) {
          const int blk = j * 4 + wn * 2 + fi;
          if (blk % 3 == 2) epi_rope32(acc[fi][ti], rn, t, tabB, wb, tl, fi * 8, hi);
          else epi_plain32(acc[fi][ti], rn, wb, tl, fi * 8, hi);
          float s = sumsq16(acc[fi][ti]); s += __shfl_xor(s, 32);
          bmax_q = fmaxf(bmax_q, s * rn * rn);
        }
      }
      stage_flush(wb, (bf16_t*)(p.ws + OFF_QB) + (size_t)tok0 * 768 + (j * 4 + wn * 2) * 32, 768, lane);
    } else {
      const int jn = j - 6;
      gemm_kloop((const bf16_t*)(dout + OO_BKV) + (size_t)m0 * 256, 256, (const bf16_t*)(p.ws + OFF_WKVUP) + (size_t)jn * 128 * 256, 256, 4, acc, lds);
#pragma unroll
      for (int ti = 0; ti < 2; ++ti) {
        const int tl = ti * 32 + r32, tok = tok0 + tl;
        const float sk = (part[6 * T + tok] + part[7 * T + tok]) + (part[8 * T + tok] + part[9 * T + tok]);
        const float rn = rsqrtf(sk * (1.0f / 256.0f) + EPS);
        epi_plain32(acc[0][ti], rn, wb, tl, 0, hi); epi_plain32(acc[1][ti], rn, wb, tl, 8, hi);
        if (wn == 0) {
          float s0 = sumsq16(acc[0][ti]), s1 = sumsq16(acc[1][ti]); s0 += __shfl_xor(s0, 32); s1 += __shfl_xor(s1, 32);
          bmax_k = fmaxf(bmax_k, fmaxf(s0, s1) * rn * rn);
        }
      }
      stage_flush(wb, (bf16_t*)(p.ws + (wn == 0 ? OFF_KBN : OFF_VB)) + (size_t)tok0 * 512 + jn * 64, 512, lane);
    }
  }
  bound_max((float*)(p.ws + OFF_BND) + 1, bmax_q);
  bound_max((float*)(p.ws + OFF_BND) + 2, bmax_k);
}

__device__ __forceinline__ void phase_g3(const Params& p, char* lds) {
  const int tid = opaque_tid(), wid = __builtin_amdgcn_readfirstlane(tid >> 6), lane = tid & 63, r32 = lane & 31, hi = lane >> 5, wm = wid & 3, wn = wid >> 2;
  char* dout = (char*)p.out;
  const bf16_t* H = (const bf16_t*)(p.ws + OFF_H);
  const bf16_t* WIN = (const bf16_t*)(p.ws + OFF_WIN);
  bf16_t* MG = (bf16_t*)(dout + OO_MERGED);
  TileIter it(8); int mt, nt;
  while (it.next(mt, nt)) {
    const int m0 = mt * 256;
#pragma nounroll
    for (int s = 0; s < 2; ++s) {
      f32x16 acc[2][2];
      zero_acc(acc);
      const bf16_t* Y = s == 0 ? (const bf16_t*)(p.ws + OFF_QA) : (const bf16_t*)(dout + OO_YB);
      const bf16_t* WOUT = (const bf16_t*)(p.ws + (s == 0 ? OFF_WAOUT : OFF_WBOUT));
      gemm_kloop(H + (size_t)m0 * DM, DM, WIN + (size_t)(2560 + s * 1024 + nt * 128) * DM, DM, 16, acc, lds);
      unsigned* gl = (unsigned*)(lds + 2 * G_STAGE) + tid;
#pragma unroll
      for (int fi = 0; fi < 2; ++fi)
#pragma unroll
        for (int ti = 0; ti < 2; ++ti)
#pragma unroll
          for (int q = 0; q < 8; ++q) gl[((fi * 2 + ti) * 8 + q) * 512] = cvtpk(sigmoidf_(acc[fi][ti][2 * q]), sigmoidf_(acc[fi][ti][2 * q + 1]));
      zero_acc(acc);
      gemm_kloop(Y + (size_t)m0 * 512, 512, WOUT + (size_t)nt * 128 * 512, 512, 8, acc, lds);
      char* wb = lds + wid * 8192;
#pragma unroll
      for (int ti = 0; ti < 2; ++ti) {
        const int tl = ti * 32 + r32;
#pragma unroll
        for (int fi = 0; fi < 2; ++fi) {
#pragma unroll
          for (int g = 0; g < 4; ++g) {
            const unsigned g01 = gl[((fi * 2 + ti) * 8 + 2 * g) * 512], g23 = gl[((fi * 2 + ti) * 8 + 2 * g + 1) * 512];
            stage_put(wb, tl, fi * 8 + 2 * g + hi, __uint_as_float(g01 << 16) * acc[fi][ti][4 * g], __uint_as_float(g01 & 0xffff0000u) * acc[fi][ti][4 * g + 1],
                      __uint_as_float(g23 << 16) * acc[fi][ti][4 * g + 2], __uint_as_float(g23 & 0xffff0000u) * acc[fi][ti][4 * g + 3]);
          }
        }
      }
      bf16_t* dst = MG + (size_t)(m0 + wm * 64) * DM + nt * 128 + wn * 64;
      if (s == 0) stage_flush(wb, dst, DM, lane); else stage_flush_add(wb, dst, DM, lane);
    }
  }
}

__device__ __forceinline__ void phase_g4(const Params& p, char* lds) {
  const int tid = opaque_tid(), wid = __builtin_amdgcn_readfirstlane(tid >> 6), lane = tid & 63, r32 = lane & 31, hi = lane >> 5, wm = wid & 3, wn = wid >> 2;
  char* dout = (char*)p.out;
  const bf16_t* MG = (const bf16_t*)(dout + OO_MERGED);
  bf16_t* Z = (bf16_t*)(p.ws + OFF_H);
  float* part = (float*)(p.ws + OFF_PART) + 10 * T;
  TileIter it(8); int mt, nt;
  while (it.next(mt, nt)) {
    const int m0 = mt * 256;
    f32x16 acc[2][2];
    zero_acc(acc);
    gemm_kloop(MG + (size_t)m0 * DM, DM, (const bf16_t*)(p.ws + OFF_WO) + (size_t)nt * 128 * DM, DM, 16, acc, lds);
    char* wb = lds + wid * 8192;
    const int tok0 = m0 + wm * 64;
#pragma unroll
    for (int ti = 0; ti < 2; ++ti) {
      const int tl = ti * 32 + r32, tok = tok0 + tl;
      epi_plain32(acc[0][ti], 1.0f, wb, tl, 0, hi); epi_plain32(acc[1][ti], 1.0f, wb, tl, 8, hi);
      float s = sumsq16(acc[0][ti]) + sumsq16(acc[1][ti]); s += __shfl_xor(s, 32);
      if (hi == 0) part[(nt * 2 + wn) * T + tok] = s;
    }
    stage_flush(wb, Z + (size_t)tok0 * DM + nt * 128 + wn * 64, DM, lane);
  }
}

__device__ __forceinline__ void phase5(const Params& p) {
  const int tid = opaque_tid(), wid = tid >> 6, lane = tid & 63;
  const float* mod = (const float*)(p.ws + OFF_MOD);
  const bf16_t* Z = (const bf16_t*)(p.ws + OFF_H);
  const float* part = (const float*)(p.ws + OFF_PART) + 10 * T;
  for (int row = blockIdx.x * 8 + wid; row < T; row += gridDim.x * 8) {
    const float* xr = xrow_ptr(p, row);
    const int b = batch_of(row);
    const float sz = wave_sum(lane < 16 ? part[lane * T + row] : 0.f);
    const float rn = rsqrtf(sz * (1.0f / 1024.0f) + EPS);
    float* o = p.out + (size_t)row * DM;
#pragma unroll
    for (int i = 0; i < 4; ++i) {
      const int col = i * 256 + lane * 4;
      const float4 xv = *(const float4*)(xr + col);
      const u32x2 zz = *(const u32x2*)(Z + (size_t)row * DM + col);
      const float4 g = *(const float4*)(p.post_g + col);
      const float4 gt = *(const float4*)(mod + b * 3072 + 2048 + col);
      float4 r;
      r.x = xv.x + gt.x * (__uint_as_float(zz.x << 16) * rn * g.x);
      r.y = xv.y + gt.y * (__uint_as_float(zz.x & 0xffff0000u) * rn * g.y);
      r.z = xv.z + gt.z * (__uint_as_float(zz.y << 16) * rn * g.z);
      r.w = xv.w + gt.w * (__uint_as_float(zz.y & 0xffff0000u) * rn * g.w);
      *(float4*)(o + col) = r;
    }
  }
}

#define SBAR() __builtin_amdgcn_sched_barrier(0)
constexpr float ATT_THR = 8.0f;
constexpr int SHM_V = 64 * 64 * 2;
template <int DK> struct KL { static constexpr int RB = DK == 64 ? 128 : 256; static constexpr int SHM_K = 64 * RB; };
template <int DK> __device__ __forceinline__ int kswz(int row, int c) {
  if (DK == 64) return row * 128 + ((c ^ ((row >> 1) & 7)) << 4);
  return row * 256 + ((c ^ (row & 15)) << 4);
}
__device__ __forceinline__ int v_st(int k, int c) {
  const int kk = (k & ~0xC) | ((k & 4) << 1) | ((k & 8) >> 1);
  return ((kk >> 3) * 2 + (c >> 5)) * 512 + ((kk & 7) * 32 + (c & 31)) * 2;
}
__device__ __forceinline__ int v_rd_base(int lane) { return ((lane & 3) << 3) | (((lane >> 2) & 3) << 6) | (((lane >> 4) & 1) << 5) | (((lane >> 5) & 1) << 8); }
constexpr int v_rd_off(int d0, int ks, int half) { return d0 * 512 + ks * 2048 + half * 1024; }
template <int OFF> __device__ __forceinline__ s16x4 tr_read(int vb) {
  s16x4 r; asm volatile("ds_read_b64_tr_b16 %0, %1 offset:%2" : "=&v"(r) : "v"(vb), "i"(OFF) : "memory"); return r;
}
template <int D0> __device__ __forceinline__ void pv_one(f32x16& od, int vb, bf16x8 pa0, bf16x8 pa1, bf16x8 pa2, bf16x8 pa3) {
  const s16x4 l0 = tr_read<v_rd_off(D0, 0, 0)>(vb), h0 = tr_read<v_rd_off(D0, 0, 1)>(vb), l1 = tr_read<v_rd_off(D0, 1, 0)>(vb), h1 = tr_read<v_rd_off(D0, 1, 1)>(vb);
  const s16x4 l2 = tr_read<v_rd_off(D0, 2, 0)>(vb), h2 = tr_read<v_rd_off(D0, 2, 1)>(vb), l3 = tr_read<v_rd_off(D0, 3, 0)>(vb), h3 = tr_read<v_rd_off(D0, 3, 1)>(vb);
  asm volatile("s_waitcnt lgkmcnt(0)" ::: "memory"); SBAR();
#define PK(L, Hh) (bf16x8){L[0], L[1], L[2], L[3], Hh[0], Hh[1], Hh[2], Hh[3]}
  od = __builtin_amdgcn_mfma_f32_32x32x16_bf16(pa0, PK(l0, h0), od, 0, 0, 0);
  od = __builtin_amdgcn_mfma_f32_32x32x16_bf16(pa1, PK(l1, h1), od, 0, 0, 0);
  od = __builtin_amdgcn_mfma_f32_32x32x16_bf16(pa2, PK(l2, h2), od, 0, 0, 0);
  od = __builtin_amdgcn_mfma_f32_32x32x16_bf16(pa3, PK(l3, h3), od, 0, 0, 0);
#undef PK
}
__device__ __forceinline__ void pv_all(f32x16* o, int vb, bf16x8 pa0, bf16x8 pa1, bf16x8 pa2, bf16x8 pa3) {
  pv_one<0>(o[0], vb, pa0, pa1, pa2, pa3); pv_one<1>(o[1], vb, pa0, pa1, pa2, pa3);
}
__device__ __forceinline__ void partialSM(f32x16& p0, f32x16& p1, float& m_reg, float& alpha) {
  float pmax = p0[0];
#pragma unroll
  for (int r = 1; r < 16; ++r) pmax = fmaxf(pmax, p0[r]);
#pragma unroll
  for (int r = 0; r < 16; ++r) pmax = fmaxf(pmax, p1[r]);
  { auto rr = __builtin_amdgcn_permlane32_swap(__float_as_uint(pmax), __float_as_uint(pmax), false, false);
    pmax = fmaxf(__uint_as_float(rr[0]), __uint_as_float(rr[1])); }
  float mn;
  if (__builtin_expect(__all(pmax - m_reg <= ATT_THR), 1)) { mn = m_reg; alpha = 1.f; }
  else { mn = fmaxf(m_reg, pmax); alpha = __builtin_amdgcn_exp2f(m_reg - mn); m_reg = mn; }
#pragma unroll
  for (int r = 0; r < 16; ++r) p0[r] -= mn;
#pragma unroll
  for (int r = 0; r < 16; ++r) p1[r] -= mn;
#pragma unroll
  for (int r = 0; r < 16; ++r) p0[r] = __builtin_amdgcn_exp2f(p0[r]);
}
__device__ __forceinline__ void finishSM(f32x16& p0, f32x16& p1, float alpha, float& l_reg, bf16x8& pa0, bf16x8& pa1, bf16x8& pa2, bf16x8& pa3) {
#pragma unroll
  for (int r = 0; r < 16; ++r) p1[r] = __builtin_amdgcn_exp2f(p1[r]);
  float ps = 0.f;
#pragma unroll
  for (int r = 0; r < 16; ++r) ps += p0[r];
#pragma unroll
  for (int r = 0; r < 16; ++r) ps += p1[r];
  { auto rr = __builtin_amdgcn_permlane32_swap(__float_as_uint(ps), __float_as_uint(ps), false, false);
    ps = __uint_as_float(rr[0]) + __uint_as_float(rr[1]); }
  l_reg = l_reg * alpha + ps;
#define PK4(P, BASE, OUT) do { unsigned a0 = cvtpk(P[BASE + 0], P[BASE + 1]), a1 = cvtpk(P[BASE + 2], P[BASE + 3]);   \
    unsigned b0 = cvtpk(P[BASE + 4], P[BASE + 5]), b1 = cvtpk(P[BASE + 6], P[BASE + 7]);                              \
    auto r0 = __builtin_amdgcn_permlane32_swap(a0, b0, false, false); auto r1 = __builtin_amdgcn_permlane32_swap(a1, b1, false, false); \
    u32x4 w = {r0[0], r1[0], r0[1], r1[1]}; OUT = *reinterpret_cast<bf16x8*>(&w); } while (0)
  PK4(p0, 0, pa0); PK4(p0, 8, pa1); PK4(p1, 0, pa2); PK4(p1, 8, pa3);
#undef PK4
}
template <int DK> __device__ __forceinline__ void qkt(f32x16& p0, f32x16& p1, const char* Ks, const bf16x8* qr, int r32, int hi) {
#pragma unroll
  for (int r = 0; r < 16; ++r) { p0[r] = 0.f; p1[r] = 0.f; }
#pragma unroll
  for (int d0 = 0; d0 < DK / 16; ++d0) {
    const int off = kswz<DK>(r32, 2 * d0 + hi);
    const bf16x8 b0 = *reinterpret_cast<const bf16x8*>(Ks + off);
    const bf16x8 b1 = *reinterpret_cast<const bf16x8*>(Ks + off + 32 * KL<DK>::RB);
    p0 = __builtin_amdgcn_mfma_f32_32x32x16_bf16(b0, qr[d0], p0, 0, 0, 0);
    p1 = __builtin_amdgcn_mfma_f32_32x32x16_bf16(b1, qr[d0], p1, 0, 0, 0);
    if (QKT_SB && (d0 & 1) == 1 && d0 + 1 < DK / 16) SBAR();
  }
}

template <int DK>
__device__ __forceinline__ void attn_unit(const bf16_t* Qb, int ldq, const bf16_t* __restrict__ Kh, int ldk, const bf16_t* __restrict__ Krp,
                                          const bf16_t* __restrict__ Vh, int ldv, const bf16_t* Gb, bf16_t* Ob, int seq, char* lds) {
  constexpr int SHM_K = KL<DK>::SHM_K;
  const int tid = opaque_tid(), wid = __builtin_amdgcn_readfirstlane(tid >> 6), lane = tid & 63, r32 = lane & 31, hi = lane >> 5;
  char* V_lds = lds; char* K_lds = lds + 2 * SHM_V;
  float* ws = (float*)(lds + 2 * SHM_V + 2 * SHM_K) + wid * 64; float* li_l = ws; float* al_l = ws + 32;
  float m_reg = -1e30f, l_reg = 0.f; f32x16 o[2]; bf16x8 qr[DK / 16];
#pragma unroll
  for (int r = 0; r < 16; ++r) { o[0][r] = 0.f; o[1][r] = 0.f; }
  const bf16_t* Qw = Qb + (size_t)(wid * 32 + r32) * ldq + hi * 8;
#pragma unroll
  for (int d0 = 0; d0 < DK / 16; ++d0) qr[d0] = *reinterpret_cast<const bf16x8*>(Qw + d0 * 16);
  const int srow = tid >> 3, sc = tid & 7, vst = v_st(srow, sc * 8), kst = kswz<DK>(srow, sc);
  const int rrow = tid >> 2, rc = tid & 3, krst = kswz<DK>(rrow & 63, 8 + rc);
  const bool dor = (DK == 96) && (wid < 4);
  const int vb0 = (int)(uintptr_t)V_lds + v_rd_base(lane);
  struct { u32x4 v, k, r; } sr_[1];
  const unsigned voff0 = (unsigned)(srow * ldv + sc * 8) * 2u, koff0 = (unsigned)(srow * ldk + sc * 8) * 2u, roff0 = (unsigned)(rrow * 32 + rc * 8) * 2u;
#define SLOAD(i, k0) do { sr_[i].v = *(const u32x4*)((const char*)Vh + (voff0 + (unsigned)((k0) * ldv) * 2u)); sr_[i].k = *(const u32x4*)((const char*)Kh + (koff0 + (unsigned)((k0) * ldk) * 2u)); \
    if (dor) sr_[i].r = *(const u32x4*)((const char*)Krp + (roff0 + (unsigned)((k0) * 64))); } while (0)
#define SWRITE(b, i) do { *(u32x4*)(V_lds + (b) * SHM_V + vst) = sr_[i].v; *(u32x4*)(K_lds + (b) * SHM_K + kst) = sr_[i].k; \
    if (dor) *(u32x4*)(K_lds + (b) * SHM_K + krst) = sr_[i].r; } while (0)
#define RESC(a) do { if (__any((a) < 1.f)) { if (hi == 0) al_l[r32] = (a); asm volatile("s_waitcnt lgkmcnt(0)" ::: "memory"); \
    _Pragma("unroll") for (int d = 0; d < 2; ++d) _Pragma("unroll") for (int r = 0; r < 16; ++r) o[d][r] *= al_l[crow(r, hi)]; } } while (0)
  f32x16 pA0, pA1, pB0, pB1; float alA, alB; bf16x8 pa0, pa1, pa2, pa3; const int NT = seq / 64;
  __syncthreads();
  SLOAD(0, 0); SWRITE(0, 0); __syncthreads();
  qkt<DK>(pA0, pA1, K_lds, qr, r32, hi); partialSM(pA0, pA1, m_reg, alA);
  SLOAD(0, 64);
  SWRITE(1, 0); __syncthreads();
  for (int j = 1; j + 1 < NT; j += 2) {
    SBAR(); qkt<DK>(pB0, pB1, K_lds + SHM_K, qr, r32, hi);
    finishSM(pA0, pA1, alA, l_reg, pa0, pa1, pa2, pa3); SBAR();
    SLOAD(0, (j + 1) * 64); SBAR();
    pv_all(o, vb0, pa0, pa1, pa2, pa3); partialSM(pB0, pB1, m_reg, alB);
    __syncthreads(); SWRITE(0, 0);
    RESC(alB); __syncthreads();
    SBAR(); qkt<DK>(pA0, pA1, K_lds, qr, r32, hi);
    finishSM(pB0, pB1, alB, l_reg, pa0, pa1, pa2, pa3); SBAR();
    SLOAD(0, (j + 2) * 64); SBAR();
    pv_all(o, vb0 + SHM_V, pa0, pa1, pa2, pa3); partialSM(pA0, pA1, m_reg, alA);
    __syncthreads(); SWRITE(1, 0);
    RESC(alA); __syncthreads();
  }
  SBAR(); qkt<DK>(pB0, pB1, K_lds + SHM_K, qr, r32, hi);
  finishSM(pA0, pA1, alA, l_reg, pa0, pa1, pa2, pa3); SBAR();
  pv_all(o, vb0, pa0, pa1, pa2, pa3); partialSM(pB0, pB1, m_reg, alB);
  __syncthreads(); RESC(alB);
  finishSM(pB0, pB1, alB, l_reg, pa0, pa1, pa2, pa3); SBAR();
  pv_all(o, vb0 + SHM_V, pa0, pa1, pa2, pa3);
  if (hi == 0) li_l[r32] = l_reg; asm volatile("s_waitcnt lgkmcnt(0)" ::: "memory");
  float rli[16];
#pragma unroll
  for (int r = 0; r < 16; ++r) rli[r] = __builtin_amdgcn_rcpf(li_l[crow(r, hi)]);
#pragma unroll
  for (int r = 0; r < 16; ++r) {
    const size_t rowo = (size_t)(wid * 32 + crow(r, hi)) * 512;
#pragma unroll
    for (int d0 = 0; d0 < 2; ++d0) {
      const size_t idx = rowo + d0 * 32 + r32;
      const float g = bf2f(Gb[idx]);
      Ob[idx] = (bf16_t)(cvtpk(o[d0][r] * rli[r] * g, 0.f) & 0xffffu);
    }
  }
#undef SLOAD
#undef SWRITE
#undef RESC
}

__device__ __forceinline__ void exp16(f32x16& p) {
#pragma unroll
  for (int r = 0; r < 16; ++r) p[r] = __builtin_amdgcn_exp2f(p[r]);
}
__device__ __forceinline__ void finishFast(f32x16& p0, f32x16& p1, float& l_reg, bf16x8& pa0, bf16x8& pa1, bf16x8& pa2, bf16x8& pa3) {
  exp16(p1);
  float ps = 0.f;
#pragma unroll
  for (int r = 0; r < 16; ++r) ps += p0[r];
#pragma unroll
  for (int r = 0; r < 16; ++r) ps += p1[r];
  l_reg += ps;
#define PK4(P, BASE, OUT) do { unsigned a0 = cvtpk(P[BASE + 0], P[BASE + 1]), a1 = cvtpk(P[BASE + 2], P[BASE + 3]);   \
    unsigned b0 = cvtpk(P[BASE + 4], P[BASE + 5]), b1 = cvtpk(P[BASE + 6], P[BASE + 7]);                              \
    auto r0 = __builtin_amdgcn_permlane32_swap(a0, b0, false, false); auto r1 = __builtin_amdgcn_permlane32_swap(a1, b1, false, false); \
    u32x4 w = {r0[0], r1[0], r0[1], r1[1]}; OUT = *reinterpret_cast<bf16x8*>(&w); } while (0)
  PK4(p0, 0, pa0); PK4(p0, 8, pa1); PK4(p1, 0, pa2); PK4(p1, 8, pa3);
#undef PK4
}
template <int DK>
__device__ __forceinline__ void attn_unit_fast(const bf16_t* Qb, int ldq, const bf16_t* __restrict__ Kh, int ldk, const bf16_t* __restrict__ Krp,
                                               const bf16_t* __restrict__ Vh, int ldv, const bf16_t* Gb, bf16_t* Ob, int seq, char* lds) {
  constexpr int SHM_K = KL<DK>::SHM_K;
  const int tid = opaque_tid(), wid = __builtin_amdgcn_readfirstlane(tid >> 6), lane = tid & 63, r32 = lane & 31, hi = lane >> 5;
  char* V_lds = lds; char* K_lds = lds + 3 * SHM_V;
  float* ws = (float*)(lds + 3 * SHM_V + 3 * SHM_K) + wid * 64; float* li_l = ws;
  float l_reg = 0.f; f32x16 o[2]; bf16x8 qr[DK / 16];
#pragma unroll
  for (int r = 0; r < 16; ++r) { o[0][r] = 0.f; o[1][r] = 0.f; }
  const bf16_t* Qw = Qb + (size_t)(wid * 32 + r32) * ldq + hi * 8;
#pragma unroll
  for (int d0 = 0; d0 < DK / 16; ++d0) qr[d0] = *reinterpret_cast<const bf16x8*>(Qw + d0 * 16);
  const int srow = tid >> 3, sc = tid & 7, vst = v_st(srow, sc * 8), kst = kswz<DK>(srow, sc);
  const int rrow = tid >> 2, rc = tid & 3, krst = kswz<DK>(rrow & 63, 8 + rc);
  const bool dor = (DK == 96) && (wid < 4);
  const int vb0 = (int)(uintptr_t)V_lds + v_rd_base(lane);
  struct { u32x4 v, k, r; } sr_[1];
  const unsigned voff0 = (unsigned)(srow * ldv + sc * 8) * 2u, koff0 = (unsigned)(srow * ldk + sc * 8) * 2u, roff0 = (unsigned)(rrow * 32 + rc * 8) * 2u;
#define SLOAD(i, k0) do { sr_[i].v = *(const u32x4*)((const char*)Vh + (voff0 + (unsigned)((k0) * ldv) * 2u)); sr_[i].k = *(const u32x4*)((const char*)Kh + (koff0 + (unsigned)((k0) * ldk) * 2u)); \
    if (dor) sr_[i].r = *(const u32x4*)((const char*)Krp + (roff0 + (unsigned)((k0) * 64))); } while (0)
#define SWRITE(slot, i) do { *(u32x4*)(V_lds + (slot) * SHM_V + vst) = sr_[i].v; *(u32x4*)(K_lds + (slot) * SHM_K + kst) = sr_[i].k; \
    if (dor) *(u32x4*)(K_lds + (slot) * SHM_K + krst) = sr_[i].r; } while (0)
  f32x16 pA0, pA1, pB0, pB1; bf16x8 pa0, pa1, pa2, pa3; const int NT = seq / 64;
  int sp = 2, st = 0, sn = 1;
#define ROT() do { sp = st; st = sn; sn = (sn == 2) ? 0 : sn + 1; } while (0)
#define STEP(C0, C1, P0, P1, SETW, t, DOW) do { SBAR(); qkt<DK>(C0, C1, K_lds + st * SHM_K, qr, r32, hi); \
    finishFast(P0, P1, l_reg, pa0, pa1, pa2, pa3); SBAR(); \
    if (DOW) { SWRITE(sn, 0); if ((t) + 2 < NT) SLOAD(0, ((t) + 2) * 64); } SBAR(); \
    pv_all(o, vb0 + sp * SHM_V, pa0, pa1, pa2, pa3); exp16(C0); \
    __syncthreads(); ROT(); } while (0)
  __syncthreads();
  SLOAD(0, 0); SWRITE(0, 0); SLOAD(0, 64); __syncthreads();
  qkt<DK>(pA0, pA1, K_lds, qr, r32, hi);
  SWRITE(1, 0); SLOAD(0, 128);
  exp16(pA0);
  __syncthreads(); ROT();
  for (int t = 1; t + 1 < NT; t += 2) {
    STEP(pB0, pB1, pA0, pA1, 0, t, true);
    STEP(pA0, pA1, pB0, pB1, 1, t + 1, true);
  }
  STEP(pB0, pB1, pA0, pA1, 0, NT - 1, false);
  finishFast(pB0, pB1, l_reg, pa0, pa1, pa2, pa3); SBAR();
  pv_all(o, vb0 + sp * SHM_V, pa0, pa1, pa2, pa3);
  { auto rr = __builtin_amdgcn_permlane32_swap(__float_as_uint(l_reg), __float_as_uint(l_reg), false, false);
    l_reg = __uint_as_float(rr[0]) + __uint_as_float(rr[1]); }
  if (hi == 0) li_l[r32] = l_reg; asm volatile("s_waitcnt lgkmcnt(0)" ::: "memory");
  float rli[16];
#pragma unroll
  for (int r = 0; r < 16; ++r) rli[r] = __builtin_amdgcn_rcpf(li_l[crow(r, hi)]);
#pragma unroll
  for (int r = 0; r < 16; ++r) {
    const size_t rowo = (size_t)(wid * 32 + crow(r, hi)) * 512;
#pragma unroll
    for (int d0 = 0; d0 < 2; ++d0) {
      const size_t idx = rowo + d0 * 32 + r32;
      const float g = bf2f(Gb[idx]);
      Ob[idx] = (bf16_t)(cvtpk(o[d0][r] * rli[r] * g, 0.f) & 0xffffu);
    }
  }
#undef SLOAD
#undef SWRITE
#undef ROT
#undef STEP
}

__device__ __forceinline__ void phase_attn(const Params& p, char* lds) {
  char* dout = (char*)p.out;
  const float* bnd = (const float*)(p.ws + OFF_BND);
  const bool fastA = bnd[0] < 60.0f;
  const bool fastB = 3.0f * bnd[1] * (2.0f * bnd[2] + bnd[3]) < 3600.0f;
  for (int u = blockIdx.x; u < 2048; u += gridDim.x) {
    const int i = u >> 8, v = u & 255, cls = i >> 1, sub = i & 1, head = v & 7, j = v >> 3;
    int seq0, seq, tok0;
    if (cls < 2) { seq0 = 0; seq = NP; tok0 = (2 * j + sub) * 256; }
    else { const int bi = j >> 3, qb = 2 * (j & 7) + sub; seq0 = NP + bi * NS; seq = NS; tok0 = seq0 + qb * 256; }
    if ((cls & 1) == 0) {
      bf16_t* QA = (bf16_t*)(p.ws + OFF_QA);
      const bf16_t* Kp = (const bf16_t*)(p.ws + OFF_KA) + (size_t)seq0 * 128 + (head >> 2) * 64;
      const bf16_t* Vp = (const bf16_t*)(p.ws + OFF_VA) + (size_t)seq0 * 128 + (head >> 2) * 64;
      const bf16_t* Gp = (const bf16_t*)(dout + OO_GA) + (size_t)tok0 * 512 + head * 64;
      bf16_t* Qp = QA + (size_t)tok0 * 512 + head * 64;
      if (fastA) attn_unit_fast<64>(Qp, 512, Kp, 128, nullptr, Vp, 128, Gp, Qp, seq, lds);
      else if (ATT_SAFE) attn_unit<64>(Qp, 512, Kp, 128, nullptr, Vp, 128, Gp, Qp, seq, lds);
    } else {
      const bf16_t* Qp = (const bf16_t*)(p.ws + OFF_QB) + (size_t)tok0 * 768 + head * 96;
      const bf16_t* Kp = (const bf16_t*)(p.ws + OFF_KBN) + (size_t)seq0 * 512 + head * 64;
      const bf16_t* Rp = (const bf16_t*)(p.ws + OFF_KR) + (size_t)seq0 * 32;
      const bf16_t* Vp = (const bf16_t*)(p.ws + OFF_VB) + (size_t)seq0 * 512 + head * 64;
      const bf16_t* Gp = (const bf16_t*)(dout + OO_GB) + (size_t)tok0 * 512 + head * 64;
      bf16_t* Op = (bf16_t*)(dout + OO_YB) + (size_t)tok0 * 512 + head * 64;
      if (fastB) attn_unit_fast<96>(Qp, 768, Kp, 512, Rp, Vp, 512, Gp, Op, seq, lds);
      else if (ATT_SAFE) attn_unit<96>(Qp, 768, Kp, 512, Rp, Vp, 512, Gp, Op, seq, lds);
    }
  }
}

#if MK_SINGLE
#ifndef PROBE_MASK
#define PROBE_MASK 0
#endif
__global__ void __launch_bounds__(512) fwd_kernel(Params p) {
  extern __shared__ __attribute__((aligned(16))) char lds[];
#if PROBE_MASK
  volatile unsigned long long* tst = (volatile unsigned long long*)(p.ws + OFF_BND + 64) + blockIdx.x * 16;
  if (threadIdx.x == 0) tst[0] = wall_clock64();
#define STAMP(k) if (threadIdx.x == 0) tst[k + 1] = wall_clock64();
#else
#define STAMP(k)
#endif
#define PHASE(k, call) if (PH_MASK & (1 << k)) { call; if (k < 7) { cg::this_grid().sync(); STAMP(k) } }
  PHASE(0, phase0(p, lds))
  PHASE(1, phase1(p))
  PHASE(2, phase_g1(p, lds))
  PHASE(3, phase_g2(p, lds))
  PHASE(4, phase_attn(p, lds))
  PHASE(5, phase_g3(p, lds))
  PHASE(6, phase_g4(p, lds))
  PHASE(7, phase5(p))
#undef PHASE
#if PROBE_MASK
  if (blockIdx.x == 0) {
    __syncthreads();
    float* dshp = (float*)lds;
    if (threadIdx.x == 0) {
    unsigned long long tot = 0;
    for (int k = 0; k < 7; ++k) if (PROBE_MASK & (1 << k)) tot += tst[k + 1] - tst[k];
    dshp[0] = sqrtf((float)tot * (0.01f / 4000.0f));
    }
    __syncthreads();
    const float d = dshp[0];
    for (int i = threadIdx.x; i < 8 * 1024; i += 512) p.out[i] += d;
  }
#endif
}
#define MAIN_KERNEL fwd_kernel
#else
template <int PH>
__global__ void __launch_bounds__(512) ph_kernel(Params p) {
  extern __shared__ __attribute__((aligned(16))) char lds[];
  if (PH == 0) phase0(p, lds);
  if (PH == 1) phase1(p);
  if (PH == 2) phase_g1(p, lds);
  if (PH == 3) phase_g2(p, lds);
  if (PH == 4) phase_attn(p, lds);
  if (PH == 5) phase_g3(p, lds);
  if (PH == 6) phase_g4(p, lds);
  if (PH == 7) phase5(p);
}
#define MAIN_KERNEL ph_kernel<4>
#endif

extern "C" void kernel_launch(void* const* d_in, const int* in_sizes, int n_in, void* d_out, int out_size, void* d_ws, size_t ws_size,
                              hipStream_t stream) {
  Params p{};
  p.x_prompt = (const float*)d_in[0]; p.x_sample = (const float*)d_in[1]; p.c_prompt = (const float*)d_in[2]; p.c_sample = (const float*)d_in[3];
  p.ada_w = (const float*)d_in[4]; p.ada_b = (const float*)d_in[5]; p.pre_g = (const float*)d_in[6]; p.post_g = (const float*)d_in[7];
  p.w_in = (const float*)d_in[8]; p.a_q_g = (const float*)d_in[9]; p.a_k_g = (const float*)d_in[10]; p.b_q_g = (const float*)d_in[11];
  p.b_q_up = (const float*)d_in[12]; p.b_kv_g = (const float*)d_in[13]; p.b_kv_up = (const float*)d_in[14]; p.a_out = (const float*)d_in[15];
  p.b_out = (const float*)d_in[16]; p.w_o = (const float*)d_in[17];
  p.out = (float*)d_out; p.ws = (char*)d_ws;
  static int grid_blocks = 0;
  if (!grid_blocks) {
    int dev = 0, cus = 0, per_cu = 0;
    (void)hipGetDevice(&dev);
    (void)hipDeviceGetAttribute(&cus, hipDeviceAttributeMultiprocessorCount, dev);
    (void)hipFuncSetAttribute((const void*)MAIN_KERNEL, hipFuncAttributeMaxDynamicSharedMemorySize, LDS_BYTES);
    (void)hipOccupancyMaxActiveBlocksPerMultiprocessor(&per_cu, MAIN_KERNEL, 512, LDS_BYTES);
    if (per_cu < 1) per_cu = 1;
    if (per_cu > 1) per_cu = 1;
    grid_blocks = cus * per_cu;
    if (grid_blocks <= 0) grid_blocks = 256;
  }
#if MK_SINGLE
  void* args[] = {&p};
  hipError_t err = hipLaunchCooperativeKernel((const void*)fwd_kernel, dim3(grid_blocks), dim3(512), args, LDS_BYTES, stream);
  if (err != hipSuccess) fprintf(stderr, "cooperative launch failed: %s (grid %d)\n", hipGetErrorString(err), grid_blocks);
#else
  static bool attr_set = false;
  if (!attr_set) {
    (void)hipFuncSetAttribute((const void*)ph_kernel<0>, hipFuncAttributeMaxDynamicSharedMemorySize, LDS_BYTES);
    (void)hipFuncSetAttribute((const void*)ph_kernel<2>, hipFuncAttributeMaxDynamicSharedMemorySize, LDS_BYTES);
    (void)hipFuncSetAttribute((const void*)ph_kernel<3>, hipFuncAttributeMaxDynamicSharedMemorySize, LDS_BYTES);
    (void)hipFuncSetAttribute((const void*)ph_kernel<5>, hipFuncAttributeMaxDynamicSharedMemorySize, LDS_BYTES);
    (void)hipFuncSetAttribute((const void*)ph_kernel<6>, hipFuncAttributeMaxDynamicSharedMemorySize, LDS_BYTES);
    attr_set = true;
  }
  hipLaunchKernelGGL(ph_kernel<0>, dim3(grid_blocks), dim3(512), LDS_BYTES, stream, p);
  hipLaunchKernelGGL(ph_kernel<1>, dim3(grid_blocks), dim3(512), LDS_BYTES, stream, p);
  hipLaunchKernelGGL(ph_kernel<2>, dim3(grid_blocks), dim3(512), LDS_BYTES, stream, p);
  hipLaunchKernelGGL(ph_kernel<3>, dim3(grid_blocks), dim3(512), LDS_BYTES, stream, p);
  hipLaunchKernelGGL(ph_kernel<4>, dim3(grid_blocks), dim3(512), LDS_BYTES, stream, p);
  hipLaunchKernelGGL(ph_kernel<5>, dim3(grid_blocks), dim3(512), LDS_BYTES, stream, p);
  hipLaunchKernelGGL(ph_kernel<6>, dim3(grid_blocks), dim3(512), LDS_BYTES, stream, p);
  hipLaunchKernelGGL(ph_kernel<7>, dim3(grid_blocks), dim3(512), LDS_BYTES, stream, p);
#endif
}
```

```cpp
#include <hip/hip_runtime.h>
#include <hip/hip_cooperative_groups.h>
#include <stdint.h>
#include <cstdio>
namespace cg = cooperative_groups;

#ifndef MK_SINGLE
#define MK_SINGLE 1
#endif
#ifndef QKT_SB
#define QKT_SB 0
#endif
#ifndef ATT_SAFE
#define ATT_SAFE 1
#endif
#ifndef PH_MASK
#define PH_MASK 255
#endif

typedef unsigned short bf16_t;
typedef short bf16x8 __attribute__((ext_vector_type(8)));
typedef short s16x4 __attribute__((ext_vector_type(4)));
typedef float f32x16 __attribute__((ext_vector_type(16)));
typedef unsigned u32x4 __attribute__((ext_vector_type(4)));
typedef unsigned u32x2 __attribute__((ext_vector_type(2)));

constexpr int T = 32768, NP = 16384, NS = 4096, DM = 1024;
constexpr float EPS = 1e-6f;
constexpr float LOG2E = 1.4426950408889634f;
constexpr float PS_A = 0.125f * LOG2E;
constexpr float PS_B = 0.10206207261596575f * LOG2E;

constexpr size_t U = 67108864ull;
constexpr size_t OFF_H = 0;
constexpr size_t OFF_QA = U;
constexpr size_t OFF_KA = U + U / 2;
constexpr size_t OFF_VA = OFF_KA + U / 8;
constexpr size_t OFF_KR = OFF_VA + U / 8;
constexpr size_t OFF_PART = OFF_KR + 2097152;
constexpr size_t OFF_QB = 2 * U;
constexpr size_t OFF_KBN = OFF_QB + (U / 4) * 3;
constexpr size_t OFF_VB = OFF_KBN + U / 2;
constexpr size_t OFF_W = OFF_VB + U / 2;
constexpr size_t OFF_WIN = OFF_W;
constexpr size_t OFF_WQUP = OFF_WIN + 4608ull * 1024 * 2;
constexpr size_t OFF_WKVUP = OFF_WQUP + 768ull * 384 * 2;
constexpr size_t OFF_WAOUT = OFF_WKVUP + 1024ull * 256 * 2;
constexpr size_t OFF_WBOUT = OFF_WAOUT + 1024ull * 512 * 2;
constexpr size_t OFF_WO = OFF_WBOUT + 1024ull * 512 * 2;
constexpr size_t OFF_MOD = OFF_WO + 1024ull * 1024 * 2;
constexpr size_t OFF_SSQ = OFF_MOD + 5 * 3072 * 4;
constexpr size_t OFF_TABA = OFF_SSQ + 3ull * T * 4;
constexpr size_t OFF_TABB = OFF_TABA + 256 * 16 * 8;
constexpr size_t OFF_BND = OFF_TABB + 256 * 8 * 8;
constexpr size_t WS_END = OFF_BND + 256 + 256 * 128;
static_assert(WS_END <= 4 * U, "workspace map exceeds 256 MiB");
constexpr size_t OO_BQ = 0;
constexpr size_t OO_BKV = (size_t)T * 384 * 2;
constexpr size_t OO_YB = 0;
constexpr size_t OO_GA = U;
constexpr size_t OO_GB = U + U / 2;
constexpr size_t OO_MERGED = U;

constexpr int LDS_BYTES = 163840;

struct Params {
  const float *x_prompt, *x_sample, *c_prompt, *c_sample, *ada_w, *ada_b, *pre_g, *post_g, *w_in, *a_q_g, *a_k_g, *b_q_g, *b_q_up,
      *b_kv_g, *b_kv_up, *a_out, *b_out, *w_o;
  float* out;
  char* ws;
};

__device__ __forceinline__ int opaque_tid() { int t = threadIdx.x; asm volatile("" : "+v"(t)); return t; }
typedef float f32x2_t __attribute__((ext_vector_type(2)));
typedef __bf16 bf16x2_t __attribute__((ext_vector_type(2)));
__device__ __forceinline__ unsigned cvtpk(float lo, float hi) { f32x2_t v = {lo, hi}; bf16x2_t b = __builtin_convertvector(v, bf16x2_t); return __builtin_bit_cast(unsigned, b); }
__device__ __forceinline__ float bf2f(unsigned short v) { return __uint_as_float(((unsigned)v) << 16); }
__device__ __forceinline__ int crow(int r, int hi) { return (r & 3) + 8 * (r >> 2) + 4 * hi; }
__device__ __forceinline__ void st4(bf16_t* p, float a, float b, float c, float d) { u32x2 w; w.x = cvtpk(a, b); w.y = cvtpk(c, d); *(u32x2*)p = w; }
__device__ __forceinline__ float sigmoidf_(float v) { return 1.0f / (1.0f + __expf(-v)); }
__device__ __forceinline__ const float* xrow_ptr(const Params& p, int tok) { return tok < NP ? p.x_prompt + (size_t)tok * DM : p.x_sample + (size_t)(tok - NP) * DM; }
__device__ __forceinline__ int batch_of(int tok) { return tok < NP ? 0 : 1 + ((tok - NP) >> 12); }
__device__ __forceinline__ int pos_of(int tok) { return tok < NP ? tok : ((tok - NP) & 4095); }

__device__ __forceinline__ int win_src(int n) {
  if (n < 768) return n;
  if (n < 1152) return 1280 + (n - 768);
  if (n < 1408) return 1664 + (n - 1152);
  if (n < 1440) return 1920 + (n - 1408);
  if (n < 1536) return -1;
  if (n < 2048) return 768 + (n - 1536);
  if (n < 2560) return 1952 + (n - 2048);
  return 2464 + (n - 2560);
}
__device__ __forceinline__ void cvt_tile(const float* __restrict__ W, int ldn, int K, bf16_t* __restrict__ dst, bool remap,
                                         const float* __restrict__ gain, int item, float* tl  , int tid) {
  const int ktiles = K >> 6, n0 = (item / ktiles) * 64, k0 = (item % ktiles) * 64;
  __syncthreads();
  {
    const int n4 = (tid & 15) * 4, kr = tid >> 4;
    const int nd = n0 + n4;
    const int src = remap ? win_src(nd) : nd;
#pragma unroll
    for (int i = 0; i < 2; ++i) {
      const int k = kr + 32 * i;
      float4 v = make_float4(0.f, 0.f, 0.f, 0.f);
      if (src >= 0) v = *(const float4*)(W + (size_t)(k0 + k) * ldn + src);
      if (gain) { const float g = gain[k0 + k]; v.x *= g; v.y *= g; v.z *= g; v.w *= g; }
      float* r = tl + k * 65 + n4;
      r[0] = v.x; r[1] = v.y; r[2] = v.z; r[3] = v.w;
    }
  }
  __syncthreads();
  {
    const int n = tid >> 3, kc = tid & 7;
    const float* c = tl + (kc * 8) * 65 + n;
    u32x4 o; o.x = cvtpk(c[0], c[65]); o.y = cvtpk(c[130], c[195]); o.z = cvtpk(c[260], c[325]); o.w = cvtpk(c[390], c[455]);
    *(u32x4*)(dst + (size_t)(n0 + n) * K + k0 + kc * 8) = o;
  }
}

__device__ __forceinline__ void phase0(const Params& p, char* lds) {
  const int tid = opaque_tid(), gsz = gridDim.x * 512, gtid = blockIdx.x * 512 + tid;
  if (gtid == 0) {
    float* bnd = (float*)(p.ws + OFF_BND);
    float gq = 0.f, gk = 0.f;
    for (int i = 0; i < 64; ++i) { gq = fmaxf(gq, fabsf(p.a_q_g[i])); gk = fmaxf(gk, fabsf(p.a_k_g[i])); }
    bnd[0] = 64.0f * gq * gk * PS_A;
    bnd[1] = 0.f; bnd[2] = 0.f; bnd[3] = 0.f;
  }
  float2* tabA = (float2*)(p.ws + OFF_TABA);
  float2* tabB = (float2*)(p.ws + OFF_TABB);
  for (int i = gtid; i < 256 * 16 + 256 * 8; i += gsz) {
    int pos, f; float inv;
    const float L2T = 13.287712379549449f;
    if (i < 4096) { pos = i >> 4; f = i & 15; inv = exp2f(-(float)f * (1.0f / 16.0f) * L2T); }
    else { int k = i - 4096; pos = k >> 3; f = k & 7; inv = exp2f(-(float)f * (1.0f / 8.0f) * L2T); }
    float ang = (float)pos * inv;
    float rev = ang * 0.15915494309189535f; rev -= floorf(rev);
    float2 cs; cs.x = __builtin_amdgcn_cosf(rev); cs.y = __builtin_amdgcn_sinf(rev);
    if (i < 4096) tabA[i] = cs; else tabB[i - 4096] = cs;
  }
  {
    float* tl = (float*)(lds + 16384);
    for (int it = blockIdx.x; it < 1800; it += gridDim.x) {
      if (it < 1152) cvt_tile(p.w_in, 4512, 1024, (bf16_t*)(p.ws + OFF_WIN), true, nullptr, it, tl, tid);
      else if (it < 1224) cvt_tile(p.b_q_up, 768, 384, (bf16_t*)(p.ws + OFF_WQUP), false, p.b_q_g, it - 1152, tl, tid);
      else if (it < 1288) cvt_tile(p.b_kv_up, 1024, 256, (bf16_t*)(p.ws + OFF_WKVUP), false, p.b_kv_g, it - 1224, tl, tid);
      else if (it < 1416) cvt_tile(p.a_out, 1024, 512, (bf16_t*)(p.ws + OFF_WAOUT), false, nullptr, it - 1288, tl, tid);
      else if (it < 1544) cvt_tile(p.b_out, 1024, 512, (bf16_t*)(p.ws + OFF_WBOUT), false, nullptr, it - 1416, tl, tid);
      else cvt_tile(p.w_o, 1024, 1024, (bf16_t*)(p.ws + OFF_WO), false, nullptr, it - 1544, tl, tid);
    }
  }
  float* red = (float*)lds;
  float* sl = (float*)(lds + 16384);
  float* mod = (float*)(p.ws + OFF_MOD);
  __syncthreads();
  for (int i = tid; i < 5 * 1024; i += 512) { const float cv = i < 1024 ? p.c_prompt[i] : p.c_sample[i - 1024]; sl[i] = cv * sigmoidf_(cv); }
  __syncthreads();
  for (int it = blockIdx.x; it < 256; it += gridDim.x) {
    const int c = tid & 15, kg = tid >> 4;
    float a0 = 0.f, a1 = 0.f, a2 = 0.f, a3 = 0.f, a4 = 0.f;
    if (c < 12) {
      const float* wp = p.ada_w + it * 12 + c;
#pragma unroll 8
      for (int k = kg; k < 1024; k += 32) {
        const float w = wp[(size_t)k * 3072];
        a0 += sl[k] * w; a1 += sl[1024 + k] * w; a2 += sl[2048 + k] * w; a3 += sl[3072 + k] * w; a4 += sl[4096 + k] * w;
      }
    }
    float* rp = red + (kg * 16 + c) * 5;
    rp[0] = a0; rp[1] = a1; rp[2] = a2; rp[3] = a3; rp[4] = a4;
    __syncthreads();
    if (tid < 60) {
      const int cc = tid / 5, b = tid % 5;
      float s = 0.f;
      for (int g = 0; g < 32; ++g) s += red[(g * 16 + cc) * 5 + b];
      const int col = it * 12 + cc;
      mod[b * 3072 + col] = s + p.ada_b[col];
    }
    __syncthreads();
  }
}

__device__ __forceinline__ float wave_sum(float v) {
#pragma unroll
  for (int o = 32; o >= 1; o >>= 1) v += __shfl_xor(v, o);
  return v;
}
__device__ __forceinline__ void phase1(const Params& p) {
  const int tid = opaque_tid(), wid = tid >> 6, lane = tid & 63;
  const float* mod = (const float*)(p.ws + OFF_MOD);
  bf16_t* H = (bf16_t*)(p.ws + OFF_H);
  for (int row = blockIdx.x * 8 + wid; row < T; row += gridDim.x * 8) {
    const float* xr = xrow_ptr(p, row);
    const int b = batch_of(row);
    float4 v[4];
#pragma unroll
    for (int i = 0; i < 4; ++i) v[i] = *(const float4*)(xr + i * 256 + lane * 4);
    float ss = 0.f;
#pragma unroll
    for (int i = 0; i < 4; ++i) ss += v[i].x * v[i].x + v[i].y * v[i].y + v[i].z * v[i].z + v[i].w * v[i].w;
    ss = wave_sum(ss);
    const float rn = rsqrtf(ss * (1.0f / 1024.0f) + EPS);
#pragma unroll
    for (int i = 0; i < 4; ++i) {
      const int col = i * 256 + lane * 4;
      const float4 g = *(const float4*)(p.pre_g + col);
      const float4 sh = *(const float4*)(mod + b * 3072 + col);
      const float4 sc = *(const float4*)(mod + b * 3072 + 1024 + col);
      st4(H + (size_t)row * DM + col, v[i].x * rn * g.x * (1.f + sc.x) + sh.x, v[i].y * rn * g.y * (1.f + sc.y) + sh.y,
          v[i].z * rn * g.z * (1.f + sc.z) + sh.z, v[i].w * rn * g.w * (1.f + sc.w) + sh.w);
    }
  }
}

constexpr int G_XB = 256 * 128, G_WB = 128 * 128, G_STAGE = G_XB + G_WB;
__device__ __forceinline__ int gswz(int row, int c) { return row * 128 + ((c ^ ((row >> 1) & 7)) << 4); }

__device__ __forceinline__ void gemm_kloop(const bf16_t* __restrict__ X, int ldx, const bf16_t* __restrict__ W, int ldw, int nk,
                                           f32x16 (&acc)[2][2], char* lds) {
  const int tid = opaque_tid(), wid = __builtin_amdgcn_readfirstlane(tid >> 6), lane = tid & 63, r32 = lane & 31, hi = lane >> 5, wm = wid & 3, wn = wid >> 2;
  const int srow = tid >> 3, sch = tid & 7;
  const char* xg = (const char*)X;
  const char* wg = (const char*)W;
  const unsigned xstep = (unsigned)ldx * 128u, wstep = (unsigned)ldw * 128u;
  const unsigned xo0 = (unsigned)(srow * ldx + sch * 8) * 2u, wo0 = (unsigned)(srow * ldw + sch * 8) * 2u;
  const int sw = gswz(srow, sch);
  u32x4 xa[4], wa[2], xb[4], wb[2];
  const int fsw = (r32 >> 1) & 7;
  int koff[4];
#pragma unroll
  for (int ks = 0; ks < 4; ++ks) koff[ks] = ((2 * ks + hi) ^ fsw) << 4;
  const int rowA = G_XB + (wn * 64 + r32) * 128, rowB = (wm * 64 + r32) * 128;
#define GLOAD(xr, wr, kt) do { _Pragma("unroll") for (int i = 0; i < 4; ++i) xr[i] = *(const u32x4*)(xg + (xo0 + i * xstep + (unsigned)(kt) * 128u)); \
    _Pragma("unroll") for (int i = 0; i < 2; ++i) wr[i] = *(const u32x4*)(wg + (wo0 + i * wstep + (unsigned)(kt) * 128u)); } while (0)
#define GWRITE(s, xr, wr) do { char* b_ = lds + (s) * G_STAGE; _Pragma("unroll") for (int i = 0; i < 4; ++i) *(u32x4*)(b_ + sw + i * 8192) = xr[i]; \
    _Pragma("unroll") for (int i = 0; i < 2; ++i) *(u32x4*)(b_ + G_XB + sw + i * 8192) = wr[i]; } while (0)
#define GCOMPUTE(s) do { const char* sb = lds + (s) * G_STAGE; _Pragma("unroll") for (int ks = 0; ks < 4; ++ks) { \
      const bf16x8 a0 = *(const bf16x8*)(sb + rowA + koff[ks]); const bf16x8 a1 = *(const bf16x8*)(sb + rowA + 4096 + koff[ks]); \
      const bf16x8 b0 = *(const bf16x8*)(sb + rowB + koff[ks]); const bf16x8 b1 = *(const bf16x8*)(sb + rowB + 4096 + koff[ks]); \
      acc[0][0] = __builtin_amdgcn_mfma_f32_32x32x16_bf16(a0, b0, acc[0][0], 0, 0, 0); acc[0][1] = __builtin_amdgcn_mfma_f32_32x32x16_bf16(a0, b1, acc[0][1], 0, 0, 0); \
      acc[1][0] = __builtin_amdgcn_mfma_f32_32x32x16_bf16(a1, b0, acc[1][0], 0, 0, 0); acc[1][1] = __builtin_amdgcn_mfma_f32_32x32x16_bf16(a1, b1, acc[1][1], 0, 0, 0); } } while (0)
  __syncthreads();
  GLOAD(xa, wa, 0); GLOAD(xb, wb, 1); GWRITE(0, xa, wa); __syncthreads();
#pragma nounroll
  for (int kt = 0; kt < nk; kt += 2) {
    const int ka = kt + 2 < nk ? kt + 2 : nk - 2, kb = kt + 3 < nk ? kt + 3 : nk - 1;
    GLOAD(xa, wa, ka);
    GCOMPUTE(0);
    GWRITE(1, xb, wb);
    __syncthreads();
    GLOAD(xb, wb, kb);
    GCOMPUTE(1);
    GWRITE(0, xa, wa);
    __syncthreads();
  }
  asm volatile("s_waitcnt vmcnt(0)" ::: "memory");
#undef GLOAD
#undef GWRITE
#undef GCOMPUTE
}
__device__ __forceinline__ void zero_acc(f32x16 (&acc)[2][2]) {
#pragma unroll
  for (int a = 0; a < 2; ++a)
#pragma unroll
    for (int b = 0; b < 2; ++b)
#pragma unroll
      for (int r = 0; r < 16; ++r) acc[a][b][r] = 0.f;
}

__device__ __forceinline__ void stage_put(char* wb, int t, int q, float a, float b, float c, float d) {
  u32x2 w; w.x = cvtpk(a, b); w.y = cvtpk(c, d);
  *(u32x2*)(wb + t * 128 + ((q ^ ((t & 7) << 1)) << 3)) = w;
}
__device__ __forceinline__ void stage_flush(const char* wb, bf16_t* dst, int ld, int lane) {
#pragma unroll
  for (int i = 0; i < 8; ++i) {
    const int row = i * 8 + (lane >> 3), c = lane & 7;
    const u32x4 v = *(const u32x4*)(wb + row * 128 + ((c ^ (row & 7)) << 4));
    *(u32x4*)(dst + (size_t)row * ld + c * 8) = v;
  }
}
__device__ __forceinline__ void stage_flush_add(const char* wb, bf16_t* dst, int ld, int lane) {
#pragma unroll
  for (int i = 0; i < 8; ++i) {
    const int row = i * 8 + (lane >> 3), c = lane & 7;
    const u32x4 v = *(const u32x4*)(wb + row * 128 + ((c ^ (row & 7)) << 4));
    u32x4* gp = (u32x4*)(dst + (size_t)row * ld + c * 8);
    const u32x4 o = *gp;
    u32x4 r;
    r.x = cvtpk(__uint_as_float(v.x << 16) + __uint_as_float(o.x << 16), __uint_as_float(v.x & 0xffff0000u) + __uint_as_float(o.x & 0xffff0000u));
    r.y = cvtpk(__uint_as_float(v.y << 16) + __uint_as_float(o.y << 16), __uint_as_float(v.y & 0xffff0000u) + __uint_as_float(o.y & 0xffff0000u));
    r.z = cvtpk(__uint_as_float(v.z << 16) + __uint_as_float(o.z << 16), __uint_as_float(v.z & 0xffff0000u) + __uint_as_float(o.z & 0xffff0000u));
    r.w = cvtpk(__uint_as_float(v.w << 16) + __uint_as_float(o.w << 16), __uint_as_float(v.w & 0xffff0000u) + __uint_as_float(o.w & 0xffff0000u));
    *gp = r;
  }
}
__device__ __forceinline__ void epi_rope64(const f32x16& a0, const f32x16& a1, int t, const float* __restrict__ gain, float ps,
                                           const float2* __restrict__ tabA, char* wb, int tl, int hi) {
  float ss = 0.f;
#pragma unroll
  for (int r = 0; r < 16; ++r) ss += a0[r] * a0[r] + a1[r] * a1[r];
  ss += __shfl_xor(ss, 32);
  const float rn = rsqrtf(ss * (1.0f / 64.0f) + EPS);
  const int prow = t >> 6, pcol = t & 63;
#pragma unroll
  for (int g = 0; g < 4; ++g) {
    const int f0 = 8 * (g & 1) + 4 * hi, pos = g < 2 ? prow : pcol, d = 8 * g + 4 * hi;
    const float4* tp = (const float4*)(tabA + pos * 16 + f0);
    const float4 t01 = tp[0], t23 = tp[1];
    const float4 g1 = *(const float4*)(gain + d), g2 = *(const float4*)(gain + 32 + d);
    const float x10 = a0[4 * g + 0] * rn * g1.x, x11 = a0[4 * g + 1] * rn * g1.y, x12 = a0[4 * g + 2] * rn * g1.z, x13 = a0[4 * g + 3] * rn * g1.w;
    const float x20 = a1[4 * g + 0] * rn * g2.x, x21 = a1[4 * g + 1] * rn * g2.y, x22 = a1[4 * g + 2] * rn * g2.z, x23 = a1[4 * g + 3] * rn * g2.w;
    stage_put(wb, tl, 2 * g + hi, (x10 * t01.x - x20 * t01.y) * ps, (x11 * t01.z - x21 * t01.w) * ps, (x12 * t23.x - x22 * t23.y) * ps, (x13 * t23.z - x23 * t23.w) * ps);
    stage_put(wb, tl, 8 + 2 * g + hi, (x20 * t01.x + x10 * t01.y) * ps, (x21 * t01.z + x11 * t01.w) * ps, (x22 * t23.x + x12 * t23.y) * ps, (x23 * t23.z + x13 * t23.w) * ps);
  }
}
__device__ __forceinline__ void rope32_vals(const f32x16& a, float mul, int t, const float2* __restrict__ tabB, int hi, int g, float (&o1)[4], float (&o2)[4]) {
  const int pos = g == 0 ? (t >> 6) : (t & 63);
  const float4* tp = (const float4*)(tabB + pos * 8 + 4 * hi);
  const float4 t01 = tp[0], t23 = tp[1];
  const float x10 = a[4 * g + 0] * mul, x11 = a[4 * g + 1] * mul, x12 = a[4 * g + 2] * mul, x13 = a[4 * g + 3] * mul;
  const float x20 = a[8 + 4 * g + 0] * mul, x21 = a[8 + 4 * g + 1] * mul, x22 = a[8 + 4 * g + 2] * mul, x23 = a[8 + 4 * g + 3] * mul;
  o1[0] = x10 * t01.x - x20 * t01.y; o1[1] = x11 * t01.z - x21 * t01.w; o1[2] = x12 * t23.x - x22 * t23.y; o1[3] = x13 * t23.z - x23 * t23.w;
  o2[0] = x20 * t01.x + x10 * t01.y; o2[1] = x21 * t01.z + x11 * t01.w; o2[2] = x22 * t23.x + x12 * t23.y; o2[3] = x23 * t23.z + x13 * t23.w;
}
__device__ __forceinline__ void epi_rope32(const f32x16& a, float mul, int t, const float2* __restrict__ tabB, char* wb, int tl, int qb, int hi) {
#pragma unroll
  for (int g = 0; g < 2; ++g) {
    float o1[4], o2[4];
    rope32_vals(a, mul, t, tabB, hi, g, o1, o2);
    stage_put(wb, tl, qb + 2 * g + hi, o1[0], o1[1], o1[2], o1[3]);
    stage_put(wb, tl, qb + 4 + 2 * g + hi, o2[0], o2[1], o2[2], o2[3]);
  }
}
__device__ __forceinline__ void epi_rope32_direct(const f32x16& a, float mul, int t, const float2* __restrict__ tabB, bf16_t* dst, int hi) {
#pragma unroll
  for (int g = 0; g < 2; ++g) {
    float o1[4], o2[4];
    rope32_vals(a, mul, t, tabB, hi, g, o1, o2);
    st4(dst + 8 * g + 4 * hi, o1[0], o1[1], o1[2], o1[3]);
    st4(dst + 16 + 8 * g + 4 * hi, o2[0], o2[1], o2[2], o2[3]);
  }
}
__device__ __forceinline__ void epi_plain32(const f32x16& a, float mul, char* wb, int tl, int qb, int hi) {
#pragma unroll
  for (int g = 0; g < 4; ++g) stage_put(wb, tl, qb + 2 * g + hi, a[4 * g] * mul, a[4 * g + 1] * mul, a[4 * g + 2] * mul, a[4 * g + 3] * mul);
}
__device__ __forceinline__ void epi_silu32(const f32x16& a, char* wb, int tl, int qb, int hi) {
#pragma unroll
  for (int g = 0; g < 4; ++g)
    stage_put(wb, tl, qb + 2 * g + hi, a[4 * g] * sigmoidf_(a[4 * g]), a[4 * g + 1] * sigmoidf_(a[4 * g + 1]), a[4 * g + 2] * sigmoidf_(a[4 * g + 2]),
              a[4 * g + 3] * sigmoidf_(a[4 * g + 3]));
}
__device__ __forceinline__ float sumsq16(const f32x16& a) {
  float s = 0.f;
#pragma unroll
  for (int r = 0; r < 16; ++r) s += a[r] * a[r];
  return s;
}

struct TileIter {
  int q, step, end, NT, mbase; bool xcd;
  __device__ __forceinline__ TileIter(int nt_count) {
    NT = nt_count; xcd = (gridDim.x == 256);
    if (xcd) { q = blockIdx.x >> 3; step = 32; end = 16 * NT; mbase = (blockIdx.x & 7) * 16; }
    else { q = blockIdx.x; step = gridDim.x; end = 128 * NT; mbase = 0; }
  }
  __device__ __forceinline__ bool next(int& mt, int& nt) { if (q >= end) return false; mt = mbase + q / NT; nt = q % NT; q += step; return true; }
};

__device__ __forceinline__ void bound_max(float* dst, float v) {
#pragma unroll
  for (int o = 32; o >= 1; o >>= 1) v = fmaxf(v, __shfl_xor(v, o));
  if ((threadIdx.x & 63) == 0) atomicMax((unsigned*)dst, __float_as_uint(v));
}
__device__ __forceinline__ void phase_g1(const Params& p, char* lds) {
  const int tid = opaque_tid(), wid = __builtin_amdgcn_readfirstlane(tid >> 6), lane = tid & 63, r32 = lane & 31, hi = lane >> 5, wm = wid & 3, wn = wid >> 2;
  const bf16_t* H = (const bf16_t*)(p.ws + OFF_H);
  const bf16_t* WIN = (const bf16_t*)(p.ws + OFF_WIN);
  const float2* tabA = (const float2*)(p.ws + OFF_TABA);
  const float2* tabB = (const float2*)(p.ws + OFF_TABB);
  float* part = (float*)(p.ws + OFF_PART);
  char* dout = (char*)p.out;
  float bmax_kr = 0.f;
  TileIter it(20); int mt, nt;
  while (it.next(mt, nt)) {
    const int m0 = mt * 256;
    f32x16 acc[2][2];
    zero_acc(acc);
    gemm_kloop(H + (size_t)m0 * DM, DM, WIN + (size_t)nt * 128 * DM, DM, 16, acc, lds);
    char* wb = lds + wid * 8192;
    const int tok0 = m0 + wm * 64;
#pragma unroll
    for (int ti = 0; ti < 2; ++ti) {
      const int tl = ti * 32 + r32, tok = tok0 + tl;
      const int t = pos_of(tok);
      if (nt < 4) {
        epi_rope64(acc[0][ti], acc[1][ti], t, p.a_q_g, PS_A, tabA, wb, tl, hi);
      } else if (nt == 4) {
        epi_rope64(acc[0][ti], acc[1][ti], t, p.a_k_g, 1.0f, tabA, wb, tl, hi);
      } else if (nt == 5) {
        epi_plain32(acc[0][ti], 1.0f, wb, tl, 0, hi); epi_plain32(acc[1][ti], 1.0f, wb, tl, 8, hi);
      } else if (nt < 9) {
        epi_plain32(acc[0][ti], 1.0f, wb, tl, 0, hi); epi_plain32(acc[1][ti], 1.0f, wb, tl, 8, hi);
        float s = sumsq16(acc[0][ti]) + sumsq16(acc[1][ti]); s += __shfl_xor(s, 32);
        if (hi == 0) part[((nt - 6) * 2 + wn) * T + tok] = s;
      } else if (nt < 11) {
        epi_plain32(acc[0][ti], 1.0f, wb, tl, 0, hi); epi_plain32(acc[1][ti], 1.0f, wb, tl, 8, hi);
        float s = sumsq16(acc[0][ti]) + sumsq16(acc[1][ti]); s += __shfl_xor(s, 32);
        if (hi == 0) part[(6 + (nt - 9) * 2 + wn) * T + tok] = s;
      } else if (nt == 11) {
        if (wn == 0) {
          epi_rope32_direct(acc[0][ti], 1.0f, t, tabB, (bf16_t*)(p.ws + OFF_KR) + (size_t)tok * 32, hi);
          float s = sumsq16(acc[0][ti]); s += __shfl_xor(s, 32);
          bmax_kr = fmaxf(bmax_kr, s);
        }
      } else {
        epi_silu32(acc[0][ti], wb, tl, 0, hi); epi_silu32(acc[1][ti], wb, tl, 8, hi);
      }
    }
    if (nt != 11) {
      bf16_t* dst; int ld;
      if (nt < 4) { dst = (bf16_t*)(p.ws + OFF_QA) + (size_t)tok0 * 512 + (nt * 2 + wn) * 64; ld = 512; }
      else if (nt == 4) { dst = (bf16_t*)(p.ws + OFF_KA) + (size_t)tok0 * 128 + wn * 64; ld = 128; }
      else if (nt == 5) { dst = (bf16_t*)(p.ws + OFF_VA) + (size_t)tok0 * 128 + wn * 64; ld = 128; }
      else if (nt < 9) { dst = (bf16_t*)(dout + OO_BQ) + (size_t)tok0 * 384 + (nt - 6) * 128 + wn * 64; ld = 384; }
      else if (nt < 11) { dst = (bf16_t*)(dout + OO_BKV) + (size_t)tok0 * 256 + (nt - 9) * 128 + wn * 64; ld = 256; }
      else if (nt < 16) { dst = (bf16_t*)(dout + OO_GA) + (size_t)tok0 * 512 + (nt - 12) * 128 + wn * 64; ld = 512; }
      else { dst = (bf16_t*)(dout + OO_GB) + (size_t)tok0 * 512 + (nt - 16) * 128 + wn * 64; ld = 512; }
      stage_flush(wb, dst, ld, lane);
    }
  }
  bound_max((float*)(p.ws + OFF_BND) + 3, bmax_kr);
}

__device__ __forceinline__ void phase_g2(const Params& p, char* lds) {
  const int tid = opaque_tid(), wid = __builtin_amdgcn_readfirstlane(tid >> 6), lane = tid & 63, r32 = lane & 31, hi = lane >> 5, wm = wid & 3, wn = wid >> 2;
  const float2* tabB = (const float2*)(p.ws + OFF_TABB);
  const float* part = (const float*)(p.ws + OFF_PART);
  char* dout = (char*)p.out;
  float bmax_q = 0.f, bmax_k = 0.f;
  TileIter it(14); int mt, j;
  while (it.next(mt, j)) {
    const int m0 = mt * 256;
    f32x16 acc[2][2];
    zero_acc(acc);
    char* wb = lds + wid * 8192;
    const int tok0 = m0 + wm * 64;
    if (j < 6) {
      gemm_kloop((const bf16_t*)(dout + OO_BQ) + (size_t)m0 * 384, 384, (const bf16_t*)(p.ws + OFF_WQUP) + (size_t)j * 128 * 384, 384, 6, acc, lds);
#pragma unroll
      for (int ti = 0; ti < 2; ++ti) {
        const int tl = ti * 32 + r32, tok = tok0 + tl;
        const int t = pos_of(tok);
        const float sq = (part[tok] + part[T + tok]) + (part[2 * T + tok] + part[3 * T + tok]) + (part[4 * T + tok] + part[5 * T + tok]);
        const float rn = rsqrtf(sq * (1.0f / 384.0f) + EPS) * PS_B;
#pragma unroll
        for (int fi = 0; fi < 2; ++fi) {
          const int blk = j * 4 + wn * 2 + fi;
          if (blk % 3 == 2) epi_rope32(acc[fi][ti], rn, t, tabB, wb, tl, fi * 8, hi);
          else epi_plain32(acc[fi][ti], rn, wb, tl, fi * 8, hi);
          float s = sumsq16(acc[fi][ti]); s += __shfl_xor(s, 32);
          bmax_q = fmaxf(bmax_q, s * rn * rn);
        }
      }
      stage_flush(wb, (bf16_t*)(p.ws + OFF_QB) + (size_t)tok0 * 768 + (j * 4 + wn * 2) * 32, 768, lane);
    } else {
      const int jn = j - 6;
      gemm_kloop((const bf16_t*)(dout + OO_BKV) + (size_t)m0 * 256, 256, (const bf16_t*)(p.ws + OFF_WKVUP) + (size_t)jn * 128 * 256, 256, 4, acc, lds);
#pragma unroll
      for (int ti = 0; ti < 2; ++ti) {
        const int tl = ti * 32 + r32, tok = tok0 + tl;
        const float sk = (part[6 * T + tok] + part[7 * T + tok]) + (part[8 * T + tok] + part[9 * T + tok]);
        const float rn = rsqrtf(sk * (1.0f / 256.0f) + EPS);
        epi_plain32(acc[0][ti], rn, wb, tl, 0, hi); epi_plain32(acc[1][ti], rn, wb, tl, 8, hi);
        if (wn == 0) {
          float s0 = sumsq16(acc[0][ti]), s1 = sumsq16(acc[1][ti]); s0 += __shfl_xor(s0, 32); s1 += __shfl_xor(s1, 32);
          bmax_k = fmaxf(bmax_k, fmaxf(s0, s1) * rn * rn);
        }
      }
      stage_flush(wb, (bf16_t*)(p.ws + (wn == 0 ? OFF_KBN : OFF_VB)) + (size_t)tok0 * 512 + jn * 64, 512, lane);
    }
  }
  bound_max((float*)(p.ws + OFF_BND) + 1, bmax_q);
  bound_max((float*)(p.ws + OFF_BND) + 2, bmax_k);
}

__device__ __forceinline__ void phase_g3(const Params& p, char* lds) {
  const int tid = opaque_tid(), wid = __builtin_amdgcn_readfirstlane(tid >> 6), lane = tid & 63, r32 = lane & 31, hi = lane >> 5, wm = wid & 3, wn = wid >> 2;
  char* dout = (char*)p.out;
  const bf16_t* H = (const bf16_t*)(p.ws + OFF_H);
  const bf16_t* WIN = (const bf16_t*)(p.ws + OFF_WIN);
  bf16_t* MG = (bf16_t*)(dout + OO_MERGED);
  TileIter it(8); int mt, nt;
  while (it.next(mt, nt)) {
    const int m0 = mt * 256;
#pragma nounroll
    for (int s = 0; s < 2; ++s) {
      f32x16 acc[2][2];
      zero_acc(acc);
      const bf16_t* Y = s == 0 ? (const bf16_t*)(p.ws + OFF_QA) : (const bf16_t*)(dout + OO_YB);
      const bf16_t* WOUT = (const bf16_t*)(p.ws + (s == 0 ? OFF_WAOUT : OFF_WBOUT));
      gemm_kloop(H + (size_t)m0 * DM, DM, WIN + (size_t)(2560 + s * 1024 + nt * 128) * DM, DM, 16, acc, lds);
      unsigned* gl = (unsigned*)(lds + 2 * G_STAGE) + tid;
#pragma unroll
      for (int fi = 0; fi < 2; ++fi)
#pragma unroll
        for (int ti = 0; ti < 2; ++ti)
#pragma unroll
          for (int q = 0; q < 8; ++q) gl[((fi * 2 + ti) * 8 + q) * 512] = cvtpk(sigmoidf_(acc[fi][ti][2 * q]), sigmoidf_(acc[fi][ti][2 * q + 1]));
      zero_acc(acc);
      gemm_kloop(Y + (size_t)m0 * 512, 512, WOUT + (size_t)nt * 128 * 512, 512, 8, acc, lds);
      char* wb = lds + wid * 8192;
#pragma unroll
      for (int ti = 0; ti < 2; ++ti) {
        const int tl = ti * 32 + r32;
#pragma unroll
        for (int fi = 0; fi < 2; ++fi) {
#pragma unroll
          for (int g = 0; g < 4; ++g) {
            const unsigned g01 = gl[((fi * 2 + ti) * 8 + 2 * g) * 512], g23 = gl[((fi * 2 + ti) * 8 + 2 * g + 1) * 512];
            stage_put(wb, tl, fi * 8 + 2 * g + hi, __uint_as_float(g01 << 16) * acc[fi][ti][4 * g], __uint_as_float(g01 & 0xffff0000u) * acc[fi][ti][4 * g + 1],
                      __uint_as_float(g23 << 16) * acc[fi][ti][4 * g + 2], __uint_as_float(g23 & 0xffff0000u) * acc[fi][ti][4 * g + 3]);
          }
        }
      }
      bf16_t* dst = MG + (size_t)(m0 + wm * 64) * DM + nt * 128 + wn * 64;
      if (s == 0) stage_flush(wb, dst, DM, lane); else stage_flush_add(wb, dst, DM, lane);
    }
  }
}

__device__ __forceinline__ void phase_g4(const Params& p, char* lds) {
  const int tid = opaque_tid(), wid = __builtin_amdgcn_readfirstlane(tid >> 6), lane = tid & 63, r32 = lane & 31, hi = lane >> 5, wm = wid & 3, wn = wid >> 2;
  char* dout = (char*)p.out;
  const bf16_t* MG = (const bf16_t*)(dout + OO_MERGED);
  bf16_t* Z = (bf16_t*)(p.ws + OFF_H);
  float* part = (float*)(p.ws + OFF_PART) + 10 * T;
  TileIter it(8); int mt, nt;
  while (it.next(mt, nt)) {
    const int m0 = mt * 256;
    f32x16 acc[2][2];
    zero_acc(acc);
    gemm_kloop(MG + (size_t)m0 * DM, DM, (const bf16_t*)(p.ws + OFF_WO) + (size_t)nt * 128 * DM, DM, 16, acc, lds);
    char* wb = lds + wid * 8192;
    const int tok0 = m0 + wm * 64;
#pragma unroll
    for (int ti = 0; ti < 2; ++ti) {
      const int tl = ti * 32 + r32, tok = tok0 + tl;
      epi_plain32(acc[0][ti], 1.0f, wb, tl, 0, hi); epi_plain32(acc[1][ti], 1.0f, wb, tl, 8, hi);
      float s = sumsq16(acc[0][ti]) + sumsq16(acc[1][ti]); s += __shfl_xor(s, 32);
      if (hi == 0) part[(nt * 2 + wn) * T + tok] = s;
    }
    stage_flush(wb, Z + (size_t)tok0 * DM + nt * 128 + wn * 64, DM, lane);
  }
}

__device__ __forceinline__ void phase5(const Params& p) {
  const int tid = opaque_tid(), wid = tid >> 6, lane = tid & 63;
  const float* mod = (const float*)(p.ws + OFF_MOD);
  const bf16_t* Z = (const bf16_t*)(p.ws + OFF_H);
  const float* part = (const float*)(p.ws + OFF_PART) + 10 * T;
  for (int row = blockIdx.x * 8 + wid; row < T; row += gridDim.x * 8) {
    const float* xr = xrow_ptr(p, row);
    const int b = batch_of(row);
    const float sz = wave_sum(lane < 16 ? part[lane * T + row] : 0.f);
    const float rn = rsqrtf(sz * (1.0f / 1024.0f) + EPS);
    float* o = p.out + (size_t)row * DM;
#pragma unroll
    for (int i = 0; i < 4; ++i) {
      const int col = i * 256 + lane * 4;
      const float4 xv = *(const float4*)(xr + col);
      const u32x2 zz = *(const u32x2*)(Z + (size_t)row * DM + col);
      const float4 g = *(const float4*)(p.post_g + col);
      const float4 gt = *(const float4*)(mod + b * 3072 + 2048 + col);
      float4 r;
      r.x = xv.x + gt.x * (__uint_as_float(zz.x << 16) * rn * g.x);
      r.y = xv.y + gt.y * (__uint_as_float(zz.x & 0xffff0000u) * rn * g.y);
      r.z = xv.z + gt.z * (__uint_as_float(zz.y << 16) * rn * g.z);
      r.w = xv.w + gt.w * (__uint_as_float(zz.y & 0xffff0000u) * rn * g.w);
      *(float4*)(o + col) = r;
    }
  }
}

#define SBAR() __builtin_amdgcn_sched_barrier(0)
constexpr float ATT_THR = 8.0f;
constexpr int SHM_V = 64 * 64 * 2;
template <int DK> struct KL { static constexpr int RB = DK == 64 ? 128 : 256; static constexpr int SHM_K = 64 * RB; };
template <int DK> __device__ __forceinline__ int kswz(int row, int c) {
  if (DK == 64) return row * 128 + ((c ^ ((row >> 1) & 7)) << 4);
  return row * 256 + ((c ^ (row & 15)) << 4);
}
__device__ __forceinline__ int v_st(int k, int c) {
  const int kk = (k & ~0xC) | ((k & 4) << 1) | ((k & 8) >> 1);
  return ((kk >> 3) * 2 + (c >> 5)) * 512 + ((kk & 7) * 32 + (c & 31)) * 2;
}
__device__ __forceinline__ int v_rd_base(int lane) { return ((lane & 3) << 3) | (((lane >> 2) & 3) << 6) | (((lane >> 4) & 1) << 5) | (((lane >> 5) & 1) << 8); }
constexpr int v_rd_off(int d0, int ks, int half) { return d0 * 512 + ks * 2048 + half * 1024; }
template <int OFF> __device__ __forceinline__ s16x4 tr_read(int vb) {
  s16x4 r; asm volatile("ds_read_b64_tr_b16 %0, %1 offset:%2" : "=&v"(r) : "v"(vb), "i"(OFF) : "memory"); return r;
}
template <int D0> __device__ __forceinline__ void pv_one(f32x16& od, int vb, bf16x8 pa0, bf16x8 pa1, bf16x8 pa2, bf16x8 pa3) {
  const s16x4 l0 = tr_read<v_rd_off(D0, 0, 0)>(vb), h0 = tr_read<v_rd_off(D0, 0, 1)>(vb), l1 = tr_read<v_rd_off(D0, 1, 0)>(vb), h1 = tr_read<v_rd_off(D0, 1, 1)>(vb);
  const s16x4 l2 = tr_read<v_rd_off(D0, 2, 0)>(vb), h2 = tr_read<v_rd_off(D0, 2, 1)>(vb), l3 = tr_read<v_rd_off(D0, 3, 0)>(vb), h3 = tr_read<v_rd_off(D0, 3, 1)>(vb);
  asm volatile("s_waitcnt lgkmcnt(0)" ::: "memory"); SBAR();
#define PK(L, Hh) (bf16x8){L[0], L[1], L[2], L[3], Hh[0], Hh[1], Hh[2], Hh[3]}
  od = __builtin_amdgcn_mfma_f32_32x32x16_bf16(pa0, PK(l0, h0), od, 0, 0, 0);
  od = __builtin_amdgcn_mfma_f32_32x32x16_bf16(pa1, PK(l1, h1), od, 0, 0, 0);
  od = __builtin_amdgcn_mfma_f32_32x32x16_bf16(pa2, PK(l2, h2), od, 0, 0, 0);
  od = __builtin_amdgcn_mfma_f32_32x32x16_bf16(pa3, PK(l3, h3), od, 0, 0, 0);
#undef PK
}
__device__ __forceinline__ void pv_all(f32x16* o, int vb, bf16x8 pa0, bf16x8 pa1, bf16x8 pa2, bf16x8 pa3) {
  pv_one<0>(o[0], vb, pa0, pa1, pa2, pa3); pv_one<1>(o[1], vb, pa0, pa1, pa2, pa3);
}
__device__ __forceinline__ void partialSM(f32x16& p0, f32x16& p1, float& m_reg, float& alpha) {
  float pmax = p0[0];
#pragma unroll
  for (int r = 1; r < 16; ++r) pmax = fmaxf(pmax, p0[r]);
#pragma unroll
  for (int r = 0; r < 16; ++r) pmax = fmaxf(pmax, p1[r]);
  { auto rr = __builtin_amdgcn_permlane32_swap(__float_as_uint(pmax), __float_as_uint(pmax), false, false);
    pmax = fmaxf(__uint_as_float(rr[0]), __uint_as_float(rr[1])); }
  float mn;
  if (__builtin_expect(__all(pmax - m_reg <= ATT_THR), 1)) { mn = m_reg; alpha = 1.f; }
  else { mn = fmaxf(m_reg, pmax); alpha = __builtin_amdgcn_exp2f(m_reg - mn); m_reg = mn; }
#pragma unroll
  for (int r = 0; r < 16; ++r) p0[r] -= mn;
#pragma unroll
  for (int r = 0; r < 16; ++r) p1[r] -= mn;
#pragma unroll
  for (int r = 0; r < 16; ++r) p0[r] = __builtin_amdgcn_exp2f(p0[r]);
}
__device__ __forceinline__ void finishSM(f32x16& p0, f32x16& p1, float alpha, float& l_reg, bf16x8& pa0, bf16x8& pa1, bf16x8& pa2, bf16x8& pa3) {
#pragma unroll
  for (int r = 0; r < 16; ++r) p1[r] = __builtin_amdgcn_exp2f(p1[r]);
  float ps = 0.f;
#pragma unroll
  for (int r = 0; r < 16; ++r) ps += p0[r];
#pragma unroll
  for (int r = 0; r < 16; ++r) ps += p1[r];
  { auto rr = __builtin_amdgcn_permlane32_swap(__float_as_uint(ps), __float_as_uint(ps), false, false);
    ps = __uint_as_float(rr[0]) + __uint_as_float(rr[1]); }
  l_reg = l_reg * alpha + ps;
#define PK4(P, BASE, OUT) do { unsigned a0 = cvtpk(P[BASE + 0], P[BASE + 1]), a1 = cvtpk(P[BASE + 2], P[BASE + 3]);   \
    unsigned b0 = cvtpk(P[BASE + 4], P[BASE + 5]), b1 = cvtpk(P[BASE + 6], P[BASE + 7]);                              \
    auto r0 = __builtin_amdgcn_permlane32_swap(a0, b0, false, false); auto r1 = __builtin_amdgcn_permlane32_swap(a1, b1, false, false); \
    u32x4 w = {r0[0], r1[0], r0[1], r1[1]}; OUT = *reinterpret_cast<bf16x8*>(&w); } while (0)
  PK4(p0, 0, pa0); PK4(p0, 8, pa1); PK4(p1, 0, pa2); PK4(p1, 8, pa3);
#undef PK4
}
template <int DK> __device__ __forceinline__ void qkt(f32x16& p0, f32x16& p1, const char* Ks, const bf16x8* qr, int r32, int hi) {
#pragma unroll
  for (int r = 0; r < 16; ++r) { p0[r] = 0.f; p1[r] = 0.f; }
#pragma unroll
  for (int d0 = 0; d0 < DK / 16; ++d0) {
    const int off = kswz<DK>(r32, 2 * d0 + hi);
    const bf16x8 b0 = *reinterpret_cast<const bf16x8*>(Ks + off);
    const bf16x8 b1 = *reinterpret_cast<const bf16x8*>(Ks + off + 32 * KL<DK>::RB);
    p0 = __builtin_amdgcn_mfma_f32_32x32x16_bf16(b0, qr[d0], p0, 0, 0, 0);
    p1 = __builtin_amdgcn_mfma_f32_32x32x16_bf16(b1, qr[d0], p1, 0, 0, 0);
    if (QKT_SB && (d0 & 1) == 1 && d0 + 1 < DK / 16) SBAR();
  }
}

template <int DK>
__device__ __forceinline__ void attn_unit(const bf16_t* Qb, int ldq, const bf16_t* __restrict__ Kh, int ldk, const bf16_t* __restrict__ Krp,
                                          const bf16_t* __restrict__ Vh, int ldv, const bf16_t* Gb, bf16_t* Ob, int seq, char* lds) {
  constexpr int SHM_K = KL<DK>::SHM_K;
  const int tid = opaque_tid(), wid = __builtin_amdgcn_readfirstlane(tid >> 6), lane = tid & 63, r32 = lane & 31, hi = lane >> 5;
  char* V_lds = lds; char* K_lds = lds + 2 * SHM_V;
  float* ws = (float*)(lds + 2 * SHM_V + 2 * SHM_K) + wid * 64; float* li_l = ws; float* al_l = ws + 32;
  float m_reg = -1e30f, l_reg = 0.f; f32x16 o[2]; bf16x8 qr[DK / 16];
#pragma unroll
  for (int r = 0; r < 16; ++r) { o[0][r] = 0.f; o[1][r] = 0.f; }
  const bf16_t* Qw = Qb + (size_t)(wid * 32 + r32) * ldq + hi * 8;
#pragma unroll
  for (int d0 = 0; d0 < DK / 16; ++d0) qr[d0] = *reinterpret_cast<const bf16x8*>(Qw + d0 * 16);
  const int srow = tid >> 3, sc = tid & 7, vst = v_st(srow, sc * 8), kst = kswz<DK>(srow, sc);
  const int rrow = tid >> 2, rc = tid & 3, krst = kswz<DK>(rrow & 63, 8 + rc);
  const bool dor = (DK == 96) && (wid < 4);
  const int vb0 = (int)(uintptr_t)V_lds + v_rd_base(lane);
  struct { u32x4 v, k, r; } sr_[1];
  const unsigned voff0 = (unsigned)(srow * ldv + sc * 8) * 2u, koff0 = (unsigned)(srow * ldk + sc * 8) * 2u, roff0 = (unsigned)(rrow * 32 + rc * 8) * 2u;
#define SLOAD(i, k0) do { sr_[i].v = *(const u32x4*)((const char*)Vh + (voff0 + (unsigned)((k0) * ldv) * 2u)); sr_[i].k = *(const u32x4*)((const char*)Kh + (koff0 + (unsigned)((k0) * ldk) * 2u)); \
    if (dor) sr_[i].r = *(const u32x4*)((const char*)Krp + (roff0 + (unsigned)((k0) * 64))); } while (0)
#define SWRITE(b, i) do { *(u32x4*)(V_lds + (b) * SHM_V + vst) = sr_[i].v; *(u32x4*)(K_lds + (b) * SHM_K + kst) = sr_[i].k; \
    if (dor) *(u32x4*)(K_lds + (b) * SHM_K + krst) = sr_[i].r; } while (0)
#define RESC(a) do { if (__any((a) < 1.f)) { if (hi == 0) al_l[r32] = (a); asm volatile("s_waitcnt lgkmcnt(0)" ::: "memory"); \
    _Pragma("unroll") for (int d = 0; d < 2; ++d) _Pragma("unroll") for (int r = 0; r < 16; ++r) o[d][r] *= al_l[crow(r, hi)]; } } while (0)
  f32x16 pA0, pA1, pB0, pB1; float alA, alB; bf16x8 pa0, pa1, pa2, pa3; const int NT = seq / 64;
  __syncthreads();
  SLOAD(0, 0); SWRITE(0, 0); __syncthreads();
  qkt<DK>(pA0, pA1, K_lds, qr, r32, hi); partialSM(pA0, pA1, m_reg, alA);
  SLOAD(0, 64);
  SWRITE(1, 0); __syncthreads();
  for (int j = 1; j + 1 < NT; j += 2) {
    SBAR(); qkt<DK>(pB0, pB1, K_lds + SHM_K, qr, r32, hi);
    finishSM(pA0, pA1, alA, l_reg, pa0, pa1, pa2, pa3); SBAR();
    SLOAD(0, (j + 1) * 64); SBAR();
    pv_all(o, vb0, pa0, pa1, pa2, pa3); partialSM(pB0, pB1, m_reg, alB);
    __syncthreads(); SWRITE(0, 0);
    RESC(alB); __syncthreads();
    SBAR(); qkt<DK>(pA0, pA1, K_lds, qr, r32, hi);
    finishSM(pB0, pB1, alB, l_reg, pa0, pa1, pa2, pa3); SBAR();
    SLOAD(0, (j + 2) * 64); SBAR();
    pv_all(o, vb0 + SHM_V, pa0, pa1, pa2, pa3); partialSM(pA0, pA1, m_reg, alA);
    __syncthreads(); SWRITE(1, 0);
    RESC(alA); __syncthreads();
  }
  SBAR(); qkt<DK>(pB0, pB1, K_lds + SHM_K, qr, r32, hi);
  finishSM(pA0, pA1, alA, l_reg, pa0, pa1, pa2, pa3); SBAR();
  pv_all(o, vb0, pa0, pa1, pa2, pa3); partialSM(pB0, pB1, m_reg, alB);
  __syncthreads(); RESC(alB);
  finishSM(pB0, pB1, alB, l_reg, pa0, pa1, pa2, pa3); SBAR();
  pv_all(o, vb0 + SHM_V, pa0, pa1, pa2, pa3);
  if (hi == 0) li_l[r32] = l_reg; asm volatile("s_waitcnt lgkmcnt(0)" ::: "memory");
  float rli[16];
#pragma unroll
  for (int r = 0; r < 16; ++r) rli[r] = __builtin_amdgcn_rcpf(li_l[crow(r, hi)]);
#pragma unroll
  for (int r = 0; r < 16; ++r) {
    const size_t rowo = (size_t)(wid * 32 + crow(r, hi)) * 512;
#pragma unroll
    for (int d0 = 0; d0 < 2; ++d0) {
      const size_t idx = rowo + d0 * 32 + r32;
      const float g = bf2f(Gb[idx]);
      Ob[idx] = (bf16_t)(cvtpk(o[d0][r] * rli[r] * g, 0.f) & 0xffffu);
    }
  }
#undef SLOAD
#undef SWRITE
#undef RESC
}

__device__ __forceinline__ void exp16(f32x16& p) {
#pragma unroll
  for (int r = 0; r < 16; ++r) p[r] = __builtin_amdgcn_exp2f(p[r]);
}
__device__ __forceinline__ void finishFast(f32x16& p0, f32x16& p1, float& l_reg, bf16x8& pa0, bf16x8& pa1, bf16x8& pa2, bf16x8& pa3) {
  exp16(p1);
  float ps = 0.f;
#pragma unroll
  for (int r = 0; r < 16; ++r) ps += p0[r];
#pragma unroll
  for (int r = 0; r < 16; ++r) ps += p1[r];
  l_reg += ps;
#define PK4(P, BASE, OUT) do { unsigned a0 = cvtpk(P[BASE + 0], P[BASE + 1]), a1 = cvtpk(P[BASE + 2], P[BASE + 3]);   \
    unsigned b0 = cvtpk(P[BASE + 4], P[BASE + 5]), b1 = cvtpk(P[BASE + 6], P[BASE + 7]);                              \
    auto r0 = __builtin_amdgcn_permlane32_swap(a0, b0, false, false); auto r1 = __builtin_amdgcn_permlane32_swap(a1, b1, false, false); \
    u32x4 w = {r0[0], r1[0], r0[1], r1[1]}; OUT = *reinterpret_cast<bf16x8*>(&w); } while (0)
  PK4(p0, 0, pa0); PK4(p0, 8, pa1); PK4(p1, 0, pa2); PK4(p1, 8, pa3);
#undef PK4
}
template <int DK>
__device__ __forceinline__ void attn_unit_fast(const bf16_t* Qb, int ldq, const bf16_t* __restrict__ Kh, int ldk, const bf16_t* __restrict__ Krp,
                                               const bf16_t* __restrict__ Vh, int ldv, const bf16_t* Gb, bf16_t* Ob, int seq, char* lds) {
  constexpr int SHM_K = KL<DK>::SHM_K;
  const int tid = opaque_tid(), wid = __builtin_amdgcn_readfirstlane(tid >> 6), lane = tid & 63, r32 = lane & 31, hi = lane >> 5;
  char* V_lds = lds; char* K_lds = lds + 3 * SHM_V;
  float* ws = (float*)(lds + 3 * SHM_V + 3 * SHM_K) + wid * 64; float* li_l = ws;
  float l_reg = 0.f; f32x16 o[2]; bf16x8 qr[DK / 16];
#pragma unroll
  for (int r = 0; r < 16; ++r) { o[0][r] = 0.f; o[1][r] = 0.f; }
  const bf16_t* Qw = Qb + (size_t)(wid * 32 + r32) * ldq + hi * 8;
#pragma unroll
  for (int d0 = 0; d0 < DK / 16; ++d0) qr[d0] = *reinterpret_cast<const bf16x8*>(Qw + d0 * 16);
  const int srow = tid >> 3, sc = tid & 7, vst = v_st(srow, sc * 8), kst = kswz<DK>(srow, sc);
  const int rrow = tid >> 2, rc = tid & 3, krst = kswz<DK>(rrow & 63, 8 + rc);
  const bool dor = (DK == 96) && (wid < 4);
  const int vb0 = (int)(uintptr_t)V_lds + v_rd_base(lane);
  struct { u32x4 v, k, r; } sr_[1];
  const unsigned voff0 = (unsigned)(srow * ldv + sc * 8) * 2u, koff0 = (unsigned)(srow * ldk + sc * 8) * 2u, roff0 = (unsigned)(rrow * 32 + rc * 8) * 2u;
#define SLOAD(i, k0) do { sr_[i].v = *(const u32x4*)((const char*)Vh + (voff0 + (unsigned)((k0) * ldv) * 2u)); sr_[i].k = *(const u32x4*)((const char*)Kh + (koff0 + (unsigned)((k0) * ldk) * 2u)); \
    if (dor) sr_[i].r = *(const u32x4*)((const char*)Krp + (roff0 + (unsigned)((k0) * 64))); } while (0)
#define SWRITE(slot, i) do { *(u32x4*)(V_lds + (slot) * SHM_V + vst) = sr_[i].v; *(u32x4*)(K_lds + (slot) * SHM_K + kst) = sr_[i].k; \
    if (dor) *(u32x4*)(K_lds + (slot) * SHM_K + krst) = sr_[i].r; } while (0)
  f32x16 pA0, pA1, pB0, pB1; bf16x8 pa0, pa1, pa2, pa3; const int NT = seq / 64;
  int sp = 2, st = 0, sn = 1;
#define ROT() do { sp = st; st = sn; sn = (sn == 2) ? 0 : sn + 1; } while (0)
#define STEP(C0, C1, P0, P1, SETW, t, DOW) do { SBAR(); qkt<DK>(C0, C1, K_lds + st * SHM_K, qr, r32, hi); \
    finishFast(P0, P1, l_reg, pa0, pa1, pa2, pa3); \
    if (DOW) { SWRITE(sn, 0); if ((t) + 2 < NT) SLOAD(0, ((t) + 2) * 64); } \
    pv_all(o, vb0 + sp * SHM_V, pa0, pa1, pa2, pa3); exp16(C0); \
    __syncthreads(); ROT(); } while (0)
  __syncthreads();
  SLOAD(0, 0); SWRITE(0, 0); SLOAD(0, 64); __syncthreads();
  qkt<DK>(pA0, pA1, K_lds, qr, r32, hi);
  SWRITE(1, 0); SLOAD(0, 128);
  exp16(pA0);
  __syncthreads(); ROT();
  for (int t = 1; t + 1 < NT; t += 2) {
    STEP(pB0, pB1, pA0, pA1, 0, t, true);
    STEP(pA0, pA1, pB0, pB1, 1, t + 1, true);
  }
  STEP(pB0, pB1, pA0, pA1, 0, NT - 1, false);
  finishFast(pB0, pB1, l_reg, pa0, pa1, pa2, pa3); SBAR();
  pv_all(o, vb0 + sp * SHM_V, pa0, pa1, pa2, pa3);
  { auto rr = __builtin_amdgcn_permlane32_swap(__float_as_uint(l_reg), __float_as_uint(l_reg), false, false);
    l_reg = __uint_as_float(rr[0]) + __uint_as_float(rr[1]); }
  if (hi == 0) li_l[r32] = l_reg; asm volatile("s_waitcnt lgkmcnt(0)" ::: "memory");
  float rli[16];
#pragma unroll
  for (int r = 0; r < 16; ++r) rli[r] = __builtin_amdgcn_rcpf(li_l[crow(r, hi)]);
#pragma unroll
  for (int r = 0; r < 16; ++r) {
    const size_t rowo = (size_t)(wid * 32 + crow(r, hi)) * 512;
#pragma unroll
    for (int d0 = 0; d0 < 2; ++d0) {
      const size_t idx = rowo + d0 * 32 + r32;
      const float g = bf2f(Gb[idx]);
      Ob[idx] = (bf16_t)(cvtpk(o[d0][r] * rli[r] * g, 0.f) & 0xffffu);
    }
  }
#undef SLOAD
#undef SWRITE
#undef ROT
#undef STEP
}

__device__ __forceinline__ void phase_attn(const Params& p, char* lds) {
  char* dout = (char*)p.out;
  const float* bnd = (const float*)(p.ws + OFF_BND);
  const bool fastA = bnd[0] < 60.0f;
  const bool fastB = 3.0f * bnd[1] * (2.0f * bnd[2] + bnd[3]) < 3600.0f;
  for (int u = blockIdx.x; u < 2048; u += gridDim.x) {
    const int i = u >> 8, v = u & 255, cls = i >> 1, sub = i & 1, head = v & 7, j = v >> 3;
    int seq0, seq, tok0;
    if (cls < 2) { seq0 = 0; seq = NP; tok0 = (2 * j + sub) * 256; }
    else { const int bi = j >> 3, qb = 2 * (j & 7) + sub; seq0 = NP + bi * NS; seq = NS; tok0 = seq0 + qb * 256; }
    if ((cls & 1) == 0) {
      bf16_t* QA = (bf16_t*)(p.ws + OFF_QA);
      const bf16_t* Kp = (const bf16_t*)(p.ws + OFF_KA) + (size_t)seq0 * 128 + (head >> 2) * 64;
      const bf16_t* Vp = (const bf16_t*)(p.ws + OFF_VA) + (size_t)seq0 * 128 + (head >> 2) * 64;
      const bf16_t* Gp = (const bf16_t*)(dout + OO_GA) + (size_t)tok0 * 512 + head * 64;
      bf16_t* Qp = QA + (size_t)tok0 * 512 + head * 64;
      if (fastA) attn_unit_fast<64>(Qp, 512, Kp, 128, nullptr, Vp, 128, Gp, Qp, seq, lds);
      else if (ATT_SAFE) attn_unit<64>(Qp, 512, Kp, 128, nullptr, Vp, 128, Gp, Qp, seq, lds);
    } else {
      const bf16_t* Qp = (const bf16_t*)(p.ws + OFF_QB) + (size_t)tok0 * 768 + head * 96;
      const bf16_t* Kp = (const bf16_t*)(p.ws + OFF_KBN) + (size_t)seq0 * 512 + head * 64;
      const bf16_t* Rp = (const bf16_t*)(p.ws + OFF_KR) + (size_t)seq0 * 32;
      const bf16_t* Vp = (const bf16_t*)(p.ws + OFF_VB) + (size_t)seq0 * 512 + head * 64;
      const bf16_t* Gp = (const bf16_t*)(dout + OO_GB) + (size_t)tok0 * 512 + head * 64;
      bf16_t* Op = (bf16_t*)(dout + OO_YB) + (size_t)tok0 * 512 + head * 64;
      if (fastB) attn_unit_fast<96>(Qp, 768, Kp, 512, Rp, Vp, 512, Gp, Op, seq, lds);
      else if (ATT_SAFE) attn_unit<96>(Qp, 768, Kp, 512, Rp, Vp, 512, Gp, Op, seq, lds);
    }
  }
}

#if MK_SINGLE
#ifndef PROBE_MASK
#define PROBE_MASK 0
#endif
__global__ void __launch_bounds__(512) fwd_kernel(Params p) {
  extern __shared__ __attribute__((aligned(16))) char lds[];
#if PROBE_MASK
  volatile unsigned long long* tst = (volatile unsigned long long*)(p.ws + OFF_BND + 64) + blockIdx.x * 16;
  if (threadIdx.x == 0) tst[0] = wall_clock64();
#define STAMP(k) if (threadIdx.x == 0) tst[k + 1] = wall_clock64();
#else
#define STAMP(k)
#endif
#define PHASE(k, call) if (PH_MASK & (1 << k)) { call; if (k < 7) { cg::this_grid().sync(); STAMP(k) } }
  PHASE(0, phase0(p, lds))
  PHASE(1, phase1(p))
  PHASE(2, phase_g1(p, lds))
  PHASE(3, phase_g2(p, lds))
  PHASE(4, phase_attn(p, lds))
  PHASE(5, phase_g3(p, lds))
  PHASE(6, phase_g4(p, lds))
  PHASE(7, phase5(p))
#undef PHASE
#if PROBE_MASK
  if (blockIdx.x == 0) {
    __syncthreads();
    float* dshp = (float*)lds;
    if (threadIdx.x == 0) {
    unsigned long long tot = 0;
    for (int k = 0; k < 7; ++k) if (PROBE_MASK & (1 << k)) tot += tst[k + 1] - tst[k];
    dshp[0] = sqrtf((float)tot * (0.01f / 4000.0f));
    }
    __syncthreads();
    const float d = dshp[0];
    for (int i = threadIdx.x; i < 8 * 1024; i += 512) p.out[i] += d;
  }
#endif
}
#define MAIN_KERNEL fwd_kernel
#else
template <int PH>
__global__ void __launch_bounds__(512) ph_kernel(Params p) {
  extern __shared__ __attribute__((aligned(16))) char lds[];
  if (PH == 0) phase0(p, lds);
  if (PH == 1) phase1(p);
  if (PH == 2) phase_g1(p, lds);
  if (PH == 3) phase_g2(p, lds);
  if (PH == 4) phase_attn(p, lds);
  if (PH == 5) phase_g3(p, lds);
  if (PH == 6) phase_g4(p, lds);
  if (PH == 7) phase5(p);
}
#define MAIN_KERNEL ph_kernel<4>
#endif

extern "C" void kernel_launch(void* const* d_in, const int* in_sizes, int n_in, void* d_out, int out_size, void* d_ws, size_t ws_size,
                              hipStream_t stream) {
  Params p{};
  p.x_prompt = (const float*)d_in[0]; p.x_sample = (const float*)d_in[1]; p.c_prompt = (const float*)d_in[2]; p.c_sample = (const float*)d_in[3];
  p.ada_w = (const float*)d_in[4]; p.ada_b = (const float*)d_in[5]; p.pre_g = (const float*)d_in[6]; p.post_g = (const float*)d_in[7];
  p.w_in = (const float*)d_in[8]; p.a_q_g = (const float*)d_in[9]; p.a_k_g = (const float*)d_in[10]; p.b_q_g = (const float*)d_in[11];
  p.b_q_up = (const float*)d_in[12]; p.b_kv_g = (const float*)d_in[13]; p.b_kv_up = (const float*)d_in[14]; p.a_out = (const float*)d_in[15];
  p.b_out = (const float*)d_in[16]; p.w_o = (const float*)d_in[17];
  p.out = (float*)d_out; p.ws = (char*)d_ws;
  static int grid_blocks = 0;
  if (!grid_blocks) {
    int dev = 0, cus = 0, per_cu = 0;
    (void)hipGetDevice(&dev);
    (void)hipDeviceGetAttribute(&cus, hipDeviceAttributeMultiprocessorCount, dev);
    (void)hipFuncSetAttribute((const void*)MAIN_KERNEL, hipFuncAttributeMaxDynamicSharedMemorySize, LDS_BYTES);
    (void)hipOccupancyMaxActiveBlocksPerMultiprocessor(&per_cu, MAIN_KERNEL, 512, LDS_BYTES);
    if (per_cu < 1) per_cu = 1;
    if (per_cu > 1) per_cu = 1;
    grid_blocks = cus * per_cu;
    if (grid_blocks <= 0) grid_blocks = 256;
  }
#if MK_SINGLE
  void* args[] = {&p};
  hipError_t err = hipLaunchCooperativeKernel((const void*)fwd_kernel, dim3(grid_blocks), dim3(512), args, LDS_BYTES, stream);
  if (err != hipSuccess) fprintf(stderr, "cooperative launch failed: %s (grid %d)\n", hipGetErrorString(err), grid_blocks);
#else
  static bool attr_set = false;
  if (!attr_set) {
    (void)hipFuncSetAttribute((const void*)ph_kernel<0>, hipFuncAttributeMaxDynamicSharedMemorySize, LDS_BYTES);
    (void)hipFuncSetAttribute((const void*)ph_kernel<2>, hipFuncAttributeMaxDynamicSharedMemorySize, LDS_BYTES);
    (void)hipFuncSetAttribute((const void*)ph_kernel<3>, hipFuncAttributeMaxDynamicSharedMemorySize, LDS_BYTES);
    (void)hipFuncSetAttribute((const void*)ph_kernel<5>, hipFuncAttributeMaxDynamicSharedMemorySize, LDS_BYTES);
    (void)hipFuncSetAttribute((const void*)ph_kernel<6>, hipFuncAttributeMaxDynamicSharedMemorySize, LDS_BYTES);
    attr_set = true;
  }
  hipLaunchKernelGGL(ph_kernel<0>, dim3(grid_blocks), dim3(512), LDS_BYTES, stream, p);
  hipLaunchKernelGGL(ph_kernel<1>, dim3(grid_blocks), dim3(512), LDS_BYTES, stream, p);
  hipLaunchKernelGGL(ph_kernel<2>, dim3(grid_blocks), dim3(512), LDS_BYTES, stream, p);
  hipLaunchKernelGGL(ph_kernel<3>, dim3(grid_blocks), dim3(512), LDS_BYTES, stream, p);
  hipLaunchKernelGGL(ph_kernel<4>, dim3(grid_blocks), dim3(512), LDS_BYTES, stream, p);
  hipLaunchKernelGGL(ph_kernel<5>, dim3(grid_blocks), dim3(512), LDS_BYTES, stream, p);
  hipLaunchKernelGGL(ph_kernel<6>, dim3(grid_blocks), dim3(512), LDS_BYTES, stream, p);
  hipLaunchKernelGGL(ph_kernel<7>, dim3(grid_blocks), dim3(512), LDS_BYTES, stream, p);
#endif
}
```

```cpp
#include <hip/hip_runtime.h>
#include <hip/hip_cooperative_groups.h>
#include <stdint.h>
#include <cstdio>
namespace cg = cooperative_groups;

#ifndef MK_SINGLE
#define MK_SINGLE 1
#endif
#ifndef QKT_SB
#define QKT_SB 0
#endif
#ifndef ATT_SAFE
#define ATT_SAFE 1
#endif
#ifndef PH_MASK
#define PH_MASK 255
#endif

typedef unsigned short bf16_t;
typedef short bf16x8 __attribute__((ext_vector_type(8)));
typedef short s16x4 __attribute__((ext_vector_type(4)));
typedef float f32x16 __attribute__((ext_vector_type(16)));
typedef unsigned u32x4 __attribute__((ext_vector_type(4)));
typedef unsigned u32x2 __attribute__((ext_vector_type(2)));

constexpr int T = 32768, NP = 16384, NS = 4096, DM = 1024;
constexpr float EPS = 1e-6f;
constexpr float LOG2E = 1.4426950408889634f;
constexpr float PS_A = 0.125f * LOG2E;
constexpr float PS_B = 0.10206207261596575f * LOG2E;

constexpr size_t U = 67108864ull;
constexpr size_t OFF_H = 0;
constexpr size_t OFF_QA = U;
constexpr size_t OFF_KA = U + U / 2;
constexpr size_t OFF_VA = OFF_KA + U / 8;
constexpr size_t OFF_KR = OFF_VA + U / 8;
constexpr size_t OFF_PART = OFF_KR + 2097152;
constexpr size_t OFF_QB = 2 * U;
constexpr size_t OFF_KBN = OFF_QB + (U / 4) * 3;
constexpr size_t OFF_VB = OFF_KBN + U / 2;
constexpr size_t OFF_W = OFF_VB + U / 2;
constexpr size_t OFF_WIN = OFF_W;
constexpr size_t OFF_WQUP = OFF_WIN + 4608ull * 1024 * 2;
constexpr size_t OFF_WKVUP = OFF_WQUP + 768ull * 384 * 2;
constexpr size_t OFF_WAOUT = OFF_WKVUP + 1024ull * 256 * 2;
constexpr size_t OFF_WBOUT = OFF_WAOUT + 1024ull * 512 * 2;
constexpr size_t OFF_WO = OFF_WBOUT + 1024ull * 512 * 2;
constexpr size_t OFF_MOD = OFF_WO + 1024ull * 1024 * 2;
constexpr size_t OFF_SSQ = OFF_MOD + 5 * 3072 * 4;
constexpr size_t OFF_TABA = OFF_SSQ + 3ull * T * 4;
constexpr size_t OFF_TABB = OFF_TABA + 256 * 16 * 8;
constexpr size_t OFF_BND = OFF_TABB + 256 * 8 * 8;
constexpr size_t OFF_BAR = OFF_BND + 128;
constexpr size_t WS_END = OFF_BND + 256 + 256 * 128;
static_assert(WS_END <= 4 * U, "workspace map exceeds 256 MiB");
constexpr size_t OO_BQ = 0;
constexpr size_t OO_BKV = (size_t)T * 384 * 2;
constexpr size_t OO_YB = 0;
constexpr size_t OO_GA = U;
constexpr size_t OO_GB = U + U / 2;
constexpr size_t OO_MERGED = U;

constexpr int LDS_BYTES = 163840;

struct Params {
  const float *x_prompt, *x_sample, *c_prompt, *c_sample, *ada_w, *ada_b, *pre_g, *post_g, *w_in, *a_q_g, *a_k_g, *b_q_g, *b_q_up,
      *b_kv_g, *b_kv_up, *a_out, *b_out, *w_o;
  float* out;
  char* ws;
};

__device__ __forceinline__ int opaque_tid() { int t = threadIdx.x; asm volatile("" : "+v"(t)); return t; }
typedef float f32x2_t __attribute__((ext_vector_type(2)));
typedef __bf16 bf16x2_t __attribute__((ext_vector_type(2)));
__device__ __forceinline__ unsigned cvtpk(float lo, float hi) { f32x2_t v = {lo, hi}; bf16x2_t b = __builtin_convertvector(v, bf16x2_t); return __builtin_bit_cast(unsigned, b); }
__device__ __forceinline__ float bf2f(unsigned short v) { return __uint_as_float(((unsigned)v) << 16); }
__device__ __forceinline__ int crow(int r, int hi) { return (r & 3) + 8 * (r >> 2) + 4 * hi; }
__device__ __forceinline__ void st4(bf16_t* p, float a, float b, float c, float d) { u32x2 w; w.x = cvtpk(a, b); w.y = cvtpk(c, d); *(u32x2*)p = w; }
__device__ __forceinline__ float sigmoidf_(float v) { return 1.0f / (1.0f + __expf(-v)); }
__device__ __forceinline__ const float* xrow_ptr(const Params& p, int tok) { return tok < NP ? p.x_prompt + (size_t)tok * DM : p.x_sample + (size_t)(tok - NP) * DM; }
__device__ __forceinline__ int batch_of(int tok) { return tok < NP ? 0 : 1 + ((tok - NP) >> 12); }
__device__ __forceinline__ int pos_of(int tok) { return tok < NP ? tok : ((tok - NP) & 4095); }

__device__ __forceinline__ int win_src(int n) {
  if (n < 768) return n;
  if (n < 1152) return 1280 + (n - 768);
  if (n < 1408) return 1664 + (n - 1152);
  if (n < 1440) return 1920 + (n - 1408);
  if (n < 1536) return -1;
  if (n < 2048) return 768 + (n - 1536);
  if (n < 2560) return 1952 + (n - 2048);
  return 2464 + (n - 2560);
}
__device__ __forceinline__ void cvt_tile(const float* __restrict__ W, int ldn, int K, bf16_t* __restrict__ dst, bool remap,
                                         const float* __restrict__ gain, int item, float* tl  , int tid) {
  const int ktiles = K >> 6, n0 = (item / ktiles) * 64, k0 = (item % ktiles) * 64;
  __syncthreads();
  {
    const int n4 = (tid & 15) * 4, kr = tid >> 4;
    const int nd = n0 + n4;
    const int src = remap ? win_src(nd) : nd;
#pragma unroll
    for (int i = 0; i < 2; ++i) {
      const int k = kr + 32 * i;
      float4 v = make_float4(0.f, 0.f, 0.f, 0.f);
      if (src >= 0) v = *(const float4*)(W + (size_t)(k0 + k) * ldn + src);
      if (gain) { const float g = gain[k0 + k]; v.x *= g; v.y *= g; v.z *= g; v.w *= g; }
      float* r = tl + k * 65 + n4;
      r[0] = v.x; r[1] = v.y; r[2] = v.z; r[3] = v.w;
    }
  }
  __syncthreads();
  {
    const int n = tid >> 3, kc = tid & 7;
    const float* c = tl + (kc * 8) * 65 + n;
    u32x4 o; o.x = cvtpk(c[0], c[65]); o.y = cvtpk(c[130], c[195]); o.z = cvtpk(c[260], c[325]); o.w = cvtpk(c[390], c[455]);
    *(u32x4*)(dst + (size_t)(n0 + n) * K + k0 + kc * 8) = o;
  }
}

__device__ __forceinline__ void phase0(const Params& p, char* lds) {
  const int tid = opaque_tid(), gsz = gridDim.x * 512, gtid = blockIdx.x * 512 + tid;
  if (gtid == 0) {
    float* bnd = (float*)(p.ws + OFF_BND);
    float gq = 0.f, gk = 0.f;
    for (int i = 0; i < 64; ++i) { gq = fmaxf(gq, fabsf(p.a_q_g[i])); gk = fmaxf(gk, fabsf(p.a_k_g[i])); }
    bnd[0] = 64.0f * gq * gk * PS_A;
    bnd[1] = 0.f; bnd[2] = 0.f; bnd[3] = 0.f;
    __hip_atomic_store((unsigned*)(p.ws + OFF_BAR), 0u, __ATOMIC_RELAXED, __HIP_MEMORY_SCOPE_AGENT);
  }
  float2* tabA = (float2*)(p.ws + OFF_TABA);
  float2* tabB = (float2*)(p.ws + OFF_TABB);
  for (int i = gtid; i < 256 * 16 + 256 * 8; i += gsz) {
    int pos, f; float inv;
    const float L2T = 13.287712379549449f;
    if (i < 4096) { pos = i >> 4; f = i & 15; inv = exp2f(-(float)f * (1.0f / 16.0f) * L2T); }
    else { int k = i - 4096; pos = k >> 3; f = k & 7; inv = exp2f(-(float)f * (1.0f / 8.0f) * L2T); }
    float ang = (float)pos * inv;
    float rev = ang * 0.15915494309189535f; rev -= floorf(rev);
    float2 cs; cs.x = __builtin_amdgcn_cosf(rev); cs.y = __builtin_amdgcn_sinf(rev);
    if (i < 4096) tabA[i] = cs; else tabB[i - 4096] = cs;
  }
  {
    float* tl = (float*)(lds + 16384);
    for (int it = blockIdx.x; it < 1800; it += gridDim.x) {
      if (it < 1152) cvt_tile(p.w_in, 4512, 1024, (bf16_t*)(p.ws + OFF_WIN), true, nullptr, it, tl, tid);
      else if (it < 1224) cvt_tile(p.b_q_up, 768, 384, (bf16_t*)(p.ws + OFF_WQUP), false, p.b_q_g, it - 1152, tl, tid);
      else if (it < 1288) cvt_tile(p.b_kv_up, 1024, 256, (bf16_t*)(p.ws + OFF_WKVUP), false, p.b_kv_g, it - 1224, tl, tid);
      else if (it < 1416) cvt_tile(p.a_out, 1024, 512, (bf16_t*)(p.ws + OFF_WAOUT), false, nullptr, it - 1288, tl, tid);
      else if (it < 1544) cvt_tile(p.b_out, 1024, 512, (bf16_t*)(p.ws + OFF_WBOUT), false, nullptr, it - 1416, tl, tid);
      else cvt_tile(p.w_o, 1024, 1024, (bf16_t*)(p.ws + OFF_WO), false, nullptr, it - 1544, tl, tid);
    }
  }
  float* red = (float*)lds;
  float* sl = (float*)(lds + 16384);
  float* mod = (float*)(p.ws + OFF_MOD);
  __syncthreads();
  for (int i = tid; i < 5 * 1024; i += 512) { const float cv = i < 1024 ? p.c_prompt[i] : p.c_sample[i - 1024]; sl[i] = cv * sigmoidf_(cv); }
  __syncthreads();
  for (int it = blockIdx.x; it < 256; it += gridDim.x) {
    const int c = tid & 15, kg = tid >> 4;
    float a0 = 0.f, a1 = 0.f, a2 = 0.f, a3 = 0.f, a4 = 0.f;
    if (c < 12) {
      const float* wp = p.ada_w + it * 12 + c;
#pragma unroll 8
      for (int k = kg; k < 1024; k += 32) {
        const float w = wp[(size_t)k * 3072];
        a0 += sl[k] * w; a1 += sl[1024 + k] * w; a2 += sl[2048 + k] * w; a3 += sl[3072 + k] * w; a4 += sl[4096 + k] * w;
      }
    }
    float* rp = red + (kg * 16 + c) * 5;
    rp[0] = a0; rp[1] = a1; rp[2] = a2; rp[3] = a3; rp[4] = a4;
    __syncthreads();
    if (tid < 60) {
      const int cc = tid / 5, b = tid % 5;
      float s = 0.f;
      for (int g = 0; g < 32; ++g) s += red[(g * 16 + cc) * 5 + b];
      const int col = it * 12 + cc;
      mod[b * 3072 + col] = s + p.ada_b[col];
    }
    __syncthreads();
  }
}

__device__ __forceinline__ float wave_sum(float v) {
#pragma unroll
  for (int o = 32; o >= 1; o >>= 1) v += __shfl_xor(v, o);
  return v;
}
__device__ __forceinline__ void phase1(const Params& p) {
  const int tid = opaque_tid(), wid = tid >> 6, lane = tid & 63;
  const float* mod = (const float*)(p.ws + OFF_MOD);
  bf16_t* H = (bf16_t*)(p.ws + OFF_H);
  const int NW = gridDim.x * 8;
  for (int row0 = blockIdx.x * 8 + wid; row0 < T; row0 += 4 * NW) {
    float4 v[4][4];
#pragma unroll
    for (int j = 0; j < 4; ++j) {
      const int row = row0 + j * NW;
      if (row < T) {
        const float* xr = xrow_ptr(p, row);
#pragma unroll
        for (int i = 0; i < 4; ++i) v[j][i] = *(const float4*)(xr + i * 256 + lane * 4);
      }
    }
#pragma unroll
    for (int j = 0; j < 4; ++j) {
      const int row = row0 + j * NW;
      if (row < T) {
        const int b = batch_of(row);
        float ss = 0.f;
#pragma unroll
        for (int i = 0; i < 4; ++i) ss += v[j][i].x * v[j][i].x + v[j][i].y * v[j][i].y + v[j][i].z * v[j][i].z + v[j][i].w * v[j][i].w;
        ss = wave_sum(ss);
        const float rn = rsqrtf(ss * (1.0f / 1024.0f) + EPS);
#pragma unroll
        for (int i = 0; i < 4; ++i) {
          const int col = i * 256 + lane * 4;
          const float4 g = *(const float4*)(p.pre_g + col);
          const float4 sh = *(const float4*)(mod + b * 3072 + col);
          const float4 sc = *(const float4*)(mod + b * 3072 + 1024 + col);
          st4(H + (size_t)row * DM + col, v[j][i].x * rn * g.x * (1.f + sc.x) + sh.x, v[j][i].y * rn * g.y * (1.f + sc.y) + sh.y,
              v[j][i].z * rn * g.z * (1.f + sc.z) + sh.z, v[j][i].w * rn * g.w * (1.f + sc.w) + sh.w);
        }
      }
    }
  }
}

constexpr int G_XB = 256 * 128, G_WB = 128 * 128, G_STAGE = G_XB + G_WB;
__device__ __forceinline__ int gswz(int row, int c) { return row * 128 + ((c ^ ((row >> 1) & 7)) << 4); }

__device__ __forceinline__ void gemm_kloop(const bf16_t* __restrict__ X, int ldx, const bf16_t* __restrict__ W, int ldw, int nk,
                                           f32x16 (&acc)[2][2], char* lds) {
  const int tid = opaque_tid(), wid = __builtin_amdgcn_readfirstlane(tid >> 6), lane = tid & 63, r32 = lane & 31, hi = lane >> 5, wm = wid & 3, wn = wid >> 2;
  const int srow = tid >> 3, sch = tid & 7;
  const char* xg = (const char*)X;
  const char* wg = (const char*)W;
  const unsigned xstep = (unsigned)ldx * 128u, wstep = (unsigned)ldw * 128u;
  const unsigned xo0 = (unsigned)(srow * ldx + sch * 8) * 2u, wo0 = (unsigned)(srow * ldw + sch * 8) * 2u;
  const int sw = gswz(srow, sch);
  u32x4 xa[4], wa[2], xb[4], wb[2];
  const int fsw = (r32 >> 1) & 7;
  int koff[4];
#pragma unroll
  for (int ks = 0; ks < 4; ++ks) koff[ks] = ((2 * ks + hi) ^ fsw) << 4;
  const int rowA = G_XB + (wn * 64 + r32) * 128, rowB = (wm * 64 + r32) * 128;
#define GLOAD(xr, wr, kt) do { _Pragma("unroll") for (int i = 0; i < 4; ++i) xr[i] = *(const u32x4*)(xg + (xo0 + i * xstep + (unsigned)(kt) * 128u)); \
    _Pragma("unroll") for (int i = 0; i < 2; ++i) wr[i] = *(const u32x4*)(wg + (wo0 + i * wstep + (unsigned)(kt) * 128u)); } while (0)
#define GWRITE(s, xr, wr) do { char* b_ = lds + (s) * G_STAGE; _Pragma("unroll") for (int i = 0; i < 4; ++i) *(u32x4*)(b_ + sw + i * 8192) = xr[i]; \
    _Pragma("unroll") for (int i = 0; i < 2; ++i) *(u32x4*)(b_ + G_XB + sw + i * 8192) = wr[i]; } while (0)
#define GCOMPUTE(s) do { const char* sb = lds + (s) * G_STAGE; _Pragma("unroll") for (int ks = 0; ks < 4; ++ks) { \
      const bf16x8 a0 = *(const bf16x8*)(sb + rowA + koff[ks]); const bf16x8 a1 = *(const bf16x8*)(sb + rowA + 4096 + koff[ks]); \
      const bf16x8 b0 = *(const bf16x8*)(sb + rowB + koff[ks]); const bf16x8 b1 = *(const bf16x8*)(sb + rowB + 4096 + koff[ks]); \
      acc[0][0] = __builtin_amdgcn_mfma_f32_32x32x16_bf16(a0, b0, acc[0][0], 0, 0, 0); acc[0][1] = __builtin_amdgcn_mfma_f32_32x32x16_bf16(a0, b1, acc[0][1], 0, 0, 0); \
      acc[1][0] = __builtin_amdgcn_mfma_f32_32x32x16_bf16(a1, b0, acc[1][0], 0, 0, 0); acc[1][1] = __builtin_amdgcn_mfma_f32_32x32x16_bf16(a1, b1, acc[1][1], 0, 0, 0); } } while (0)
  __syncthreads();
  GLOAD(xa, wa, 0); GLOAD(xb, wb, 1); GWRITE(0, xa, wa); __syncthreads();
#pragma nounroll
  for (int kt = 0; kt < nk; kt += 2) {
    const int ka = kt + 2 < nk ? kt + 2 : nk - 2, kb = kt + 3 < nk ? kt + 3 : nk - 1;
    GLOAD(xa, wa, ka);
    GCOMPUTE(0);
    GWRITE(1, xb, wb);
    __syncthreads();
    GLOAD(xb, wb, kb);
    GCOMPUTE(1);
    GWRITE(0, xa, wa);
    __syncthreads();
  }
  asm volatile("s_waitcnt vmcnt(0)" ::: "memory");
#undef GLOAD
#undef GWRITE
#undef GCOMPUTE
}
__device__ __forceinline__ void zero_acc(f32x16 (&acc)[2][2]) {
#pragma unroll
  for (int a = 0; a < 2; ++a)
#pragma unroll
    for (int b = 0; b < 2; ++b)
#pragma unroll
      for (int r = 0; r < 16; ++r) acc[a][b][r] = 0.f;
}

__device__ __forceinline__ void stage_put(char* wb, int t, int q, float a, float b, float c, float d) {
  u32x2 w; w.x = cvtpk(a, b); w.y = cvtpk(c, d);
  *(u32x2*)(wb + t * 128 + ((q ^ ((t & 7) << 1)) << 3)) = w;
}
__device__ __forceinline__ void stage_flush(const char* wb, bf16_t* dst, int ld, int lane) {
#pragma unroll
  for (int i = 0; i < 8; ++i) {
    const int row = i * 8 + (lane >> 3), c = lane & 7;
    const u32x4 v = *(const u32x4*)(wb + row * 128 + ((c ^ (row & 7)) << 4));
    *(u32x4*)(dst + (size_t)row * ld + c * 8) = v;
  }
}
__device__ __forceinline__ void stage_flush_add(const char* wb, bf16_t* dst, int ld, int lane) {
#pragma unroll
  for (int i = 0; i < 8; ++i) {
    const int row = i * 8 + (lane >> 3), c = lane & 7;
    const u32x4 v = *(const u32x4*)(wb + row * 128 + ((c ^ (row & 7)) << 4));
    u32x4* gp = (u32x4*)(dst + (size_t)row * ld + c * 8);
    const u32x4 o = *gp;
    u32x4 r;
    r.x = cvtpk(__uint_as_float(v.x << 16) + __uint_as_float(o.x << 16), __uint_as_float(v.x & 0xffff0000u) + __uint_as_float(o.x & 0xffff0000u));
    r.y = cvtpk(__uint_as_float(v.y << 16) + __uint_as_float(o.y << 16), __uint_as_float(v.y & 0xffff0000u) + __uint_as_float(o.y & 0xffff0000u));
    r.z = cvtpk(__uint_as_float(v.z << 16) + __uint_as_float(o.z << 16), __uint_as_float(v.z & 0xffff0000u) + __uint_as_float(o.z & 0xffff0000u));
    r.w = cvtpk(__uint_as_float(v.w << 16) + __uint_as_float(o.w << 16), __uint_as_float(v.w & 0xffff0000u) + __uint_as_float(o.w & 0xffff0000u));
    *gp = r;
  }
}
__device__ __forceinline__ void epi_rope64(const f32x16& a0, const f32x16& a1, int t, const float* __restrict__ gain, float ps,
                                           const float2* __restrict__ tabA, char* wb, int tl, int hi) {
  float ss = 0.f;
#pragma unroll
  for (int r = 0; r < 16; ++r) ss += a0[r] * a0[r] + a1[r] * a1[r];
  ss += __shfl_xor(ss, 32);
  const float rn = rsqrtf(ss * (1.0f / 64.0f) + EPS);
  const int prow = t >> 6, pcol = t & 63;
#pragma unroll
  for (int g = 0; g < 4; ++g) {
    const int f0 = 8 * (g & 1) + 4 * hi, pos = g < 2 ? prow : pcol, d = 8 * g + 4 * hi;
    const float4* tp = (const float4*)(tabA + pos * 16 + f0);
    const float4 t01 = tp[0], t23 = tp[1];
    const float4 g1 = *(const float4*)(gain + d), g2 = *(const float4*)(gain + 32 + d);
    const float x10 = a0[4 * g + 0] * rn * g1.x, x11 = a0[4 * g + 1] * rn * g1.y, x12 = a0[4 * g + 2] * rn * g1.z, x13 = a0[4 * g + 3] * rn * g1.w;
    const float x20 = a1[4 * g + 0] * rn * g2.x, x21 = a1[4 * g + 1] * rn * g2.y, x22 = a1[4 * g + 2] * rn * g2.z, x23 = a1[4 * g + 3] * rn * g2.w;
    stage_put(wb, tl, 2 * g + hi, (x10 * t01.x - x20 * t01.y) * ps, (x11 * t01.z - x21 * t01.w) * ps, (x12 * t23.x - x22 * t23.y) * ps, (x13 * t23.z - x23 * t23.w) * ps);
    stage_put(wb, tl, 8 + 2 * g + hi, (x20 * t01.x + x10 * t01.y) * ps, (x21 * t01.z + x11 * t01.w) * ps, (x22 * t23.x + x12 * t23.y) * ps, (x23 * t23.z + x13 * t23.w) * ps);
  }
}
__device__ __forceinline__ void rope32_vals(const f32x16& a, float mul, int t, const float2* __restrict__ tabB, int hi, int g, float (&o1)[4], float (&o2)[4]) {
  const int pos = g == 0 ? (t >> 6) : (t & 63);
  const float4* tp = (const float4*)(tabB + pos * 8 + 4 * hi);
  const float4 t01 = tp[0], t23 = tp[1];
  const float x10 = a[4 * g + 0] * mul, x11 = a[4 * g + 1] * mul, x12 = a[4 * g + 2] * mul, x13 = a[4 * g + 3] * mul;
  const float x20 = a[8 + 4 * g + 0] * mul, x21 = a[8 + 4 * g + 1] * mul, x22 = a[8 + 4 * g + 2] * mul, x23 = a[8 + 4 * g + 3] * mul;
  o1[0] = x10 * t01.x - x20 * t01.y; o1[1] = x11 * t01.z - x21 * t01.w; o1[2] = x12 * t23.x - x22 * t23.y; o1[3] = x13 * t23.z - x23 * t23.w;
  o2[0] = x20 * t01.x + x10 * t01.y; o2[1] = x21 * t01.z + x11 * t01.w; o2[2] = x22 * t23.x + x12 * t23.y; o2[3] = x23 * t23.z + x13 * t23.w;
}
__device__ __forceinline__ void epi_rope32(const f32x16& a, float mul, int t, const float2* __restrict__ tabB, char* wb, int tl, int qb, int hi) {
#pragma unroll
  for (int g = 0; g < 2; ++g) {
    float o1[4], o2[4];
    rope32_vals(a, mul, t, tabB, hi, g, o1, o2);
    stage_put(wb, tl, qb + 2 * g + hi, o1[0], o1[1], o1[2], o1[3]);
    stage_put(wb, tl, qb + 4 + 2 * g + hi, o2[0], o2[1], o2[2], o2[3]);
  }
}
__device__ __forceinline__ void epi_rope32_direct(const f32x16& a, float mul, int t, const float2* __restrict__ tabB, bf16_t* dst, int hi) {
#pragma unroll
  for (int g = 0; g < 2; ++g) {
    float o1[4], o2[4];
    rope32_vals(a, mul, t, tabB, hi, g, o1, o2);
    st4(dst + 8 * g + 4 * hi, o1[0], o1[1], o1[2], o1[3]);
    st4(dst + 16 + 8 * g + 4 * hi, o2[0], o2[1], o2[2], o2[3]);
  }
}
__device__ __forceinline__ void epi_plain32(const f32x16& a, float mul, char* wb, int tl, int qb, int hi) {
#pragma unroll
  for (int g = 0; g < 4; ++g) stage_put(wb, tl, qb + 2 * g + hi, a[4 * g] * mul, a[4 * g + 1] * mul, a[4 * g + 2] * mul, a[4 * g + 3] * mul);
}
__device__ __forceinline__ void epi_silu32(const f32x16& a, char* wb, int tl, int qb, int hi) {
#pragma unroll
  for (int g = 0; g < 4; ++g)
    stage_put(wb, tl, qb + 2 * g + hi, a[4 * g] * sigmoidf_(a[4 * g]), a[4 * g + 1] * sigmoidf_(a[4 * g + 1]), a[4 * g + 2] * sigmoidf_(a[4 * g + 2]),
              a[4 * g + 3] * sigmoidf_(a[4 * g + 3]));
}
__device__ __forceinline__ float sumsq16(const f32x16& a) {
  float s = 0.f;
#pragma unroll
  for (int r = 0; r < 16; ++r) s += a[r] * a[r];
  return s;
}

struct TileIter {
  int q, step, end, NT, mbase; bool xcd;
  __device__ __forceinline__ TileIter(int nt_count) {
    NT = nt_count; xcd = (gridDim.x == 256);
    if (xcd) { q = blockIdx.x >> 3; step = 32; end = 16 * NT; mbase = (blockIdx.x & 7) * 16; }
    else { q = blockIdx.x; step = gridDim.x; end = 128 * NT; mbase = 0; }
  }
  __device__ __forceinline__ bool next(int& mt, int& nt) { if (q >= end) return false; mt = mbase + q / NT; nt = q % NT; q += step; return true; }
};

__device__ __forceinline__ void bound_max(float* dst, float v) {
#pragma unroll
  for (int o = 32; o >= 1; o >>= 1) v = fmaxf(v, __shfl_xor(v, o));
  if ((threadIdx.x & 63) == 0) atomicMax((unsigned*)dst, __float_as_uint(v));
}
__device__ __forceinline__ void phase_g1(const Params& p, char* lds) {
  const int tid = opaque_tid(), wid = __builtin_amdgcn_readfirstlane(tid >> 6), lane = tid & 63, r32 = lane & 31, hi = lane >> 5, wm = wid & 3, wn = wid >> 2;
  const bf16_t* H = (const bf16_t*)(p.ws + OFF_H);
  const bf16_t* WIN = (const bf16_t*)(p.ws + OFF_WIN);
  const float2* tabA = (const float2*)(p.ws + OFF_TABA);
  const float2* tabB = (const float2*)(p.ws + OFF_TABB);
  float* part = (float*)(p.ws + OFF_PART);
  char* dout = (char*)p.out;
  float bmax_kr = 0.f;
  TileIter it(20); int mt, nt;
  while (it.next(mt, nt)) {
    const int m0 = mt * 256;
    f32x16 acc[2][2];
    zero_acc(acc);
    gemm_kloop(H + (size_t)m0 * DM, DM, WIN + (size_t)nt * 128 * DM, DM, 16, acc, lds);
    char* wb = lds + wid * 8192;
    const int tok0 = m0 + wm * 64;
#pragma unroll
    for (int ti = 0; ti < 2; ++ti) {
      const int tl = ti * 32 + r32, tok = tok0 + tl;
      const int t = pos_of(tok);
      if (nt < 4) {
        epi_rope64(acc[0][ti], acc[1][ti], t, p.a_q_g, PS_A, tabA, wb, tl, hi);
      } else if (nt == 4) {
        epi_rope64(acc[0][ti], acc[1][ti], t, p.a_k_g, 1.0f, tabA, wb, tl, hi);
      } else if (nt == 5) {
        epi_plain32(acc[0][ti], 1.0f, wb, tl, 0, hi); epi_plain32(acc[1][ti], 1.0f, wb, tl, 8, hi);
      } else if (nt < 9) {
        epi_plain32(acc[0][ti], 1.0f, wb, tl, 0, hi); epi_plain32(acc[1][ti], 1.0f, wb, tl, 8, hi);
        float s = sumsq16(acc[0][ti]) + sumsq16(acc[1][ti]); s += __shfl_xor(s, 32);
        if (hi == 0) part[((nt - 6) * 2 + wn) * T + tok] = s;
      } else if (nt < 11) {
        epi_plain32(acc[0][ti], 1.0f, wb, tl, 0, hi); epi_plain32(acc[1][ti], 1.0f, wb, tl, 8, hi);
        float s = sumsq16(acc[0][ti]) + sumsq16(acc[1][ti]); s += __shfl_xor(s, 32);
        if (hi == 0) part[(6 + (nt - 9) * 2 + wn) * T + tok] = s;
      } else if (nt == 11) {
        if (wn == 0) {
          epi_rope32_direct(acc[0][ti], 1.0f, t, tabB, (bf16_t*)(p.ws + OFF_KR) + (size_t)tok * 32, hi);
          float s = sumsq16(acc[0][ti]); s += __shfl_xor(s, 32);
          bmax_kr = fmaxf(bmax_kr, s);
        }
      } else {
        epi_silu32(acc[0][ti], wb, tl, 0, hi); epi_silu32(acc[1][ti], wb, tl, 8, hi);
      }
    }
    if (nt != 11) {
      bf16_t* dst; int ld;
      if (nt < 4) { dst = (bf16_t*)(p.ws + OFF_QA) + (size_t)tok0 * 512 + (nt * 2 + wn) * 64; ld = 512; }
      else if (nt == 4) { dst = (bf16_t*)(p.ws + OFF_KA) + (size_t)tok0 * 128 + wn * 64; ld = 128; }
      else if (nt == 5) { dst = (bf16_t*)(p.ws + OFF_VA) + (size_t)tok0 * 128 + wn * 64; ld = 128; }
      else if (nt < 9) { dst = (bf16_t*)(dout + OO_BQ) + (size_t)tok0 * 384 + (nt - 6) * 128 + wn * 64; ld = 384; }
      else if (nt < 11) { dst = (bf16_t*)(dout + OO_BKV) + (size_t)tok0 * 256 + (nt - 9) * 128 + wn * 64; ld = 256; }
      else if (nt < 16) { dst = (bf16_t*)(dout + OO_GA) + (size_t)tok0 * 512 + (nt - 12) * 128 + wn * 64; ld = 512; }
      else { dst = (bf16_t*)(dout + OO_GB) + (size_t)tok0 * 512 + (nt - 16) * 128 + wn * 64; ld = 512; }
      stage_flush(wb, dst, ld, lane);
    }
  }
  bound_max((float*)(p.ws + OFF_BND) + 3, bmax_kr);
}

__device__ __forceinline__ void phase_g2(const Params& p, char* lds) {
  const int tid = opaque_tid(), wid = __builtin_amdgcn_readfirstlane(tid >> 6), lane = tid & 63, r32 = lane & 31, hi = lane >> 5, wm = wid & 3, wn = wid >> 2;
  const float2* tabB = (const float2*)(p.ws + OFF_TABB);
  const float* part = (const float*)(p.ws + OFF_PART);
  char* dout = (char*)p.out;
  float bmax_q = 0.f, bmax_k = 0.f;
  TileIter it(14); int mt, j;
  while (it.next(mt, j)) {
    const int m0 = mt * 256;
    f32x16 acc[2][2];
    zero_acc(acc);
    char* wb = lds + wid * 8192;
    const int tok0 = m0 + wm * 64;
    if (j < 6) {
      gemm_kloop((const bf16_t*)(dout + OO_BQ) + (size_t)m0 * 384, 384, (const bf16_t*)(p.ws + OFF_WQUP) + (size_t)j * 128 * 384, 384, 6, acc, lds);
#pragma unroll
      for (int ti = 0; ti < 2; ++ti) {
        const int tl = ti * 32 + r32, tok = tok0 + tl;
        const int t = pos_of(tok);
        const float sq = (part[tok] + part[T + tok]) + (part[2 * T + tok] + part[3 * T + tok]) + (part[4 * T + tok] + part[5 * T + tok]);
        const float rn = rsqrtf(sq * (1.0f / 384.0f) + EPS) * PS_B;
#pragma unroll
        for (int fi = 0; fi < 2; ++fi) {
          const int blk = j * 4 + wn * 2 + fi;
          if (blk % 3 == 2) epi_rope32(acc[fi][ti], rn, t, tabB, wb, tl, fi * 8, hi);
          else epi_plain32(acc[fi][ti], rn, wb, tl, fi * 8, hi);
          float s = sumsq16(acc[fi][ti]); s += __shfl_xor(s, 32);
          bmax_q = fmaxf(bmax_q, s * rn * rn);
        }
      }
      stage_flush(wb, (bf16_t*)(p.ws + OFF_QB) + (size_t)tok0 * 768 + (j * 4 + wn * 2) * 32, 768, lane);
    } else {
      const int jn = j - 6;
      gemm_kloop((const bf16_t*)(dout + OO_BKV) + (size_t)m0 * 256, 256, (const bf16_t*)(p.ws + OFF_WKVUP) + (size_t)jn * 128 * 256, 256, 4, acc, lds);
#pragma unroll
      for (int ti = 0; ti < 2; ++ti) {
        const int tl = ti * 32 + r32, tok = tok0 + tl;
        const float sk = (part[6 * T + tok] + part[7 * T + tok]) + (part[8 * T + tok] + part[9 * T + tok]);
        const float rn = rsqrtf(sk * (1.0f / 256.0f) + EPS);
        epi_plain32(acc[0][ti], rn, wb, tl, 0, hi); epi_plain32(acc[1][ti], rn, wb, tl, 8, hi);
        if (wn == 0) {
          float s0 = sumsq16(acc[0][ti]), s1 = sumsq16(acc[1][ti]); s0 += __shfl_xor(s0, 32); s1 += __shfl_xor(s1, 32);
          bmax_k = fmaxf(bmax_k, fmaxf(s0, s1) * rn * rn);
        }
      }
      stage_flush(wb, (bf16_t*)(p.ws + (wn == 0 ? OFF_KBN : OFF_VB)) + (size_t)tok0 * 512 + jn * 64, 512, lane);
    }
  }
  bound_max((float*)(p.ws + OFF_BND) + 1, bmax_q);
  bound_max((float*)(p.ws + OFF_BND) + 2, bmax_k);
}

__device__ __forceinline__ void phase_g3(const Params& p, char* lds) {
  const int tid = opaque_tid(), wid = __builtin_amdgcn_readfirstlane(tid >> 6), lane = tid & 63, r32 = lane & 31, hi = lane >> 5, wm = wid & 3, wn = wid >> 2;
  char* dout = (char*)p.out;
  const bf16_t* H = (const bf16_t*)(p.ws + OFF_H);
  const bf16_t* WIN = (const bf16_t*)(p.ws + OFF_WIN);
  bf16_t* MG = (bf16_t*)(dout + OO_MERGED);
  TileIter it(8); int mt, nt;
  while (it.next(mt, nt)) {
    const int m0 = mt * 256;
#pragma nounroll
    for (int s = 0; s < 2; ++s) {
      f32x16 acc[2][2];
      zero_acc(acc);
      const bf16_t* Y = s == 0 ? (const bf16_t*)(p.ws + OFF_QA) : (const bf16_t*)(dout + OO_YB);
      const bf16_t* WOUT = (const bf16_t*)(p.ws + (s == 0 ? OFF_WAOUT : OFF_WBOUT));
      gemm_kloop(H + (size_t)m0 * DM, DM, WIN + (size_t)(2560 + s * 1024 + nt * 128) * DM, DM, 16, acc, lds);
      unsigned* gl = (unsigned*)(lds + 2 * G_STAGE) + tid;
#pragma unroll
      for (int fi = 0; fi < 2; ++fi)
#pragma unroll
        for (int ti = 0; ti < 2; ++ti)
#pragma unroll
          for (int q = 0; q < 8; ++q) gl[((fi * 2 + ti) * 8 + q) * 512] = cvtpk(sigmoidf_(acc[fi][ti][2 * q]), sigmoidf_(acc[fi][ti][2 * q + 1]));
      zero_acc(acc);
      gemm_kloop(Y + (size_t)m0 * 512, 512, WOUT + (size_t)nt * 128 * 512, 512, 8, acc, lds);
      char* wb = lds + wid * 8192;
#pragma unroll
      for (int ti = 0; ti < 2; ++ti) {
        const int tl = ti * 32 + r32;
#pragma unroll
        for (int fi = 0; fi < 2; ++fi) {
#pragma unroll
          for (int g = 0; g < 4; ++g) {
            const unsigned g01 = gl[((fi * 2 + ti) * 8 + 2 * g) * 512], g23 = gl[((fi * 2 + ti) * 8 + 2 * g + 1) * 512];
            stage_put(wb, tl, fi * 8 + 2 * g + hi, __uint_as_float(g01 << 16) * acc[fi][ti][4 * g], __uint_as_float(g01 & 0xffff0000u) * acc[fi][ti][4 * g + 1],
                      __uint_as_float(g23 << 16) * acc[fi][ti][4 * g + 2], __uint_as_float(g23 & 0xffff0000u) * acc[fi][ti][4 * g + 3]);
          }
        }
      }
      bf16_t* dst = MG + (size_t)(m0 + wm * 64) * DM + nt * 128 + wn * 64;
      if (s == 0) stage_flush(wb, dst, DM, lane); else stage_flush_add(wb, dst, DM, lane);
    }
  }
}

__device__ __forceinline__ void phase_g4(const Params& p, char* lds) {
  const int tid = opaque_tid(), wid = __builtin_amdgcn_readfirstlane(tid >> 6), lane = tid & 63, r32 = lane & 31, hi = lane >> 5, wm = wid & 3, wn = wid >> 2;
  char* dout = (char*)p.out;
  const bf16_t* MG = (const bf16_t*)(dout + OO_MERGED);
  bf16_t* Z = (bf16_t*)(p.ws + OFF_H);
  float* part = (float*)(p.ws + OFF_PART) + 10 * T;
  TileIter it(8); int mt, nt;
  while (it.next(mt, nt)) {
    const int m0 = mt * 256;
    f32x16 acc[2][2];
    zero_acc(acc);
    gemm_kloop(MG + (size_t)m0 * DM, DM, (const bf16_t*)(p.ws + OFF_WO) + (size_t)nt * 128 * DM, DM, 16, acc, lds);
    char* wb = lds + wid * 8192;
    const int tok0 = m0 + wm * 64;
#pragma unroll
    for (int ti = 0; ti < 2; ++ti) {
      const int tl = ti * 32 + r32, tok = tok0 + tl;
      epi_plain32(acc[0][ti], 1.0f, wb, tl, 0, hi); epi_plain32(acc[1][ti], 1.0f, wb, tl, 8, hi);
      float s = sumsq16(acc[0][ti]) + sumsq16(acc[1][ti]); s += __shfl_xor(s, 32);
      if (hi == 0) part[(nt * 2 + wn) * T + tok] = s;
    }
    stage_flush(wb, Z + (size_t)tok0 * DM + nt * 128 + wn * 64, DM, lane);
  }
}

__device__ __forceinline__ void phase5(const Params& p) {
  const int tid = opaque_tid(), wid = tid >> 6, lane = tid & 63;
  const float* mod = (const float*)(p.ws + OFF_MOD);
  const bf16_t* Z = (const bf16_t*)(p.ws + OFF_H);
  const float* part = (const float*)(p.ws + OFF_PART) + 10 * T;
  const int NW = gridDim.x * 8;
  for (int row0 = blockIdx.x * 8 + wid; row0 < T; row0 += 2 * NW) {
    float4 xv[2][4]; u32x2 zz[2][4]; float pz[2];
#pragma unroll
    for (int j = 0; j < 2; ++j) {
      const int row = row0 + j * NW;
      if (row < T) {
        const float* xr = xrow_ptr(p, row);
        pz[j] = lane < 16 ? part[lane * T + row] : 0.f;
#pragma unroll
        for (int i = 0; i < 4; ++i) { xv[j][i] = *(const float4*)(xr + i * 256 + lane * 4); zz[j][i] = *(const u32x2*)(Z + (size_t)row * DM + i * 256 + lane * 4); }
      }
    }
#pragma unroll
    for (int j = 0; j < 2; ++j) {
      const int row = row0 + j * NW;
      if (row < T) {
        const int b = batch_of(row);
        const float rn = rsqrtf(wave_sum(pz[j]) * (1.0f / 1024.0f) + EPS);
        float* o = p.out + (size_t)row * DM;
#pragma unroll
        for (int i = 0; i < 4; ++i) {
          const int col = i * 256 + lane * 4;
          const float4 g = *(const float4*)(p.post_g + col);
          const float4 gt = *(const float4*)(mod + b * 3072 + 2048 + col);
          float4 r;
          r.x = xv[j][i].x + gt.x * (__uint_as_float(zz[j][i].x << 16) * rn * g.x);
          r.y = xv[j][i].y + gt.y * (__uint_as_float(zz[j][i].x & 0xffff0000u) * rn * g.y);
          r.z = xv[j][i].z + gt.z * (__uint_as_float(zz[j][i].y << 16) * rn * g.z);
          r.w = xv[j][i].w + gt.w * (__uint_as_float(zz[j][i].y & 0xffff0000u) * rn * g.w);
          *(float4*)(o + col) = r;
        }
      }
    }
  }
}

#define SBAR() __builtin_amdgcn_sched_barrier(0)
constexpr float ATT_THR = 8.0f;
constexpr int SHM_V = 64 * 64 * 2;
template <int DK> struct KL { static constexpr int RB = DK == 64 ? 128 : 256; static constexpr int SHM_K = 64 * RB; };
template <int DK> __device__ __forceinline__ int kswz(int row, int c) {
  if (DK == 64) return row * 128 + ((c ^ ((row >> 1) & 7)) << 4);
  return row * 256 + ((c ^ (row & 15)) << 4);
}
__device__ __forceinline__ int v_st(int k, int c) {
  const int kk = (k & ~0xC) | ((k & 4) << 1) | ((k & 8) >> 1);
  return ((kk >> 3) * 2 + (c >> 5)) * 512 + ((kk & 7) * 32 + (c & 31)) * 2;
}
__device__ __forceinline__ int v_rd_base(int lane) { return ((lane & 3) << 3) | (((lane >> 2) & 3) << 6) | (((lane >> 4) & 1) << 5) | (((lane >> 5) & 1) << 8); }
constexpr int v_rd_off(int d0, int ks, int half) { return d0 * 512 + ks * 2048 + half * 1024; }
typedef __attribute__((address_space(3))) const char* lds_cptr;
typedef short v4i16_t __attribute__((ext_vector_type(4)));
__device__ __forceinline__ s16x4 vtr(lds_cptr p) { return __builtin_bit_cast(s16x4, __builtin_amdgcn_ds_read_tr16_b64_v4i16((__attribute__((address_space(3))) v4i16_t*)p)); }
template <int D0> __device__ __forceinline__ void pv_one(f32x16& od, lds_cptr vb, bf16x8 pa0, bf16x8 pa1, bf16x8 pa2, bf16x8 pa3) {
  const s16x4 l0 = vtr(vb + v_rd_off(D0, 0, 0)), h0 = vtr(vb + v_rd_off(D0, 0, 1)), l1 = vtr(vb + v_rd_off(D0, 1, 0)), h1 = vtr(vb + v_rd_off(D0, 1, 1));
  const s16x4 l2 = vtr(vb + v_rd_off(D0, 2, 0)), h2 = vtr(vb + v_rd_off(D0, 2, 1)), l3 = vtr(vb + v_rd_off(D0, 3, 0)), h3 = vtr(vb + v_rd_off(D0, 3, 1));
#define PK(L, Hh) (bf16x8){L[0], L[1], L[2], L[3], Hh[0], Hh[1], Hh[2], Hh[3]}
  od = __builtin_amdgcn_mfma_f32_32x32x16_bf16(pa0, PK(l0, h0), od, 0, 0, 0);
  od = __builtin_amdgcn_mfma_f32_32x32x16_bf16(pa1, PK(l1, h1), od, 0, 0, 0);
  od = __builtin_amdgcn_mfma_f32_32x32x16_bf16(pa2, PK(l2, h2), od, 0, 0, 0);
  od = __builtin_amdgcn_mfma_f32_32x32x16_bf16(pa3, PK(l3, h3), od, 0, 0, 0);
#undef PK
}
__device__ __forceinline__ void pv_all(f32x16* o, lds_cptr vb, bf16x8 pa0, bf16x8 pa1, bf16x8 pa2, bf16x8 pa3) {
  pv_one<0>(o[0], vb, pa0, pa1, pa2, pa3); pv_one<1>(o[1], vb, pa0, pa1, pa2, pa3);
}
__device__ __forceinline__ void partialSM(f32x16& p0, f32x16& p1, float& m_reg, float& alpha) {
  float pmax = p0[0];
#pragma unroll
  for (int r = 1; r < 16; ++r) pmax = fmaxf(pmax, p0[r]);
#pragma unroll
  for (int r = 0; r < 16; ++r) pmax = fmaxf(pmax, p1[r]);
  { auto rr = __builtin_amdgcn_permlane32_swap(__float_as_uint(pmax), __float_as_uint(pmax), false, false);
    pmax = fmaxf(__uint_as_float(rr[0]), __uint_as_float(rr[1])); }
  float mn;
  if (__builtin_expect(__all(pmax - m_reg <= ATT_THR), 1)) { mn = m_reg; alpha = 1.f; }
  else { mn = fmaxf(m_reg, pmax); alpha = __builtin_amdgcn_exp2f(m_reg - mn); m_reg = mn; }
#pragma unroll
  for (int r = 0; r < 16; ++r) p0[r] -= mn;
#pragma unroll
  for (int r = 0; r < 16; ++r) p1[r] -= mn;
#pragma unroll
  for (int r = 0; r < 16; ++r) p0[r] = __builtin_amdgcn_exp2f(p0[r]);
}
__device__ __forceinline__ void finishSM(f32x16& p0, f32x16& p1, float alpha, float& l_reg, bf16x8& pa0, bf16x8& pa1, bf16x8& pa2, bf16x8& pa3) {
#pragma unroll
  for (int r = 0; r < 16; ++r) p1[r] = __builtin_amdgcn_exp2f(p1[r]);
  float ps = 0.f;
#pragma unroll
  for (int r = 0; r < 16; ++r) ps += p0[r];
#pragma unroll
  for (int r = 0; r < 16; ++r) ps += p1[r];
  { auto rr = __builtin_amdgcn_permlane32_swap(__float_as_uint(ps), __float_as_uint(ps), false, false);
    ps = __uint_as_float(rr[0]) + __uint_as_float(rr[1]); }
  l_reg = l_reg * alpha + ps;
#define PK4(P, BASE, OUT) do { unsigned a0 = cvtpk(P[BASE + 0], P[BASE + 1]), a1 = cvtpk(P[BASE + 2], P[BASE + 3]);   \
    unsigned b0 = cvtpk(P[BASE + 4], P[BASE + 5]), b1 = cvtpk(P[BASE + 6], P[BASE + 7]);                              \
    auto r0 = __builtin_amdgcn_permlane32_swap(a0, b0, false, false); auto r1 = __builtin_amdgcn_permlane32_swap(a1, b1, false, false); \
    u32x4 w = {r0[0], r1[0], r0[1], r1[1]}; OUT = *reinterpret_cast<bf16x8*>(&w); } while (0)
  PK4(p0, 0, pa0); PK4(p0, 8, pa1); PK4(p1, 0, pa2); PK4(p1, 8, pa3);
#undef PK4
}
template <int DK> __device__ __forceinline__ void qkt(f32x16& p0, f32x16& p1, const char* Ks, const bf16x8* qr, int r32, int hi) {
#pragma unroll
  for (int r = 0; r < 16; ++r) { p0[r] = 0.f; p1[r] = 0.f; }
#pragma unroll
  for (int d0 = 0; d0 < DK / 16; ++d0) {
    const int off = kswz<DK>(r32, 2 * d0 + hi);
    const bf16x8 b0 = *reinterpret_cast<const bf16x8*>(Ks + off);
    const bf16x8 b1 = *reinterpret_cast<const bf16x8*>(Ks + off + 32 * KL<DK>::RB);
    p0 = __builtin_amdgcn_mfma_f32_32x32x16_bf16(b0, qr[d0], p0, 0, 0, 0);
    p1 = __builtin_amdgcn_mfma_f32_32x32x16_bf16(b1, qr[d0], p1, 0, 0, 0);
    if (QKT_SB && (d0 & 1) == 1 && d0 + 1 < DK / 16) SBAR();
  }
}

template <int DK>
__device__ __forceinline__ void attn_unit(const bf16_t* Qb, int ldq, const bf16_t* __restrict__ Kh, int ldk, const bf16_t* __restrict__ Krp,
                                          const bf16_t* __restrict__ Vh, int ldv, const bf16_t* Gb, bf16_t* Ob, int seq, char* lds) {
  constexpr int SHM_K = KL<DK>::SHM_K;
  const int tid = opaque_tid(), wid = __builtin_amdgcn_readfirstlane(tid >> 6), lane = tid & 63, r32 = lane & 31, hi = lane >> 5;
  char* V_lds = lds; char* K_lds = lds + 2 * SHM_V;
  float* ws = (float*)(lds + 2 * SHM_V + 2 * SHM_K) + wid * 64; float* li_l = ws; float* al_l = ws + 32;
  float m_reg = -1e30f, l_reg = 0.f; f32x16 o[2]; bf16x8 qr[DK / 16];
#pragma unroll
  for (int r = 0; r < 16; ++r) { o[0][r] = 0.f; o[1][r] = 0.f; }
  const bf16_t* Qw = Qb + (size_t)(wid * 32 + r32) * ldq + hi * 8;
#pragma unroll
  for (int d0 = 0; d0 < DK / 16; ++d0) qr[d0] = *reinterpret_cast<const bf16x8*>(Qw + d0 * 16);
  const int srow = tid >> 3, sc = tid & 7, vst = v_st(srow, sc * 8), kst = kswz<DK>(srow, sc);
  const int rrow = tid >> 2, rc = tid & 3, krst = kswz<DK>(rrow & 63, 8 + rc);
  const bool dor = (DK == 96) && (wid < 4);
  const lds_cptr vb0 = (lds_cptr)V_lds + v_rd_base(lane);
  struct { u32x4 v, k, r; } sr_[1];
  const unsigned voff0 = (unsigned)(srow * ldv + sc * 8) * 2u, koff0 = (unsigned)(srow * ldk + sc * 8) * 2u, roff0 = (unsigned)(rrow * 32 + rc * 8) * 2u;
#define SLOAD(i, k0) do { sr_[i].v = *(const u32x4*)((const char*)Vh + (voff0 + (unsigned)((k0) * ldv) * 2u)); sr_[i].k = *(const u32x4*)((const char*)Kh + (koff0 + (unsigned)((k0) * ldk) * 2u)); \
    if (dor) sr_[i].r = *(const u32x4*)((const char*)Krp + (roff0 + (unsigned)((k0) * 64))); } while (0)
#define SWRITE(b, i) do { *(u32x4*)(V_lds + (b) * SHM_V + vst) = sr_[i].v; *(u32x4*)(K_lds + (b) * SHM_K + kst) = sr_[i].k; \
    if (dor) *(u32x4*)(K_lds + (b) * SHM_K + krst) = sr_[i].r; } while (0)
#define RESC(a) do { if (__any((a) < 1.f)) { if (hi == 0) al_l[r32] = (a); asm volatile("s_waitcnt lgkmcnt(0)" ::: "memory"); \
    _Pragma("unroll") for (int d = 0; d < 2; ++d) _Pragma("unroll") for (int r = 0; r < 16; ++r) o[d][r] *= al_l[crow(r, hi)]; } } while (0)
  f32x16 pA0, pA1, pB0, pB1; float alA, alB; bf16x8 pa0, pa1, pa2, pa3; const int NT = seq / 64;
  __syncthreads();
  SLOAD(0, 0); SWRITE(0, 0); __syncthreads();
  qkt<DK>(pA0, pA1, K_lds, qr, r32, hi); partialSM(pA0, pA1, m_reg, alA);
  SLOAD(0, 64);
  SWRITE(1, 0); __syncthreads();
  for (int j = 1; j + 1 < NT; j += 2) {
    SBAR(); qkt<DK>(pB0, pB1, K_lds + SHM_K, qr, r32, hi);
    finishSM(pA0, pA1, alA, l_reg, pa0, pa1, pa2, pa3); SBAR();
    SLOAD(0, (j + 1) * 64); SBAR();
    pv_all(o, vb0, pa0, pa1, pa2, pa3); partialSM(pB0, pB1, m_reg, alB);
    __syncthreads(); SWRITE(0, 0);
    RESC(alB); __syncthreads();
    SBAR(); qkt<DK>(pA0, pA1, K_lds, qr, r32, hi);
    finishSM(pB0, pB1, alB, l_reg, pa0, pa1, pa2, pa3); SBAR();
    SLOAD(0, (j + 2) * 64); SBAR();
    pv_all(o, vb0 + SHM_V, pa0, pa1, pa2, pa3); partialSM(pA0, pA1, m_reg, alA);
    __syncthreads(); SWRITE(1, 0);
    RESC(alA); __syncthreads();
  }
  SBAR(); qkt<DK>(pB0, pB1, K_lds + SHM_K, qr, r32, hi);
  finishSM(pA0, pA1, alA, l_reg, pa0, pa1, pa2, pa3); SBAR();
  pv_all(o, vb0, pa0, pa1, pa2, pa3); partialSM(pB0, pB1, m_reg, alB);
  __syncthreads(); RESC(alB);
  finishSM(pB0, pB1, alB, l_reg, pa0, pa1, pa2, pa3); SBAR();
  pv_all(o, vb0 + SHM_V, pa0, pa1, pa2, pa3);
  if (hi == 0) li_l[r32] = l_reg; asm volatile("s_waitcnt lgkmcnt(0)" ::: "memory");
  float rli[16];
#pragma unroll
  for (int r = 0; r < 16; ++r) rli[r] = __builtin_amdgcn_rcpf(li_l[crow(r, hi)]);
#pragma unroll
  for (int r = 0; r < 16; ++r) {
    const size_t rowo = (size_t)(wid * 32 + crow(r, hi)) * 512;
#pragma unroll
    for (int d0 = 0; d0 < 2; ++d0) {
      const size_t idx = rowo + d0 * 32 + r32;
      const float g = bf2f(Gb[idx]);
      Ob[idx] = (bf16_t)(cvtpk(o[d0][r] * rli[r] * g, 0.f) & 0xffffu);
    }
  }
#undef SLOAD
#undef SWRITE
#undef RESC
}

__device__ __forceinline__ void exp16(f32x16& p) {
#pragma unroll
  for (int r = 0; r < 16; ++r) p[r] = __builtin_amdgcn_exp2f(p[r]);
}
__device__ __forceinline__ void finishFast(f32x16& p0, f32x16& p1, float& l_reg, bf16x8& pa0, bf16x8& pa1, bf16x8& pa2, bf16x8& pa3) {
  exp16(p1);
  float ps = 0.f;
#pragma unroll
  for (int r = 0; r < 16; ++r) ps += p0[r];
#pragma unroll
  for (int r = 0; r < 16; ++r) ps += p1[r];
  l_reg += ps;
#define PK4(P, BASE, OUT) do { unsigned a0 = cvtpk(P[BASE + 0], P[BASE + 1]), a1 = cvtpk(P[BASE + 2], P[BASE + 3]);   \
    unsigned b0 = cvtpk(P[BASE + 4], P[BASE + 5]), b1 = cvtpk(P[BASE + 6], P[BASE + 7]);                              \
    auto r0 = __builtin_amdgcn_permlane32_swap(a0, b0, false, false); auto r1 = __builtin_amdgcn_permlane32_swap(a1, b1, false, false); \
    u32x4 w = {r0[0], r1[0], r0[1], r1[1]}; OUT = *reinterpret_cast<bf16x8*>(&w); } while (0)
  PK4(p0, 0, pa0); PK4(p0, 8, pa1); PK4(p1, 0, pa2); PK4(p1, 8, pa3);
#undef PK4
}
template <int DK>
__device__ __forceinline__ void attn_unit_fast(const bf16_t* Qb, int ldq, const bf16_t* __restrict__ Kh, int ldk, const bf16_t* __restrict__ Krp,
                                               const bf16_t* __restrict__ Vh, int ldv, const bf16_t* Gb, bf16_t* Ob, int seq, char* lds) {
  constexpr int SHM_K = KL<DK>::SHM_K;
  const int tid = opaque_tid(), wid = __builtin_amdgcn_readfirstlane(tid >> 6), lane = tid & 63, r32 = lane & 31, hi = lane >> 5;
  char* V_lds = lds; char* K_lds = lds + 3 * SHM_V;
  float* ws = (float*)(lds + 3 * SHM_V + 3 * SHM_K) + wid * 64; float* li_l = ws;
  float l_reg = 0.f; f32x16 o[2]; bf16x8 qr[DK / 16];
#pragma unroll
  for (int r = 0; r < 16; ++r) { o[0][r] = 0.f; o[1][r] = 0.f; }
  const bf16_t* Qw = Qb + (size_t)(wid * 32 + r32) * ldq + hi * 8;
#pragma unroll
  for (int d0 = 0; d0 < DK / 16; ++d0) qr[d0] = *reinterpret_cast<const bf16x8*>(Qw + d0 * 16);
  const int srow = tid >> 3, sc = tid & 7, vst = v_st(srow, sc * 8), kst = kswz<DK>(srow, sc);
  const int rrow = tid >> 2, rc = tid & 3, krst = kswz<DK>(rrow & 63, 8 + rc);
  const bool dor = (DK == 96) && (wid < 4);
  const lds_cptr vb0 = (lds_cptr)V_lds + v_rd_base(lane);
  struct { u32x4 v, k, r; } sr_[1];
  const unsigned voff0 = (unsigned)(srow * ldv + sc * 8) * 2u, koff0 = (unsigned)(srow * ldk + sc * 8) * 2u, roff0 = (unsigned)(rrow * 32 + rc * 8) * 2u;
#define SLOAD(i, k0) do { sr_[i].v = *(const u32x4*)((const char*)Vh + (voff0 + (unsigned)((k0) * ldv) * 2u)); sr_[i].k = *(const u32x4*)((const char*)Kh + (koff0 + (unsigned)((k0) * ldk) * 2u)); \
    if (dor) sr_[i].r = *(const u32x4*)((const char*)Krp + (roff0 + (unsigned)((k0) * 64))); } while (0)
#define SWRITE(slot, i) do { *(u32x4*)(V_lds + (slot) * SHM_V + vst) = sr_[i].v; *(u32x4*)(K_lds + (slot) * SHM_K + kst) = sr_[i].k; \
    if (dor) *(u32x4*)(K_lds + (slot) * SHM_K + krst) = sr_[i].r; } while (0)
  f32x16 pA0, pA1, pB0, pB1; bf16x8 pa0, pa1, pa2, pa3; const int NT = seq / 64;
  int sp = 2, st = 0, sn = 1;
#define ROT() do { sp = st; st = sn; sn = (sn == 2) ? 0 : sn + 1; } while (0)
#define STEP(C0, C1, P0, P1, SETW, t, DOW) do { SBAR(); qkt<DK>(C0, C1, K_lds + st * SHM_K, qr, r32, hi); \
    finishFast(P0, P1, l_reg, pa0, pa1, pa2, pa3); \
    if (DOW) { SWRITE(sn, 0); if ((t) + 2 < NT) SLOAD(0, ((t) + 2) * 64); } \
    pv_all(o, vb0 + sp * SHM_V, pa0, pa1, pa2, pa3); exp16(C0); \
    __syncthreads(); ROT(); } while (0)
  __syncthreads();
  SLOAD(0, 0); SWRITE(0, 0); SLOAD(0, 64); __syncthreads();
  qkt<DK>(pA0, pA1, K_lds, qr, r32, hi);
  SWRITE(1, 0); SLOAD(0, 128);
  exp16(pA0);
  __syncthreads(); ROT();
  for (int t = 1; t + 1 < NT; t += 2) {
    STEP(pB0, pB1, pA0, pA1, 0, t, true);
    STEP(pA0, pA1, pB0, pB1, 1, t + 1, true);
  }
  STEP(pB0, pB1, pA0, pA1, 0, NT - 1, false);
  finishFast(pB0, pB1, l_reg, pa0, pa1, pa2, pa3); SBAR();
  pv_all(o, vb0 + sp * SHM_V, pa0, pa1, pa2, pa3);
  { auto rr = __builtin_amdgcn_permlane32_swap(__float_as_uint(l_reg), __float_as_uint(l_reg), false, false);
    l_reg = __uint_as_float(rr[0]) + __uint_as_float(rr[1]); }
  if (hi == 0) li_l[r32] = l_reg; asm volatile("s_waitcnt lgkmcnt(0)" ::: "memory");
  float rli[16];
#pragma unroll
  for (int r = 0; r < 16; ++r) rli[r] = __builtin_amdgcn_rcpf(li_l[crow(r, hi)]);
#pragma unroll
  for (int r = 0; r < 16; ++r) {
    const size_t rowo = (size_t)(wid * 32 + crow(r, hi)) * 512;
#pragma unroll
    for (int d0 = 0; d0 < 2; ++d0) {
      const size_t idx = rowo + d0 * 32 + r32;
      const float g = bf2f(Gb[idx]);
      Ob[idx] = (bf16_t)(cvtpk(o[d0][r] * rli[r] * g, 0.f) & 0xffffu);
    }
  }
#undef SLOAD
#undef SWRITE
#undef ROT
#undef STEP
}

__device__ __forceinline__ void phase_attn(const Params& p, char* lds) {
  char* dout = (char*)p.out;
  const float* bnd = (const float*)(p.ws + OFF_BND);
  const bool fastA = bnd[0] < 60.0f;
  const bool fastB = 3.0f * bnd[1] * (2.0f * bnd[2] + bnd[3]) < 3600.0f;
  for (int u = blockIdx.x; u < 2048; u += gridDim.x) {
    const int i = u >> 8, v = u & 255, cls = i >> 1, sub = i & 1, head = v & 7, j = v >> 3;
    int seq0, seq, tok0;
    if (cls < 2) { seq0 = 0; seq = NP; tok0 = (2 * j + sub) * 256; }
    else { const int bi = j >> 3, qb = 2 * (j & 7) + sub; seq0 = NP + bi * NS; seq = NS; tok0 = seq0 + qb * 256; }
    if ((cls & 1) == 0) {
      bf16_t* QA = (bf16_t*)(p.ws + OFF_QA);
      const bf16_t* Kp = (const bf16_t*)(p.ws + OFF_KA) + (size_t)seq0 * 128 + (head >> 2) * 64;
      const bf16_t* Vp = (const bf16_t*)(p.ws + OFF_VA) + (size_t)seq0 * 128 + (head >> 2) * 64;
      const bf16_t* Gp = (const bf16_t*)(dout + OO_GA) + (size_t)tok0 * 512 + head * 64;
      bf16_t* Qp = QA + (size_t)tok0 * 512 + head * 64;
      if (fastA) attn_unit_fast<64>(Qp, 512, Kp, 128, nullptr, Vp, 128, Gp, Qp, seq, lds);
      else if (ATT_SAFE) attn_unit<64>(Qp, 512, Kp, 128, nullptr, Vp, 128, Gp, Qp, seq, lds);
    } else {
      const bf16_t* Qp = (const bf16_t*)(p.ws + OFF_QB) + (size_t)tok0 * 768 + head * 96;
      const bf16_t* Kp = (const bf16_t*)(p.ws + OFF_KBN) + (size_t)seq0 * 512 + head * 64;
      const bf16_t* Rp = (const bf16_t*)(p.ws + OFF_KR) + (size_t)seq0 * 32;
      const bf16_t* Vp = (const bf16_t*)(p.ws + OFF_VB) + (size_t)seq0 * 512 + head * 64;
      const bf16_t* Gp = (const bf16_t*)(dout + OO_GB) + (size_t)tok0 * 512 + head * 64;
      bf16_t* Op = (bf16_t*)(dout + OO_YB) + (size_t)tok0 * 512 + head * 64;
      if (fastB) attn_unit_fast<96>(Qp, 768, Kp, 512, Rp, Vp, 512, Gp, Op, seq, lds);
      else if (ATT_SAFE) attn_unit<96>(Qp, 768, Kp, 512, Rp, Vp, 512, Gp, Op, seq, lds);
    }
  }
}

__device__ __forceinline__ void grid_barrier(unsigned* ctr, unsigned target) {
  asm volatile("s_waitcnt vmcnt(0)" ::: "memory");
  __syncthreads();
  if (threadIdx.x == 0) {
    __builtin_amdgcn_fence(__ATOMIC_RELEASE, "agent");
    asm volatile("s_waitcnt vmcnt(0)" ::: "memory");
    (void)__hip_atomic_fetch_add(ctr, 1u, __ATOMIC_RELAXED, __HIP_MEMORY_SCOPE_AGENT);
    unsigned spins = 0;
    while (__hip_atomic_load(ctr, __ATOMIC_RELAXED, __HIP_MEMORY_SCOPE_AGENT) < target) {
      __builtin_amdgcn_s_sleep(2);
      if (++spins > (1u << 24)) break;
    }
    __builtin_amdgcn_fence(__ATOMIC_ACQUIRE, "agent");
    asm volatile("s_waitcnt vmcnt(0)" ::: "memory");
  }
  __syncthreads();
}

#if MK_SINGLE
#ifndef PROBE_MASK
#define PROBE_MASK 0
#endif
__global__ void __launch_bounds__(512) fwd_kernel(Params p) {
  extern __shared__ __attribute__((aligned(16))) char lds[];
#if PROBE_MASK
  volatile unsigned long long* tst = (volatile unsigned long long*)(p.ws + OFF_BND + 256) + blockIdx.x * 16;
  if (threadIdx.x == 0) tst[0] = wall_clock64();
#define STAMP(k) if (threadIdx.x == 0) tst[k + 1] = wall_clock64();
#else
#define STAMP(k)
#endif
#define PHASE(k, call) if (PH_MASK & (1 << k)) { call; if (k == 0) { cg::this_grid().sync(); STAMP(k) } else if (k < 7) { grid_barrier((unsigned*)(p.ws + OFF_BAR), gridDim.x * (unsigned)k); STAMP(k) } }
  PHASE(0, phase0(p, lds))
  PHASE(1, phase1(p))
  PHASE(2, phase_g1(p, lds))
  PHASE(3, phase_g2(p, lds))
  PHASE(4, phase_attn(p, lds))
  PHASE(5, phase_g3(p, lds))
  PHASE(6, phase_g4(p, lds))
  PHASE(7, phase5(p))
#undef PHASE
#if PROBE_MASK
  if (blockIdx.x == 0) {
    __syncthreads();
    float* dshp = (float*)lds;
    if (threadIdx.x == 0) {
    unsigned long long tot = 0;
    for (int k = 0; k < 7; ++k) if (PROBE_MASK & (1 << k)) tot += tst[k + 1] - tst[k];
    dshp[0] = sqrtf((float)tot * (0.01f / 4000.0f));
    }
    __syncthreads();
    const float d = dshp[0];
    for (int i = threadIdx.x; i < 8 * 1024; i += 512) p.out[i] += d;
  }
#endif
}
#define MAIN_KERNEL fwd_kernel
#else
template <int PH>
__global__ void __launch_bounds__(512) ph_kernel(Params p) {
  extern __shared__ __attribute__((aligned(16))) char lds[];
  if (PH == 0) phase0(p, lds);
  if (PH == 1) phase1(p);
  if (PH == 2) phase_g1(p, lds);
  if (PH == 3) phase_g2(p, lds);
  if (PH == 4) phase_attn(p, lds);
  if (PH == 5) phase_g3(p, lds);
  if (PH == 6) phase_g4(p, lds);
  if (PH == 7) phase5(p);
}
#define MAIN_KERNEL ph_kernel<4>
#endif

extern "C" void kernel_launch(void* const* d_in, const int* in_sizes, int n_in, void* d_out, int out_size, void* d_ws, size_t ws_size,
                              hipStream_t stream) {
  Params p{};
  p.x_prompt = (const float*)d_in[0]; p.x_sample = (const float*)d_in[1]; p.c_prompt = (const float*)d_in[2]; p.c_sample = (const float*)d_in[3];
  p.ada_w = (const float*)d_in[4]; p.ada_b = (const float*)d_in[5]; p.pre_g = (const float*)d_in[6]; p.post_g = (const float*)d_in[7];
  p.w_in = (const float*)d_in[8]; p.a_q_g = (const float*)d_in[9]; p.a_k_g = (const float*)d_in[10]; p.b_q_g = (const float*)d_in[11];
  p.b_q_up = (const float*)d_in[12]; p.b_kv_g = (const float*)d_in[13]; p.b_kv_up = (const float*)d_in[14]; p.a_out = (const float*)d_in[15];
  p.b_out = (const float*)d_in[16]; p.w_o = (const float*)d_in[17];
  p.out = (float*)d_out; p.ws = (char*)d_ws;
  static int grid_blocks = 0;
  if (!grid_blocks) {
    int dev = 0, cus = 0, per_cu = 0;
    (void)hipGetDevice(&dev);
    (void)hipDeviceGetAttribute(&cus, hipDeviceAttributeMultiprocessorCount, dev);
    (void)hipFuncSetAttribute((const void*)MAIN_KERNEL, hipFuncAttributeMaxDynamicSharedMemorySize, LDS_BYTES);
    (void)hipOccupancyMaxActiveBlocksPerMultiprocessor(&per_cu, MAIN_KERNEL, 512, LDS_BYTES);
    if (per_cu < 1) per_cu = 1;
    if (per_cu > 1) per_cu = 1;
    grid_blocks = cus * per_cu;
    if (grid_blocks <= 0) grid_blocks = 256;
  }
#if MK_SINGLE
  void* args[] = {&p};
  hipError_t err = hipLaunchCooperativeKernel((const void*)fwd_kernel, dim3(grid_blocks), dim3(512), args, LDS_BYTES, stream);
  if (err != hipSuccess) fprintf(stderr, "cooperative launch failed: %s (grid %d)\n", hipGetErrorString(err), grid_blocks);
#else
  static bool attr_set = false;
  if (!attr_set) {
    (void)hipFuncSetAttribute((const void*)ph_kernel<0>, hipFuncAttributeMaxDynamicSharedMemorySize, LDS_BYTES);
    (void)hipFuncSetAttribute((const void*)ph_kernel<2>, hipFuncAttributeMaxDynamicSharedMemorySize, LDS_BYTES);
    (void)hipFuncSetAttribute((const void*)ph_kernel<3>, hipFuncAttributeMaxDynamicSharedMemorySize, LDS_BYTES);
    (void)hipFuncSetAttribute((const void*)ph_kernel<5>, hipFuncAttributeMaxDynamicSharedMemorySize, LDS_BYTES);
    (void)hipFuncSetAttribute((const void*)ph_kernel<6>, hipFuncAttributeMaxDynamicSharedMemorySize, LDS_BYTES);
    attr_set = true;
  }
  hipLaunchKernelGGL(ph_kernel<0>, dim3(grid_blocks), dim3(512), LDS_BYTES, stream, p);
  hipLaunchKernelGGL(ph_kernel<1>, dim3(grid_blocks), dim3(512), LDS_BYTES, stream, p);
  hipLaunchKernelGGL(ph_kernel<2>, dim3(grid_blocks), dim3(512), LDS_BYTES, stream, p);
  hipLaunchKernelGGL(ph_kernel<3>, dim3(grid_blocks), dim3(512), LDS_BYTES, stream, p);
  hipLaunchKernelGGL(ph_kernel<4>, dim3(grid_blocks), dim3(512), LDS_BYTES, stream, p);
  hipLaunchKernelGGL(ph_kernel<5>, dim3(grid_blocks), dim3(512), LDS_BYTES, stream, p);
  hipLaunchKernelGGL(ph_kernel<6>, dim3(grid_blocks), dim3(512), LDS_BYTES, stream, p);
  hipLaunchKernelGGL(ph_kernel<7>, dim3(grid_blocks), dim3(512), LDS_BYTES, stream, p);
#endif
}
```

```cpp
#include <hip/hip_runtime.h>
#include <hip/hip_cooperative_groups.h>
#include <stdint.h>
#include <cstdio>
namespace cg = cooperative_groups;

#ifndef MK_SINGLE
#define MK_SINGLE 1
#endif
#ifndef QKT_SB
#define QKT_SB 0
#endif
#ifndef ATT_SAFE
#define ATT_SAFE 1
#endif
#ifndef PH_MASK
#define PH_MASK 255
#endif

typedef unsigned short bf16_t;
typedef short bf16x8 __attribute__((ext_vector_type(8)));
typedef short s16x4 __attribute__((ext_vector_type(4)));
typedef float f32x16 __attribute__((ext_vector_type(16)));
typedef unsigned u32x4 __attribute__((ext_vector_type(4)));
typedef unsigned u32x2 __attribute__((ext_vector_type(2)));

constexpr int T = 32768, NP = 16384, NS = 4096, DM = 1024;
constexpr float EPS = 1e-6f;
constexpr float LOG2E = 1.4426950408889634f;
constexpr float PS_A = 0.125f * LOG2E;
constexpr float PS_B = 0.10206207261596575f * LOG2E;

constexpr size_t U = 67108864ull;
constexpr size_t OFF_H = 0;
constexpr size_t OFF_QA = U;
constexpr size_t OFF_KA = U + U / 2;
constexpr size_t OFF_VA = OFF_KA + U / 8;
constexpr size_t OFF_KR = OFF_VA + U / 8;
constexpr size_t OFF_PART = OFF_KR + 2097152;
constexpr size_t OFF_QB = 2 * U;
constexpr size_t OFF_KBN = OFF_QB + (U / 4) * 3;
constexpr size_t OFF_VB = OFF_KBN + U / 2;
constexpr size_t OFF_W = OFF_VB + U / 2;
constexpr size_t OFF_WIN = OFF_W;
constexpr size_t OFF_WQUP = OFF_WIN + 4608ull * 1024 * 2;
constexpr size_t OFF_WKVUP = OFF_WQUP + 768ull * 384 * 2;
constexpr size_t OFF_WAOUT = OFF_WKVUP + 1024ull * 256 * 2;
constexpr size_t OFF_WBOUT = OFF_WAOUT + 1024ull * 512 * 2;
constexpr size_t OFF_WO = OFF_WBOUT + 1024ull * 512 * 2;
constexpr size_t OFF_MOD = OFF_WO + 1024ull * 1024 * 2;
constexpr size_t OFF_SSQ = OFF_MOD + 5 * 3072 * 4;
constexpr size_t OFF_TABA = OFF_SSQ + 3ull * T * 4;
constexpr size_t OFF_TABB = OFF_TABA + 256 * 16 * 8;
constexpr size_t OFF_BND = OFF_TABB + 256 * 8 * 8;
constexpr size_t OFF_BAR = OFF_BND + 128;
constexpr size_t WS_END = OFF_BND + 256 + 256 * 128;
static_assert(WS_END <= 4 * U, "workspace map exceeds 256 MiB");
constexpr size_t OO_BQ = 0;
constexpr size_t OO_BKV = (size_t)T * 384 * 2;
constexpr size_t OO_YB = 0;
constexpr size_t OO_GA = U;
constexpr size_t OO_GB = U + U / 2;
constexpr size_t OO_MERGED = U;

constexpr int LDS_BYTES = 163840;

struct Params {
  const float *x_prompt, *x_sample, *c_prompt, *c_sample, *ada_w, *ada_b, *pre_g, *post_g, *w_in, *a_q_g, *a_k_g, *b_q_g, *b_q_up,
      *b_kv_g, *b_kv_up, *a_out, *b_out, *w_o;
  float* out;
  char* ws;
};

__device__ __forceinline__ int opaque_tid() { int t = threadIdx.x; asm volatile("" : "+v"(t)); return t; }
typedef float f32x2_t __attribute__((ext_vector_type(2)));
typedef __bf16 bf16x2_t __attribute__((ext_vector_type(2)));
__device__ __forceinline__ unsigned cvtpk(float lo, float hi) { f32x2_t v = {lo, hi}; bf16x2_t b = __builtin_convertvector(v, bf16x2_t); return __builtin_bit_cast(unsigned, b); }
__device__ __forceinline__ float bf2f(unsigned short v) { return __uint_as_float(((unsigned)v) << 16); }
__device__ __forceinline__ int crow(int r, int hi) { return (r & 3) + 8 * (r >> 2) + 4 * hi; }
__device__ __forceinline__ void st4(bf16_t* p, float a, float b, float c, float d) { u32x2 w; w.x = cvtpk(a, b); w.y = cvtpk(c, d); *(u32x2*)p = w; }
__device__ __forceinline__ float sigmoidf_(float v) { return 1.0f / (1.0f + __expf(-v)); }
__device__ __forceinline__ const float* xrow_ptr(const Params& p, int tok) { return tok < NP ? p.x_prompt + (size_t)tok * DM : p.x_sample + (size_t)(tok - NP) * DM; }
__device__ __forceinline__ int batch_of(int tok) { return tok < NP ? 0 : 1 + ((tok - NP) >> 12); }
__device__ __forceinline__ int pos_of(int tok) { return tok < NP ? tok : ((tok - NP) & 4095); }

__device__ __forceinline__ int win_src(int n) {
  if (n < 768) return n;
  if (n < 1152) return 1280 + (n - 768);
  if (n < 1408) return 1664 + (n - 1152);
  if (n < 1440) return 1920 + (n - 1408);
  if (n < 1536) return -1;
  if (n < 2048) return 768 + (n - 1536);
  if (n < 2560) return 1952 + (n - 2048);
  return 2464 + (n - 2560);
}
__device__ __forceinline__ void cvt_tile(const float* __restrict__ W, int ldn, int K, bf16_t* __restrict__ dst, bool remap,
                                         const float* __restrict__ gain, int item, float* tl  , int tid) {
  const int ktiles = K >> 6, n0 = (item / ktiles) * 64, k0 = (item % ktiles) * 64;
  __syncthreads();
  {
    const int n4 = (tid & 15) * 4, kr = tid >> 4;
    const int nd = n0 + n4;
    const int src = remap ? win_src(nd) : nd;
#pragma unroll
    for (int i = 0; i < 2; ++i) {
      const int k = kr + 32 * i;
      float4 v = make_float4(0.f, 0.f, 0.f, 0.f);
      if (src >= 0) v = *(const float4*)(W + (size_t)(k0 + k) * ldn + src);
      if (gain) { const float g = gain[k0 + k]; v.x *= g; v.y *= g; v.z *= g; v.w *= g; }
      float* r = tl + k * 65 + n4;
      r[0] = v.x; r[1] = v.y; r[2] = v.z; r[3] = v.w;
    }
  }
  __syncthreads();
  {
    const int n = tid >> 3, kc = tid & 7;
    const float* c = tl + (kc * 8) * 65 + n;
    u32x4 o; o.x = cvtpk(c[0], c[65]); o.y = cvtpk(c[130], c[195]); o.z = cvtpk(c[260], c[325]); o.w = cvtpk(c[390], c[455]);
    *(u32x4*)(dst + (size_t)(n0 + n) * K + k0 + kc * 8) = o;
  }
}

__device__ __forceinline__ void phase0(const Params& p, char* lds) {
  const int tid = opaque_tid(), gsz = gridDim.x * 512, gtid = blockIdx.x * 512 + tid;
  if (gtid == 0) {
    float* bnd = (float*)(p.ws + OFF_BND);
    float gq = 0.f, gk = 0.f;
    for (int i = 0; i < 64; ++i) { gq = fmaxf(gq, fabsf(p.a_q_g[i])); gk = fmaxf(gk, fabsf(p.a_k_g[i])); }
    bnd[0] = 64.0f * gq * gk * PS_A;
    bnd[1] = 0.f; bnd[2] = 0.f; bnd[3] = 0.f;
    __hip_atomic_store((unsigned*)(p.ws + OFF_BAR), 0u, __ATOMIC_RELAXED, __HIP_MEMORY_SCOPE_AGENT);
  }
  float2* tabA = (float2*)(p.ws + OFF_TABA);
  float2* tabB = (float2*)(p.ws + OFF_TABB);
  for (int i = gtid; i < 256 * 16 + 256 * 8; i += gsz) {
    int pos, f; float inv;
    const float L2T = 13.287712379549449f;
    if (i < 4096) { pos = i >> 4; f = i & 15; inv = exp2f(-(float)f * (1.0f / 16.0f) * L2T); }
    else { int k = i - 4096; pos = k >> 3; f = k & 7; inv = exp2f(-(float)f * (1.0f / 8.0f) * L2T); }
    float ang = (float)pos * inv;
    float rev = ang * 0.15915494309189535f; rev -= floorf(rev);
    float2 cs; cs.x = __builtin_amdgcn_cosf(rev); cs.y = __builtin_amdgcn_sinf(rev);
    if (i < 4096) tabA[i] = cs; else tabB[i - 4096] = cs;
  }
  {
    float* tl = (float*)(lds + 16384);
    for (int it = blockIdx.x; it < 1800; it += gridDim.x) {
      if (it < 1152) cvt_tile(p.w_in, 4512, 1024, (bf16_t*)(p.ws + OFF_WIN), true, nullptr, it, tl, tid);
      else if (it < 1224) cvt_tile(p.b_q_up, 768, 384, (bf16_t*)(p.ws + OFF_WQUP), false, p.b_q_g, it - 1152, tl, tid);
      else if (it < 1288) cvt_tile(p.b_kv_up, 1024, 256, (bf16_t*)(p.ws + OFF_WKVUP), false, p.b_kv_g, it - 1224, tl, tid);
      else if (it < 1416) cvt_tile(p.a_out, 1024, 512, (bf16_t*)(p.ws + OFF_WAOUT), false, nullptr, it - 1288, tl, tid);
      else if (it < 1544) cvt_tile(p.b_out, 1024, 512, (bf16_t*)(p.ws + OFF_WBOUT), false, nullptr, it - 1416, tl, tid);
      else cvt_tile(p.w_o, 1024, 1024, (bf16_t*)(p.ws + OFF_WO), false, nullptr, it - 1544, tl, tid);
    }
  }
  float* red = (float*)lds;
  float* sl = (float*)(lds + 16384);
  float* mod = (float*)(p.ws + OFF_MOD);
  __syncthreads();
  for (int i = tid; i < 5 * 1024; i += 512) { const float cv = i < 1024 ? p.c_prompt[i] : p.c_sample[i - 1024]; sl[i] = cv * sigmoidf_(cv); }
  __syncthreads();
  for (int it = blockIdx.x; it < 256; it += gridDim.x) {
    const int c = tid & 15, kg = tid >> 4;
    float a0 = 0.f, a1 = 0.f, a2 = 0.f, a3 = 0.f, a4 = 0.f;
    if (c < 12) {
      const float* wp = p.ada_w + it * 12 + c;
#pragma unroll 8
      for (int k = kg; k < 1024; k += 32) {
        const float w = wp[(size_t)k * 3072];
        a0 += sl[k] * w; a1 += sl[1024 + k] * w; a2 += sl[2048 + k] * w; a3 += sl[3072 + k] * w; a4 += sl[4096 + k] * w;
      }
    }
    float* rp = red + (kg * 16 + c) * 5;
    rp[0] = a0; rp[1] = a1; rp[2] = a2; rp[3] = a3; rp[4] = a4;
    __syncthreads();
    if (tid < 60) {
      const int cc = tid / 5, b = tid % 5;
      float s = 0.f;
      for (int g = 0; g < 32; ++g) s += red[(g * 16 + cc) * 5 + b];
      const int col = it * 12 + cc;
      mod[b * 3072 + col] = s + p.ada_b[col];
    }
    __syncthreads();
  }
}

__device__ __forceinline__ float wave_sum(float v) {
#pragma unroll
  for (int o = 32; o >= 1; o >>= 1) v += __shfl_xor(v, o);
  return v;
}
__device__ __forceinline__ void phase1(const Params& p) {
  const int tid = opaque_tid(), wid = tid >> 6, lane = tid & 63;
  const float* mod = (const float*)(p.ws + OFF_MOD);
  bf16_t* H = (bf16_t*)(p.ws + OFF_H);
  const int NW = gridDim.x * 8;
  for (int row0 = blockIdx.x * 8 + wid; row0 < T; row0 += 4 * NW) {
    float4 v[4][4];
#pragma unroll
    for (int j = 0; j < 4; ++j) {
      const int row = row0 + j * NW;
      if (row < T) {
        const float* xr = xrow_ptr(p, row);
#pragma unroll
        for (int i = 0; i < 4; ++i) v[j][i] = *(const float4*)(xr + i * 256 + lane * 4);
      }
    }
#pragma unroll
    for (int j = 0; j < 4; ++j) {
      const int row = row0 + j * NW;
      if (row < T) {
        const int b = batch_of(row);
        float ss = 0.f;
#pragma unroll
        for (int i = 0; i < 4; ++i) ss += v[j][i].x * v[j][i].x + v[j][i].y * v[j][i].y + v[j][i].z * v[j][i].z + v[j][i].w * v[j][i].w;
        ss = wave_sum(ss);
        const float rn = rsqrtf(ss * (1.0f / 1024.0f) + EPS);
#pragma unroll
        for (int i = 0; i < 4; ++i) {
          const int col = i * 256 + lane * 4;
          const float4 g = *(const float4*)(p.pre_g + col);
          const float4 sh = *(const float4*)(mod + b * 3072 + col);
          const float4 sc = *(const float4*)(mod + b * 3072 + 1024 + col);
          st4(H + (size_t)row * DM + col, v[j][i].x * rn * g.x * (1.f + sc.x) + sh.x, v[j][i].y * rn * g.y * (1.f + sc.y) + sh.y,
              v[j][i].z * rn * g.z * (1.f + sc.z) + sh.z, v[j][i].w * rn * g.w * (1.f + sc.w) + sh.w);
        }
      }
    }
  }
}

constexpr int G_XB = 256 * 128, G_WB = 128 * 128, G_STAGE = G_XB + G_WB;
__device__ __forceinline__ int gswz(int row, int c) { return row * 128 + ((c ^ ((row >> 1) & 7)) << 4); }

__device__ __forceinline__ void gemm_kloop(const bf16_t* __restrict__ X, int ldx, const bf16_t* __restrict__ W, int ldw, int nk,
                                           f32x16 (&acc)[2][2], char* lds) {
  const int tid = opaque_tid(), wid = __builtin_amdgcn_readfirstlane(tid >> 6), lane = tid & 63, r32 = lane & 31, hi = lane >> 5, wm = wid & 3, wn = wid >> 2;
  const int srow = tid >> 3, sch = tid & 7;
  const char* xg = (const char*)X;
  const char* wg = (const char*)W;
  const unsigned xstep = (unsigned)ldx * 128u, wstep = (unsigned)ldw * 128u;
  const unsigned xo0 = (unsigned)(srow * ldx + sch * 8) * 2u, wo0 = (unsigned)(srow * ldw + sch * 8) * 2u;
  const int sw = gswz(srow, sch);
  u32x4 xa[4], wa[2], xb[4], wb[2];
  const int fsw = (r32 >> 1) & 7;
  int koff[4];
#pragma unroll
  for (int ks = 0; ks < 4; ++ks) koff[ks] = ((2 * ks + hi) ^ fsw) << 4;
  const int rowA = G_XB + (wn * 64 + r32) * 128, rowB = (wm * 64 + r32) * 128;
#define GLOAD(xr, wr, kt) do { _Pragma("unroll") for (int i = 0; i < 4; ++i) xr[i] = *(const u32x4*)(xg + (xo0 + i * xstep + (unsigned)(kt) * 128u)); \
    _Pragma("unroll") for (int i = 0; i < 2; ++i) wr[i] = *(const u32x4*)(wg + (wo0 + i * wstep + (unsigned)(kt) * 128u)); } while (0)
#define GWRITE(s, xr, wr) do { char* b_ = lds + (s) * G_STAGE; _Pragma("unroll") for (int i = 0; i < 4; ++i) *(u32x4*)(b_ + sw + i * 8192) = xr[i]; \
    _Pragma("unroll") for (int i = 0; i < 2; ++i) *(u32x4*)(b_ + G_XB + sw + i * 8192) = wr[i]; } while (0)
#define GCOMPUTE(s) do { const char* sb = lds + (s) * G_STAGE; _Pragma("unroll") for (int ks = 0; ks < 4; ++ks) { \
      const bf16x8 a0 = *(const bf16x8*)(sb + rowA + koff[ks]); const bf16x8 a1 = *(const bf16x8*)(sb + rowA + 4096 + koff[ks]); \
      const bf16x8 b0 = *(const bf16x8*)(sb + rowB + koff[ks]); const bf16x8 b1 = *(const bf16x8*)(sb + rowB + 4096 + koff[ks]); \
      acc[0][0] = __builtin_amdgcn_mfma_f32_32x32x16_bf16(a0, b0, acc[0][0], 0, 0, 0); acc[0][1] = __builtin_amdgcn_mfma_f32_32x32x16_bf16(a0, b1, acc[0][1], 0, 0, 0); \
      acc[1][0] = __builtin_amdgcn_mfma_f32_32x32x16_bf16(a1, b0, acc[1][0], 0, 0, 0); acc[1][1] = __builtin_amdgcn_mfma_f32_32x32x16_bf16(a1, b1, acc[1][1], 0, 0, 0); } } while (0)
  __syncthreads();
  GLOAD(xa, wa, 0); GLOAD(xb, wb, 1); GWRITE(0, xa, wa); __syncthreads();
#pragma nounroll
  for (int kt = 0; kt < nk; kt += 2) {
    const int ka = kt + 2 < nk ? kt + 2 : nk - 2, kb = kt + 3 < nk ? kt + 3 : nk - 1;
    GLOAD(xa, wa, ka);
    GCOMPUTE(0);
    GWRITE(1, xb, wb);
    __syncthreads();
    GLOAD(xb, wb, kb);
    GCOMPUTE(1);
    GWRITE(0, xa, wa);
    __syncthreads();
  }
  asm volatile("s_waitcnt vmcnt(0)" ::: "memory");
#undef GLOAD
#undef GWRITE
#undef GCOMPUTE
}
__device__ __forceinline__ void zero_acc(f32x16 (&acc)[2][2]) {
#pragma unroll
  for (int a = 0; a < 2; ++a)
#pragma unroll
    for (int b = 0; b < 2; ++b)
#pragma unroll
      for (int r = 0; r < 16; ++r) acc[a][b][r] = 0.f;
}

constexpr int G2_XB = 256 * 128, G2_STAGE = 2 * G2_XB;
__device__ __forceinline__ void gemm_kloop256(const bf16_t* __restrict__ X, int ldx, const bf16_t* __restrict__ W, int ldw, int nk,
                                              f32x16 (&acc)[2][4], char* lds) {
  const int tid = opaque_tid(), wid = __builtin_amdgcn_readfirstlane(tid >> 6), lane = tid & 63, r32 = lane & 31, hi = lane >> 5, wm = wid & 1, wn = wid >> 1;
  const int srow = tid >> 3, sch = tid & 7;
  const char* xg = (const char*)X; const char* wg = (const char*)W;
  const unsigned xstep = (unsigned)ldx * 128u, wstep = (unsigned)ldw * 128u;
  const unsigned xo0 = (unsigned)(srow * ldx + sch * 8) * 2u, wo0 = (unsigned)(srow * ldw + sch * 8) * 2u;
  const int sw = gswz(srow, sch);
  u32x4 xa[4], wa[4];
  const int fsw = (r32 >> 1) & 7;
  int koff[4];
#pragma unroll
  for (int ks = 0; ks < 4; ++ks) koff[ks] = ((2 * ks + hi) ^ fsw) << 4;
  const int rowA = G2_XB + (wn * 64 + r32) * 128, rowB = (wm * 128 + r32) * 128;
#define GLOAD(xr, wr, kt) do { _Pragma("unroll") for (int i = 0; i < 4; ++i) { xr[i] = *(const u32x4*)(xg + (xo0 + i * xstep + (unsigned)(kt) * 128u)); \
    wr[i] = *(const u32x4*)(wg + (wo0 + i * wstep + (unsigned)(kt) * 128u)); } } while (0)
#define GWRITE(s, xr, wr) do { char* b_ = lds + (s) * G2_STAGE; _Pragma("unroll") for (int i = 0; i < 4; ++i) { *(u32x4*)(b_ + sw + i * 8192) = xr[i]; \
    *(u32x4*)(b_ + G2_XB + sw + i * 8192) = wr[i]; } } while (0)
#define GCOMPUTE(s) do { const char* sb = lds + (s) * G2_STAGE; _Pragma("unroll") for (int ks = 0; ks < 4; ++ks) { \
      const bf16x8 a0 = *(const bf16x8*)(sb + rowA + koff[ks]); const bf16x8 a1 = *(const bf16x8*)(sb + rowA + 4096 + koff[ks]); \
      _Pragma("unroll") for (int ti = 0; ti < 4; ++ti) { const bf16x8 b = *(const bf16x8*)(sb + rowB + ti * 4096 + koff[ks]); \
        acc[0][ti] = __builtin_amdgcn_mfma_f32_32x32x16_bf16(a0, b, acc[0][ti], 0, 0, 0); acc[1][ti] = __builtin_amdgcn_mfma_f32_32x32x16_bf16(a1, b, acc[1][ti], 0, 0, 0); } } } while (0)
  __syncthreads();
  GLOAD(xa, wa, 0); GWRITE(0, xa, wa); __syncthreads();
#pragma nounroll
  for (int kt = 0; kt < nk; kt += 2) {
    const int ka = kt + 1, kb = kt + 2 < nk ? kt + 2 : nk - 1;
    GLOAD(xa, wa, ka);
    GCOMPUTE(0);
    GWRITE(1, xa, wa);
    __syncthreads();
    GLOAD(xa, wa, kb);
    GCOMPUTE(1);
    GWRITE(0, xa, wa);
    __syncthreads();
  }
  asm volatile("s_waitcnt vmcnt(0)" ::: "memory");
#undef GLOAD
#undef GWRITE
#undef GCOMPUTE
}
__device__ __forceinline__ void zero_acc4(f32x16 (&acc)[2][4]) {
#pragma unroll
  for (int a = 0; a < 2; ++a)
#pragma unroll
    for (int b = 0; b < 4; ++b)
#pragma unroll
      for (int r = 0; r < 16; ++r) acc[a][b][r] = 0.f;
}

__device__ __forceinline__ void stage_put(char* wb, int t, int q, float a, float b, float c, float d) {
  u32x2 w; w.x = cvtpk(a, b); w.y = cvtpk(c, d);
  *(u32x2*)(wb + t * 128 + ((q ^ ((t & 7) << 1)) << 3)) = w;
}
__device__ __forceinline__ void stage_flush(const char* wb, bf16_t* dst, int ld, int lane) {
#pragma unroll
  for (int i = 0; i < 8; ++i) {
    const int row = i * 8 + (lane >> 3), c = lane & 7;
    const u32x4 v = *(const u32x4*)(wb + row * 128 + ((c ^ (row & 7)) << 4));
    *(u32x4*)(dst + (size_t)row * ld + c * 8) = v;
  }
}
__device__ __forceinline__ void stage_flush128(const char* wb, bf16_t* dst, int ld, int lane) {
#pragma unroll
  for (int i = 0; i < 16; ++i) {
    const int row = i * 8 + (lane >> 3), c = lane & 7;
    const u32x4 v = *(const u32x4*)(wb + row * 128 + ((c ^ (row & 7)) << 4));
    *(u32x4*)(dst + (size_t)row * ld + c * 8) = v;
  }
}
__device__ __forceinline__ void stage_flush_add(const char* wb, bf16_t* dst, int ld, int lane) {
#pragma unroll
  for (int i = 0; i < 8; ++i) {
    const int row = i * 8 + (lane >> 3), c = lane & 7;
    const u32x4 v = *(const u32x4*)(wb + row * 128 + ((c ^ (row & 7)) << 4));
    u32x4* gp = (u32x4*)(dst + (size_t)row * ld + c * 8);
    const u32x4 o = *gp;
    u32x4 r;
    r.x = cvtpk(__uint_as_float(v.x << 16) + __uint_as_float(o.x << 16), __uint_as_float(v.x & 0xffff0000u) + __uint_as_float(o.x & 0xffff0000u));
    r.y = cvtpk(__uint_as_float(v.y << 16) + __uint_as_float(o.y << 16), __uint_as_float(v.y & 0xffff0000u) + __uint_as_float(o.y & 0xffff0000u));
    r.z = cvtpk(__uint_as_float(v.z << 16) + __uint_as_float(o.z << 16), __uint_as_float(v.z & 0xffff0000u) + __uint_as_float(o.z & 0xffff0000u));
    r.w = cvtpk(__uint_as_float(v.w << 16) + __uint_as_float(o.w << 16), __uint_as_float(v.w & 0xffff0000u) + __uint_as_float(o.w & 0xffff0000u));
    *gp = r;
  }
}
__device__ __forceinline__ void epi_rope64(const f32x16& a0, const f32x16& a1, int t, const float* __restrict__ gain, float ps,
                                           const float2* __restrict__ tabA, char* wb, int tl, int hi) {
  float ss = 0.f;
#pragma unroll
  for (int r = 0; r < 16; ++r) ss += a0[r] * a0[r] + a1[r] * a1[r];
  ss += __shfl_xor(ss, 32);
  const float rn = rsqrtf(ss * (1.0f / 64.0f) + EPS);
  const int prow = t >> 6, pcol = t & 63;
#pragma unroll
  for (int g = 0; g < 4; ++g) {
    const int f0 = 8 * (g & 1) + 4 * hi, pos = g < 2 ? prow : pcol, d = 8 * g + 4 * hi;
    const float4* tp = (const float4*)(tabA + pos * 16 + f0);
    const float4 t01 = tp[0], t23 = tp[1];
    const float4 g1 = *(const float4*)(gain + d), g2 = *(const float4*)(gain + 32 + d);
    const float x10 = a0[4 * g + 0] * rn * g1.x, x11 = a0[4 * g + 1] * rn * g1.y, x12 = a0[4 * g + 2] * rn * g1.z, x13 = a0[4 * g + 3] * rn * g1.w;
    const float x20 = a1[4 * g + 0] * rn * g2.x, x21 = a1[4 * g + 1] * rn * g2.y, x22 = a1[4 * g + 2] * rn * g2.z, x23 = a1[4 * g + 3] * rn * g2.w;
    stage_put(wb, tl, 2 * g + hi, (x10 * t01.x - x20 * t01.y) * ps, (x11 * t01.z - x21 * t01.w) * ps, (x12 * t23.x - x22 * t23.y) * ps, (x13 * t23.z - x23 * t23.w) * ps);
    stage_put(wb, tl, 8 + 2 * g + hi, (x20 * t01.x + x10 * t01.y) * ps, (x21 * t01.z + x11 * t01.w) * ps, (x22 * t23.x + x12 * t23.y) * ps, (x23 * t23.z + x13 * t23.w) * ps);
  }
}
__device__ __forceinline__ void rope32_vals(const f32x16& a, float mul, int t, const float2* __restrict__ tabB, int hi, int g, float (&o1)[4], float (&o2)[4]) {
  const int pos = g == 0 ? (t >> 6) : (t & 63);
  const float4* tp = (const float4*)(tabB + pos * 8 + 4 * hi);
  const float4 t01 = tp[0], t23 = tp[1];
  const float x10 = a[4 * g + 0] * mul, x11 = a[4 * g + 1] * mul, x12 = a[4 * g + 2] * mul, x13 = a[4 * g + 3] * mul;
  const float x20 = a[8 + 4 * g + 0] * mul, x21 = a[8 + 4 * g + 1] * mul, x22 = a[8 + 4 * g + 2] * mul, x23 = a[8 + 4 * g + 3] * mul;
  o1[0] = x10 * t01.x - x20 * t01.y; o1[1] = x11 * t01.z - x21 * t01.w; o1[2] = x12 * t23.x - x22 * t23.y; o1[3] = x13 * t23.z - x23 * t23.w;
  o2[0] = x20 * t01.x + x10 * t01.y; o2[1] = x21 * t01.z + x11 * t01.w; o2[2] = x22 * t23.x + x12 * t23.y; o2[3] = x23 * t23.z + x13 * t23.w;
}
__device__ __forceinline__ void epi_rope32(const f32x16& a, float mul, int t, const float2* __restrict__ tabB, char* wb, int tl, int qb, int hi) {
#pragma unroll
  for (int g = 0; g < 2; ++g) {
    float o1[4], o2[4];
    rope32_vals(a, mul, t, tabB, hi, g, o1, o2);
    stage_put(wb, tl, qb + 2 * g + hi, o1[0], o1[1], o1[2], o1[3]);
    stage_put(wb, tl, qb + 4 + 2 * g + hi, o2[0], o2[1], o2[2], o2[3]);
  }
}
__device__ __forceinline__ void epi_rope32_direct(const f32x16& a, float mul, int t, const float2* __restrict__ tabB, bf16_t* dst, int hi) {
#pragma unroll
  for (int g = 0; g < 2; ++g) {
    float o1[4], o2[4];
    rope32_vals(a, mul, t, tabB, hi, g, o1, o2);
    st4(dst + 8 * g + 4 * hi, o1[0], o1[1], o1[2], o1[3]);
    st4(dst + 16 + 8 * g + 4 * hi, o2[0], o2[1], o2[2], o2[3]);
  }
}
__device__ __forceinline__ void epi_plain32(const f32x16& a, float mul, char* wb, int tl, int qb, int hi) {
#pragma unroll
  for (int g = 0; g < 4; ++g) stage_put(wb, tl, qb + 2 * g + hi, a[4 * g] * mul, a[4 * g + 1] * mul, a[4 * g + 2] * mul, a[4 * g + 3] * mul);
}
__device__ __forceinline__ void epi_silu32(const f32x16& a, char* wb, int tl, int qb, int hi) {
#pragma unroll
  for (int g = 0; g < 4; ++g)
    stage_put(wb, tl, qb + 2 * g + hi, a[4 * g] * sigmoidf_(a[4 * g]), a[4 * g + 1] * sigmoidf_(a[4 * g + 1]), a[4 * g + 2] * sigmoidf_(a[4 * g + 2]),
              a[4 * g + 3] * sigmoidf_(a[4 * g + 3]));
}
__device__ __forceinline__ float sumsq16(const f32x16& a) {
  float s = 0.f;
#pragma unroll
  for (int r = 0; r < 16; ++r) s += a[r] * a[r];
  return s;
}

struct TileIter {
  int q, step, end, NT, mbase; bool xcd;
  __device__ __forceinline__ TileIter(int nt_count) {
    NT = nt_count; xcd = (gridDim.x == 256);
    if (xcd) { q = blockIdx.x >> 3; step = 32; end = 16 * NT; mbase = (blockIdx.x & 7) * 16; }
    else { q = blockIdx.x; step = gridDim.x; end = 128 * NT; mbase = 0; }
  }
  __device__ __forceinline__ bool next(int& mt, int& nt) { if (q >= end) return false; mt = mbase + q / NT; nt = q % NT; q += step; return true; }
};

__device__ __forceinline__ void bound_max(float* dst, float v) {
#pragma unroll
  for (int o = 32; o >= 1; o >>= 1) v = fmaxf(v, __shfl_xor(v, o));
  if ((threadIdx.x & 63) == 0) atomicMax((unsigned*)dst, __float_as_uint(v));
}
__device__ __forceinline__ void phase_g1(const Params& p, char* lds) {
  const int tid = opaque_tid(), wid = __builtin_amdgcn_readfirstlane(tid >> 6), lane = tid & 63, r32 = lane & 31, hi = lane >> 5, wm = wid & 1, wn4 = wid >> 1;
  const int wn = wn4 & 1;
  const bf16_t* H = (const bf16_t*)(p.ws + OFF_H);
  const bf16_t* WIN = (const bf16_t*)(p.ws + OFF_WIN);
  const float2* tabA = (const float2*)(p.ws + OFF_TABA);
  const float2* tabB = (const float2*)(p.ws + OFF_TABB);
  float* part = (float*)(p.ws + OFF_PART);
  char* dout = (char*)p.out;
  float bmax_kr = 0.f;
  TileIter it(10); int mt, nt2;
  while (it.next(mt, nt2)) {
    const int m0 = mt * 256;
    f32x16 acc[2][4];
    zero_acc4(acc);
    gemm_kloop256(H + (size_t)m0 * DM, DM, WIN + (size_t)nt2 * 256 * DM, DM, 16, acc, lds);
    const int nt = nt2 * 2 + (wn4 >> 1);
    char* wb = lds + wid * 16384;
    const int tok0 = m0 + wm * 128;
#pragma unroll
    for (int ti = 0; ti < 4; ++ti) {
      const int tl = ti * 32 + r32, tok = tok0 + tl;
      const int t = pos_of(tok);
      if (nt < 4) {
        epi_rope64(acc[0][ti], acc[1][ti], t, p.a_q_g, PS_A, tabA, wb, tl, hi);
      } else if (nt == 4) {
        epi_rope64(acc[0][ti], acc[1][ti], t, p.a_k_g, 1.0f, tabA, wb, tl, hi);
      } else if (nt == 5) {
        epi_plain32(acc[0][ti], 1.0f, wb, tl, 0, hi); epi_plain32(acc[1][ti], 1.0f, wb, tl, 8, hi);
      } else if (nt < 9) {
        epi_plain32(acc[0][ti], 1.0f, wb, tl, 0, hi); epi_plain32(acc[1][ti], 1.0f, wb, tl, 8, hi);
        float s = sumsq16(acc[0][ti]) + sumsq16(acc[1][ti]); s += __shfl_xor(s, 32);
        if (hi == 0) part[((nt - 6) * 2 + wn) * T + tok] = s;
      } else if (nt < 11) {
        epi_plain32(acc[0][ti], 1.0f, wb, tl, 0, hi); epi_plain32(acc[1][ti], 1.0f, wb, tl, 8, hi);
        float s = sumsq16(acc[0][ti]) + sumsq16(acc[1][ti]); s += __shfl_xor(s, 32);
        if (hi == 0) part[(6 + (nt - 9) * 2 + wn) * T + tok] = s;
      } else if (nt == 11) {
        if (wn == 0) {
          epi_rope32_direct(acc[0][ti], 1.0f, t, tabB, (bf16_t*)(p.ws + OFF_KR) + (size_t)tok * 32, hi);
          float s = sumsq16(acc[0][ti]); s += __shfl_xor(s, 32);
          bmax_kr = fmaxf(bmax_kr, s);
        }
      } else {
        epi_silu32(acc[0][ti], wb, tl, 0, hi); epi_silu32(acc[1][ti], wb, tl, 8, hi);
      }
    }
    if (nt != 11) {
      bf16_t* dst; int ld;
      if (nt < 4) { dst = (bf16_t*)(p.ws + OFF_QA) + (size_t)tok0 * 512 + (nt * 2 + wn) * 64; ld = 512; }
      else if (nt == 4) { dst = (bf16_t*)(p.ws + OFF_KA) + (size_t)tok0 * 128 + wn * 64; ld = 128; }
      else if (nt == 5) { dst = (bf16_t*)(p.ws + OFF_VA) + (size_t)tok0 * 128 + wn * 64; ld = 128; }
      else if (nt < 9) { dst = (bf16_t*)(dout + OO_BQ) + (size_t)tok0 * 384 + (nt - 6) * 128 + wn * 64; ld = 384; }
      else if (nt < 11) { dst = (bf16_t*)(dout + OO_BKV) + (size_t)tok0 * 256 + (nt - 9) * 128 + wn * 64; ld = 256; }
      else if (nt < 16) { dst = (bf16_t*)(dout + OO_GA) + (size_t)tok0 * 512 + (nt - 12) * 128 + wn * 64; ld = 512; }
      else { dst = (bf16_t*)(dout + OO_GB) + (size_t)tok0 * 512 + (nt - 16) * 128 + wn * 64; ld = 512; }
      stage_flush128(wb, dst, ld, lane);
    }
  }
  bound_max((float*)(p.ws + OFF_BND) + 3, bmax_kr);
}

__device__ __forceinline__ void phase_g2(const Params& p, char* lds) {
  const int tid = opaque_tid(), wid = __builtin_amdgcn_readfirstlane(tid >> 6), lane = tid & 63, r32 = lane & 31, hi = lane >> 5, wm = wid & 3, wn = wid >> 2;
  const float2* tabB = (const float2*)(p.ws + OFF_TABB);
  const float* part = (const float*)(p.ws + OFF_PART);
  char* dout = (char*)p.out;
  float bmax_q = 0.f, bmax_k = 0.f;
  TileIter it(14); int mt, j;
  while (it.next(mt, j)) {
    const int m0 = mt * 256;
    f32x16 acc[2][2];
    zero_acc(acc);
    char* wb = lds + wid * 8192;
    const int tok0 = m0 + wm * 64;
    if (j < 6) {
      gemm_kloop((const bf16_t*)(dout + OO_BQ) + (size_t)m0 * 384, 384, (const bf16_t*)(p.ws + OFF_WQUP) + (size_t)j * 128 * 384, 384, 6, acc, lds);
#pragma unroll
      for (int ti = 0; ti < 2; ++ti) {
        const int tl = ti * 32 + r32, tok = tok0 + tl;
        const int t = pos_of(tok);
        const float sq = (part[tok] + part[T + tok]) + (part[2 * T + tok] + part[3 * T + tok]) + (part[4 * T + tok] + part[5 * T + tok]);
        const float rn = rsqrtf(sq * (1.0f / 384.0f) + EPS) * PS_B;
#pragma unroll
        for (int fi = 0; fi < 2; ++fi) {
          const int blk = j * 4 + wn * 2 + fi;
          if (blk % 3 == 2) epi_rope32(acc[fi][ti], rn, t, tabB, wb, tl, fi * 8, hi);
          else epi_plain32(acc[fi][ti], rn, wb, tl, fi * 8, hi);
          float s = sumsq16(acc[fi][ti]); s += __shfl_xor(s, 32);
          bmax_q = fmaxf(bmax_q, s * rn * rn);
        }
      }
      stage_flush(wb, (bf16_t*)(p.ws + OFF_QB) + (size_t)tok0 * 768 + (j * 4 + wn * 2) * 32, 768, lane);
    } else {
      const int jn = j - 6;
      gemm_kloop((const bf16_t*)(dout + OO_BKV) + (size_t)m0 * 256, 256, (const bf16_t*)(p.ws + OFF_WKVUP) + (size_t)jn * 128 * 256, 256, 4, acc, lds);
#pragma unroll
      for (int ti = 0; ti < 2; ++ti) {
        const int tl = ti * 32 + r32, tok = tok0 + tl;
        const float sk = (part[6 * T + tok] + part[7 * T + tok]) + (part[8 * T + tok] + part[9 * T + tok]);
        const float rn = rsqrtf(sk * (1.0f / 256.0f) + EPS);
        epi_plain32(acc[0][ti], rn, wb, tl, 0, hi); epi_plain32(acc[1][ti], rn, wb, tl, 8, hi);
        if (wn == 0) {
          float s0 = sumsq16(acc[0][ti]), s1 = sumsq16(acc[1][ti]); s0 += __shfl_xor(s0, 32); s1 += __shfl_xor(s1, 32);
          bmax_k = fmaxf(bmax_k, fmaxf(s0, s1) * rn * rn);
        }
      }
      stage_flush(wb, (bf16_t*)(p.ws + (wn == 0 ? OFF_KBN : OFF_VB)) + (size_t)tok0 * 512 + jn * 64, 512, lane);
    }
  }
  bound_max((float*)(p.ws + OFF_BND) + 1, bmax_q);
  bound_max((float*)(p.ws + OFF_BND) + 2, bmax_k);
}

__device__ __forceinline__ void phase_g3(const Params& p, char* lds) {
  const int tid = opaque_tid(), wid = __builtin_amdgcn_readfirstlane(tid >> 6), lane = tid & 63, r32 = lane & 31, hi = lane >> 5, wm = wid & 3, wn = wid >> 2;
  char* dout = (char*)p.out;
  const bf16_t* H = (const bf16_t*)(p.ws + OFF_H);
  const bf16_t* WIN = (const bf16_t*)(p.ws + OFF_WIN);
  bf16_t* MG = (bf16_t*)(dout + OO_MERGED);
  TileIter it(8); int mt, nt;
  while (it.next(mt, nt)) {
    const int m0 = mt * 256;
#pragma nounroll
    for (int s = 0; s < 2; ++s) {
      f32x16 acc[2][2];
      zero_acc(acc);
      const bf16_t* Y = s == 0 ? (const bf16_t*)(p.ws + OFF_QA) : (const bf16_t*)(dout + OO_YB);
      const bf16_t* WOUT = (const bf16_t*)(p.ws + (s == 0 ? OFF_WAOUT : OFF_WBOUT));
      gemm_kloop(H + (size_t)m0 * DM, DM, WIN + (size_t)(2560 + s * 1024 + nt * 128) * DM, DM, 16, acc, lds);
      unsigned* gl = (unsigned*)(lds + 2 * G_STAGE) + tid;
#pragma unroll
      for (int fi = 0; fi < 2; ++fi)
#pragma unroll
        for (int ti = 0; ti < 2; ++ti)
#pragma unroll
          for (int q = 0; q < 8; ++q) gl[((fi * 2 + ti) * 8 + q) * 512] = cvtpk(sigmoidf_(acc[fi][ti][2 * q]), sigmoidf_(acc[fi][ti][2 * q + 1]));
      zero_acc(acc);
      gemm_kloop(Y + (size_t)m0 * 512, 512, WOUT + (size_t)nt * 128 * 512, 512, 8, acc, lds);
      char* wb = lds + wid * 8192;
#pragma unroll
      for (int ti = 0; ti < 2; ++ti) {
        const int tl = ti * 32 + r32;
#pragma unroll
        for (int fi = 0; fi < 2; ++fi) {
#pragma unroll
          for (int g = 0; g < 4; ++g) {
            const unsigned g01 = gl[((fi * 2 + ti) * 8 + 2 * g) * 512], g23 = gl[((fi * 2 + ti) * 8 + 2 * g + 1) * 512];
            stage_put(wb, tl, fi * 8 + 2 * g + hi, __uint_as_float(g01 << 16) * acc[fi][ti][4 * g], __uint_as_float(g01 & 0xffff0000u) * acc[fi][ti][4 * g + 1],
                      __uint_as_float(g23 << 16) * acc[fi][ti][4 * g + 2], __uint_as_float(g23 & 0xffff0000u) * acc[fi][ti][4 * g + 3]);
          }
        }
      }
      bf16_t* dst = MG + (size_t)(m0 + wm * 64) * DM + nt * 128 + wn * 64;
      if (s == 0) stage_flush(wb, dst, DM, lane); else stage_flush_add(wb, dst, DM, lane);
    }
  }
}

__device__ __forceinline__ void phase_g4(const Params& p, char* lds) {
  const int tid = opaque_tid(), wid = __builtin_amdgcn_readfirstlane(tid >> 6), lane = tid & 63, r32 = lane & 31, hi = lane >> 5, wm = wid & 1, wn4 = wid >> 1;
  char* dout = (char*)p.out;
  const bf16_t* MG = (const bf16_t*)(dout + OO_MERGED);
  bf16_t* Z = (bf16_t*)(p.ws + OFF_H);
  float* part = (float*)(p.ws + OFF_PART) + 10 * T;
  TileIter it(4); int mt, nt;
  while (it.next(mt, nt)) {
    const int m0 = mt * 256;
    f32x16 acc[2][4];
    zero_acc4(acc);
    gemm_kloop256(MG + (size_t)m0 * DM, DM, (const bf16_t*)(p.ws + OFF_WO) + (size_t)nt * 256 * DM, DM, 16, acc, lds);
    char* wb = lds + wid * 16384;
    const int tok0 = m0 + wm * 128;
#pragma unroll
    for (int ti = 0; ti < 4; ++ti) {
      const int tl = ti * 32 + r32, tok = tok0 + tl;
      epi_plain32(acc[0][ti], 1.0f, wb, tl, 0, hi); epi_plain32(acc[1][ti], 1.0f, wb, tl, 8, hi);
      float s = sumsq16(acc[0][ti]) + sumsq16(acc[1][ti]); s += __shfl_xor(s, 32);
      if (hi == 0) part[(nt * 4 + wn4) * T + tok] = s;
    }
    stage_flush128(wb, Z + (size_t)tok0 * DM + nt * 256 + wn4 * 64, DM, lane);
  }
}

__device__ __forceinline__ void phase5(const Params& p) {
  const int tid = opaque_tid(), wid = tid >> 6, lane = tid & 63;
  const float* mod = (const float*)(p.ws + OFF_MOD);
  const bf16_t* Z = (const bf16_t*)(p.ws + OFF_H);
  const float* part = (const float*)(p.ws + OFF_PART) + 10 * T;
  const int NW = gridDim.x * 8;
  for (int row0 = blockIdx.x * 8 + wid; row0 < T; row0 += 2 * NW) {
    float4 xv[2][4]; u32x2 zz[2][4]; float pz[2];
#pragma unroll
    for (int j = 0; j < 2; ++j) {
      const int row = row0 + j * NW;
      if (row < T) {
        const float* xr = xrow_ptr(p, row);
        pz[j] = lane < 16 ? part[lane * T + row] : 0.f;
#pragma unroll
        for (int i = 0; i < 4; ++i) { xv[j][i] = *(const float4*)(xr + i * 256 + lane * 4); zz[j][i] = *(const u32x2*)(Z + (size_t)row * DM + i * 256 + lane * 4); }
      }
    }
#pragma unroll
    for (int j = 0; j < 2; ++j) {
      const int row = row0 + j * NW;
      if (row < T) {
        const int b = batch_of(row);
        const float rn = rsqrtf(wave_sum(pz[j]) * (1.0f / 1024.0f) + EPS);
        float* o = p.out + (size_t)row * DM;
#pragma unroll
        for (int i = 0; i < 4; ++i) {
          const int col = i * 256 + lane * 4;
          const float4 g = *(const float4*)(p.post_g + col);
          const float4 gt = *(const float4*)(mod + b * 3072 + 2048 + col);
          float4 r;
          r.x = xv[j][i].x + gt.x * (__uint_as_float(zz[j][i].x << 16) * rn * g.x);
          r.y = xv[j][i].y + gt.y * (__uint_as_float(zz[j][i].x & 0xffff0000u) * rn * g.y);
          r.z = xv[j][i].z + gt.z * (__uint_as_float(zz[j][i].y << 16) * rn * g.z);
          r.w = xv[j][i].w + gt.w * (__uint_as_float(zz[j][i].y & 0xffff0000u) * rn * g.w);
          *(float4*)(o + col) = r;
        }
      }
    }
  }
}

#define SBAR() __builtin_amdgcn_sched_barrier(0)
constexpr float ATT_THR = 8.0f;
constexpr int SHM_V = 64 * 64 * 2;
template <int DK> struct KL { static constexpr int RB = DK == 64 ? 128 : 256; static constexpr int SHM_K = 64 * RB; };
template <int DK> __device__ __forceinline__ int kswz(int row, int c) {
  if (DK == 64) return row * 128 + ((c ^ ((row >> 1) & 7)) << 4);
  return row * 256 + ((c ^ (row & 15)) << 4);
}
__device__ __forceinline__ int v_st(int k, int c) {
  const int kk = (k & ~0xC) | ((k & 4) << 1) | ((k & 8) >> 1);
  return ((kk >> 3) * 2 + (c >> 5)) * 512 + ((kk & 7) * 32 + (c & 31)) * 2;
}
__device__ __forceinline__ int v_rd_base(int lane) { return ((lane & 3) << 3) | (((lane >> 2) & 3) << 6) | (((lane >> 4) & 1) << 5) | (((lane >> 5) & 1) << 8); }
constexpr int v_rd_off(int d0, int ks, int half) { return d0 * 512 + ks * 2048 + half * 1024; }
typedef __attribute__((address_space(3))) const char* lds_cptr;
typedef short v4i16_t __attribute__((ext_vector_type(4)));
__device__ __forceinline__ s16x4 vtr(lds_cptr p) { return __builtin_bit_cast(s16x4, __builtin_amdgcn_ds_read_tr16_b64_v4i16((__attribute__((address_space(3))) v4i16_t*)p)); }
template <int D0> __device__ __forceinline__ void pv_one(f32x16& od, lds_cptr vb, bf16x8 pa0, bf16x8 pa1, bf16x8 pa2, bf16x8 pa3) {
  const s16x4 l0 = vtr(vb + v_rd_off(D0, 0, 0)), h0 = vtr(vb + v_rd_off(D0, 0, 1)), l1 = vtr(vb + v_rd_off(D0, 1, 0)), h1 = vtr(vb + v_rd_off(D0, 1, 1));
  const s16x4 l2 = vtr(vb + v_rd_off(D0, 2, 0)), h2 = vtr(vb + v_rd_off(D0, 2, 1)), l3 = vtr(vb + v_rd_off(D0, 3, 0)), h3 = vtr(vb + v_rd_off(D0, 3, 1));
#define PK(L, Hh) (bf16x8){L[0], L[1], L[2], L[3], Hh[0], Hh[1], Hh[2], Hh[3]}
  od = __builtin_amdgcn_mfma_f32_32x32x16_bf16(pa0, PK(l0, h0), od, 0, 0, 0);
  od = __builtin_amdgcn_mfma_f32_32x32x16_bf16(pa1, PK(l1, h1), od, 0, 0, 0);
  od = __builtin_amdgcn_mfma_f32_32x32x16_bf16(pa2, PK(l2, h2), od, 0, 0, 0);
  od = __builtin_amdgcn_mfma_f32_32x32x16_bf16(pa3, PK(l3, h3), od, 0, 0, 0);
#undef PK
}
__device__ __forceinline__ void pv_all(f32x16* o, lds_cptr vb, bf16x8 pa0, bf16x8 pa1, bf16x8 pa2, bf16x8 pa3) {
  pv_one<0>(o[0], vb, pa0, pa1, pa2, pa3); pv_one<1>(o[1], vb, pa0, pa1, pa2, pa3);
}
__device__ __forceinline__ void partialSM(f32x16& p0, f32x16& p1, float& m_reg, float& alpha) {
  float pmax = p0[0];
#pragma unroll
  for (int r = 1; r < 16; ++r) pmax = fmaxf(pmax, p0[r]);
#pragma unroll
  for (int r = 0; r < 16; ++r) pmax = fmaxf(pmax, p1[r]);
  { auto rr = __builtin_amdgcn_permlane32_swap(__float_as_uint(pmax), __float_as_uint(pmax), false, false);
    pmax = fmaxf(__uint_as_float(rr[0]), __uint_as_float(rr[1])); }
  float mn;
  if (__builtin_expect(__all(pmax - m_reg <= ATT_THR), 1)) { mn = m_reg; alpha = 1.f; }
  else { mn = fmaxf(m_reg, pmax); alpha = __builtin_amdgcn_exp2f(m_reg - mn); m_reg = mn; }
#pragma unroll
  for (int r = 0; r < 16; ++r) p0[r] -= mn;
#pragma unroll
  for (int r = 0; r < 16; ++r) p1[r] -= mn;
#pragma unroll
  for (int r = 0; r < 16; ++r) p0[r] = __builtin_amdgcn_exp2f(p0[r]);
}
__device__ __forceinline__ void finishSM(f32x16& p0, f32x16& p1, float alpha, float& l_reg, bf16x8& pa0, bf16x8& pa1, bf16x8& pa2, bf16x8& pa3) {
#pragma unroll
  for (int r = 0; r < 16; ++r) p1[r] = __builtin_amdgcn_exp2f(p1[r]);
  float ps = 0.f;
#pragma unroll
  for (int r = 0; r < 16; ++r) ps += p0[r];
#pragma unroll
  for (int r = 0; r < 16; ++r) ps += p1[r];
  { auto rr = __builtin_amdgcn_permlane32_swap(__float_as_uint(ps), __float_as_uint(ps), false, false);
    ps = __uint_as_float(rr[0]) + __uint_as_float(rr[1]); }
  l_reg = l_reg * alpha + ps;
#define PK4(P, BASE, OUT) do { unsigned a0 = cvtpk(P[BASE + 0], P[BASE + 1]), a1 = cvtpk(P[BASE + 2], P[BASE + 3]);   \
    unsigned b0 = cvtpk(P[BASE + 4], P[BASE + 5]), b1 = cvtpk(P[BASE + 6], P[BASE + 7]);                              \
    auto r0 = __builtin_amdgcn_permlane32_swap(a0, b0, false, false); auto r1 = __builtin_amdgcn_permlane32_swap(a1, b1, false, false); \
    u32x4 w = {r0[0], r1[0], r0[1], r1[1]}; OUT = *reinterpret_cast<bf16x8*>(&w); } while (0)
  PK4(p0, 0, pa0); PK4(p0, 8, pa1); PK4(p1, 0, pa2); PK4(p1, 8, pa3);
#undef PK4
}
template <int DK> __device__ __forceinline__ void qkt(f32x16& p0, f32x16& p1, const char* Ks, const bf16x8* qr, int r32, int hi) {
#pragma unroll
  for (int r = 0; r < 16; ++r) { p0[r] = 0.f; p1[r] = 0.f; }
#pragma unroll
  for (int d0 = 0; d0 < DK / 16; ++d0) {
    const int off = kswz<DK>(r32, 2 * d0 + hi);
    const bf16x8 b0 = *reinterpret_cast<const bf16x8*>(Ks + off);
    const bf16x8 b1 = *reinterpret_cast<const bf16x8*>(Ks + off + 32 * KL<DK>::RB);
    p0 = __builtin_amdgcn_mfma_f32_32x32x16_bf16(b0, qr[d0], p0, 0, 0, 0);
    p1 = __builtin_amdgcn_mfma_f32_32x32x16_bf16(b1, qr[d0], p1, 0, 0, 0);
    if (QKT_SB && (d0 & 1) == 1 && d0 + 1 < DK / 16) SBAR();
  }
}

template <int DK>
__device__ __forceinline__ void attn_unit(const bf16_t* Qb, int ldq, const bf16_t* __restrict__ Kh, int ldk, const bf16_t* __restrict__ Krp,
                                          const bf16_t* __restrict__ Vh, int ldv, const bf16_t* Gb, bf16_t* Ob, int seq, char* lds) {
  constexpr int SHM_K = KL<DK>::SHM_K;
  const int tid = opaque_tid(), wid = __builtin_amdgcn_readfirstlane(tid >> 6), lane = tid & 63, r32 = lane & 31, hi = lane >> 5;
  char* V_lds = lds; char* K_lds = lds + 2 * SHM_V;
  float* ws = (float*)(lds + 2 * SHM_V + 2 * SHM_K) + wid * 64; float* li_l = ws; float* al_l = ws + 32;
  float m_reg = -1e30f, l_reg = 0.f; f32x16 o[2]; bf16x8 qr[DK / 16];
#pragma unroll
  for (int r = 0; r < 16; ++r) { o[0][r] = 0.f; o[1][r] = 0.f; }
  const bf16_t* Qw = Qb + (size_t)(wid * 32 + r32) * ldq + hi * 8;
#pragma unroll
  for (int d0 = 0; d0 < DK / 16; ++d0) qr[d0] = *reinterpret_cast<const bf16x8*>(Qw + d0 * 16);
  const int srow = tid >> 3, sc = tid & 7, vst = v_st(srow, sc * 8), kst = kswz<DK>(srow, sc);
  const int rrow = tid >> 2, rc = tid & 3, krst = kswz<DK>(rrow & 63, 8 + rc);
  const bool dor = (DK == 96) && (wid < 4);
  const lds_cptr vb0 = (lds_cptr)V_lds + v_rd_base(lane);
  struct { u32x4 v, k, r; } sr_[1];
  const unsigned voff0 = (unsigned)(srow * ldv + sc * 8) * 2u, koff0 = (unsigned)(srow * ldk + sc * 8) * 2u, roff0 = (unsigned)(rrow * 32 + rc * 8) * 2u;
#define SLOAD(i, k0) do { sr_[i].v = *(const u32x4*)((const char*)Vh + (voff0 + (unsigned)((k0) * ldv) * 2u)); sr_[i].k = *(const u32x4*)((const char*)Kh + (koff0 + (unsigned)((k0) * ldk) * 2u)); \
    if (dor) sr_[i].r = *(const u32x4*)((const char*)Krp + (roff0 + (unsigned)((k0) * 64))); } while (0)
#define SWRITE(b, i) do { *(u32x4*)(V_lds + (b) * SHM_V + vst) = sr_[i].v; *(u32x4*)(K_lds + (b) * SHM_K + kst) = sr_[i].k; \
    if (dor) *(u32x4*)(K_lds + (b) * SHM_K + krst) = sr_[i].r; } while (0)
#define RESC(a) do { if (__any((a) < 1.f)) { if (hi == 0) al_l[r32] = (a); asm volatile("s_waitcnt lgkmcnt(0)" ::: "memory"); \
    _Pragma("unroll") for (int d = 0; d < 2; ++d) _Pragma("unroll") for (int r = 0; r < 16; ++r) o[d][r] *= al_l[crow(r, hi)]; } } while (0)
  f32x16 pA0, pA1, pB0, pB1; float alA, alB; bf16x8 pa0, pa1, pa2, pa3; const int NT = seq / 64;
  __syncthreads();
  SLOAD(0, 0); SWRITE(0, 0); __syncthreads();
  qkt<DK>(pA0, pA1, K_lds, qr, r32, hi); partialSM(pA0, pA1, m_reg, alA);
  SLOAD(0, 64);
  SWRITE(1, 0); __syncthreads();
  for (int j = 1; j + 1 < NT; j += 2) {
    SBAR(); qkt<DK>(pB0, pB1, K_lds + SHM_K, qr, r32, hi);
    finishSM(pA0, pA1, alA, l_reg, pa0, pa1, pa2, pa3); SBAR();
    SLOAD(0, (j + 1) * 64); SBAR();
    pv_all(o, vb0, pa0, pa1, pa2, pa3); partialSM(pB0, pB1, m_reg, alB);
    __syncthreads(); SWRITE(0, 0);
    RESC(alB); __syncthreads();
    SBAR(); qkt<DK>(pA0, pA1, K_lds, qr, r32, hi);
    finishSM(pB0, pB1, alB, l_reg, pa0, pa1, pa2, pa3); SBAR();
    SLOAD(0, (j + 2) * 64); SBAR();
    pv_all(o, vb0 + SHM_V, pa0, pa1, pa2, pa3); partialSM(pA0, pA1, m_reg, alA);
    __syncthreads(); SWRITE(1, 0);
    RESC(alA); __syncthreads();
  }
  SBAR(); qkt<DK>(pB0, pB1, K_lds + SHM_K, qr, r32, hi);
  finishSM(pA0, pA1, alA, l_reg, pa0, pa1, pa2, pa3); SBAR();
  pv_all(o, vb0, pa0, pa1, pa2, pa3); partialSM(pB0, pB1, m_reg, alB);
  __syncthreads(); RESC(alB);
  finishSM(pB0, pB1, alB, l_reg, pa0, pa1, pa2, pa3); SBAR();
  pv_all(o, vb0 + SHM_V, pa0, pa1, pa2, pa3);
  if (hi == 0) li_l[r32] = l_reg; asm volatile("s_waitcnt lgkmcnt(0)" ::: "memory");
  float rli[16];
#pragma unroll
  for (int r = 0; r < 16; ++r) rli[r] = __builtin_amdgcn_rcpf(li_l[crow(r, hi)]);
#pragma unroll
  for (int r = 0; r < 16; ++r) {
    const size_t rowo = (size_t)(wid * 32 + crow(r, hi)) * 512;
#pragma unroll
    for (int d0 = 0; d0 < 2; ++d0) {
      const size_t idx = rowo + d0 * 32 + r32;
      const float g = bf2f(Gb[idx]);
      Ob[idx] = (bf16_t)(cvtpk(o[d0][r] * rli[r] * g, 0.f) & 0xffffu);
    }
  }
#undef SLOAD
#undef SWRITE
#undef RESC
}

__device__ __forceinline__ void exp16(f32x16& p) {
#pragma unroll
  for (int r = 0; r < 16; ++r) p[r] = __builtin_amdgcn_exp2f(p[r]);
}
__device__ __forceinline__ void finishFast(f32x16& p0, f32x16& p1, float& l_reg, bf16x8& pa0, bf16x8& pa1, bf16x8& pa2, bf16x8& pa3) {
  exp16(p1);
  float ps = 0.f;
#pragma unroll
  for (int r = 0; r < 16; ++r) ps += p0[r];
#pragma unroll
  for (int r = 0; r < 16; ++r) ps += p1[r];
  l_reg += ps;
#define PK4(P, BASE, OUT) do { unsigned a0 = cvtpk(P[BASE + 0], P[BASE + 1]), a1 = cvtpk(P[BASE + 2], P[BASE + 3]);   \
    unsigned b0 = cvtpk(P[BASE + 4], P[BASE + 5]), b1 = cvtpk(P[BASE + 6], P[BASE + 7]);                              \
    auto r0 = __builtin_amdgcn_permlane32_swap(a0, b0, false, false); auto r1 = __builtin_amdgcn_permlane32_swap(a1, b1, false, false); \
    u32x4 w = {r0[0], r1[0], r0[1], r1[1]}; OUT = *reinterpret_cast<bf16x8*>(&w); } while (0)
  PK4(p0, 0, pa0); PK4(p0, 8, pa1); PK4(p1, 0, pa2); PK4(p1, 8, pa3);
#undef PK4
}
template <int DK>
__device__ __forceinline__ void attn_unit_fast(const bf16_t* Qb, int ldq, const bf16_t* __restrict__ Kh, int ldk, const bf16_t* __restrict__ Krp,
                                               const bf16_t* __restrict__ Vh, int ldv, const bf16_t* Gb, bf16_t* Ob, int seq, char* lds) {
  constexpr int SHM_K = KL<DK>::SHM_K;
  const int tid = opaque_tid(), wid = __builtin_amdgcn_readfirstlane(tid >> 6), lane = tid & 63, r32 = lane & 31, hi = lane >> 5;
  char* V_lds = lds; char* K_lds = lds + 3 * SHM_V;
  float* ws = (float*)(lds + 3 * SHM_V + 3 * SHM_K) + wid * 64; float* li_l = ws;
  float l_reg = 0.f; f32x16 o[2]; bf16x8 qr[DK / 16];
#pragma unroll
  for (int r = 0; r < 16; ++r) { o[0][r] = 0.f; o[1][r] = 0.f; }
  const bf16_t* Qw = Qb + (size_t)(wid * 32 + r32) * ldq + hi * 8;
#pragma unroll
  for (int d0 = 0; d0 < DK / 16; ++d0) qr[d0] = *reinterpret_cast<const bf16x8*>(Qw + d0 * 16);
  const int srow = tid >> 3, sc = tid & 7, vst = v_st(srow, sc * 8), kst = kswz<DK>(srow, sc);
  const int rrow = tid >> 2, rc = tid & 3, krst = kswz<DK>(rrow & 63, 8 + rc);
  const bool dor = (DK == 96) && (wid < 4);
  const lds_cptr vb0 = (lds_cptr)V_lds + v_rd_base(lane);
  struct { u32x4 v, k, r; } sr_[1];
  const unsigned voff0 = (unsigned)(srow * ldv + sc * 8) * 2u, koff0 = (unsigned)(srow * ldk + sc * 8) * 2u, roff0 = (unsigned)(rrow * 32 + rc * 8) * 2u;
#define SLOAD(i, k0) do { sr_[i].v = *(const u32x4*)((const char*)Vh + (voff0 + (unsigned)((k0) * ldv) * 2u)); sr_[i].k = *(const u32x4*)((const char*)Kh + (koff0 + (unsigned)((k0) * ldk) * 2u)); \
    if (dor) sr_[i].r = *(const u32x4*)((const char*)Krp + (roff0 + (unsigned)((k0) * 64))); } while (0)
#define SWRITE(slot, i) do { *(u32x4*)(V_lds + (slot) * SHM_V + vst) = sr_[i].v; *(u32x4*)(K_lds + (slot) * SHM_K + kst) = sr_[i].k; \
    if (dor) *(u32x4*)(K_lds + (slot) * SHM_K + krst) = sr_[i].r; } while (0)
  f32x16 pA0, pA1, pB0, pB1; bf16x8 pa0, pa1, pa2, pa3; const int NT = seq / 64;
  int sp = 2, st = 0, sn = 1;
#define ROT() do { sp = st; st = sn; sn = (sn == 2) ? 0 : sn + 1; } while (0)
#define STEP(C0, C1, P0, P1, SETW, t, DOW) do { SBAR(); qkt<DK>(C0, C1, K_lds + st * SHM_K, qr, r32, hi); \
    finishFast(P0, P1, l_reg, pa0, pa1, pa2, pa3); \
    if (DOW) { SWRITE(sn, 0); if ((t) + 2 < NT) SLOAD(0, ((t) + 2) * 64); } \
    pv_all(o, vb0 + sp * SHM_V, pa0, pa1, pa2, pa3); exp16(C0); \
    __syncthreads(); ROT(); } while (0)
  __syncthreads();
  SLOAD(0, 0); SWRITE(0, 0); SLOAD(0, 64); __syncthreads();
  qkt<DK>(pA0, pA1, K_lds, qr, r32, hi);
  SWRITE(1, 0); SLOAD(0, 128);
  exp16(pA0);
  __syncthreads(); ROT();
  for (int t = 1; t + 1 < NT; t += 2) {
    STEP(pB0, pB1, pA0, pA1, 0, t, true);
    STEP(pA0, pA1, pB0, pB1, 1, t + 1, true);
  }
  STEP(pB0, pB1, pA0, pA1, 0, NT - 1, false);
  finishFast(pB0, pB1, l_reg, pa0, pa1, pa2, pa3); SBAR();
  pv_all(o, vb0 + sp * SHM_V, pa0, pa1, pa2, pa3);
  { auto rr = __builtin_amdgcn_permlane32_swap(__float_as_uint(l_reg), __float_as_uint(l_reg), false, false);
    l_reg = __uint_as_float(rr[0]) + __uint_as_float(rr[1]); }
  if (hi == 0) li_l[r32] = l_reg; asm volatile("s_waitcnt lgkmcnt(0)" ::: "memory");
  float rli[16];
#pragma unroll
  for (int r = 0; r < 16; ++r) rli[r] = __builtin_amdgcn_rcpf(li_l[crow(r, hi)]);
#pragma unroll
  for (int r = 0; r < 16; ++r) {
    const size_t rowo = (size_t)(wid * 32 + crow(r, hi)) * 512;
#pragma unroll
    for (int d0 = 0; d0 < 2; ++d0) {
      const size_t idx = rowo + d0 * 32 + r32;
      const float g = bf2f(Gb[idx]);
      Ob[idx] = (bf16_t)(cvtpk(o[d0][r] * rli[r] * g, 0.f) & 0xffffu);
    }
  }
#undef SLOAD
#undef SWRITE
#undef ROT
#undef STEP
}

__device__ __forceinline__ void phase_attn(const Params& p, char* lds) {
  char* dout = (char*)p.out;
  const float* bnd = (const float*)(p.ws + OFF_BND);
  const bool fastA = bnd[0] < 60.0f;
  const bool fastB = 3.0f * bnd[1] * (2.0f * bnd[2] + bnd[3]) < 3600.0f;
  for (int u = blockIdx.x; u < 2048; u += gridDim.x) {
    const int i = u >> 8, v = u & 255, cls = i >> 1, sub = i & 1, head = v & 7, j = v >> 3;
    int seq0, seq, tok0;
    if (cls < 2) { seq0 = 0; seq = NP; tok0 = (2 * j + sub) * 256; }
    else { const int bi = j >> 3, qb = 2 * (j & 7) + sub; seq0 = NP + bi * NS; seq = NS; tok0 = seq0 + qb * 256; }
    if ((cls & 1) == 0) {
      bf16_t* QA = (bf16_t*)(p.ws + OFF_QA);
      const bf16_t* Kp = (const bf16_t*)(p.ws + OFF_KA) + (size_t)seq0 * 128 + (head >> 2) * 64;
      const bf16_t* Vp = (const bf16_t*)(p.ws + OFF_VA) + (size_t)seq0 * 128 + (head >> 2) * 64;
      const bf16_t* Gp = (const bf16_t*)(dout + OO_GA) + (size_t)tok0 * 512 + head * 64;
      bf16_t* Qp = QA + (size_t)tok0 * 512 + head * 64;
      if (fastA) attn_unit_fast<64>(Qp, 512, Kp, 128, nullptr, Vp, 128, Gp, Qp, seq, lds);
      else if (ATT_SAFE) attn_unit<64>(Qp, 512, Kp, 128, nullptr, Vp, 128, Gp, Qp, seq, lds);
    } else {
      const bf16_t* Qp = (const bf16_t*)(p.ws + OFF_QB) + (size_t)tok0 * 768 + head * 96;
      const bf16_t* Kp = (const bf16_t*)(p.ws + OFF_KBN) + (size_t)seq0 * 512 + head * 64;
      const bf16_t* Rp = (const bf16_t*)(p.ws + OFF_KR) + (size_t)seq0 * 32;
      const bf16_t* Vp = (const bf16_t*)(p.ws + OFF_VB) + (size_t)seq0 * 512 + head * 64;
      const bf16_t* Gp = (const bf16_t*)(dout + OO_GB) + (size_t)tok0 * 512 + head * 64;
      bf16_t* Op = (bf16_t*)(dout + OO_YB) + (size_t)tok0 * 512 + head * 64;
      if (fastB) attn_unit_fast<96>(Qp, 768, Kp, 512, Rp, Vp, 512, Gp, Op, seq, lds);
      else if (ATT_SAFE) attn_unit<96>(Qp, 768, Kp, 512, Rp, Vp, 512, Gp, Op, seq, lds);
    }
  }
}

__device__ __forceinline__ void grid_barrier(unsigned* ctr, unsigned target) {
  asm volatile("s_waitcnt vmcnt(0)" ::: "memory");
  __syncthreads();
  if (threadIdx.x == 0) {
    __builtin_amdgcn_fence(__ATOMIC_RELEASE, "agent");
    asm volatile("s_waitcnt vmcnt(0)" ::: "memory");
    (void)__hip_atomic_fetch_add(ctr, 1u, __ATOMIC_RELAXED, __HIP_MEMORY_SCOPE_AGENT);
    unsigned spins = 0;
    while (__hip_atomic_load(ctr, __ATOMIC_RELAXED, __HIP_MEMORY_SCOPE_AGENT) < target) {
      __builtin_amdgcn_s_sleep(2);
      if (++spins > (1u << 24)) break;
    }
    __builtin_amdgcn_fence(__ATOMIC_ACQUIRE, "agent");
    asm volatile("s_waitcnt vmcnt(0)" ::: "memory");
  }
  __syncthreads();
}

#if MK_SINGLE
#ifndef PROBE_MASK
#define PROBE_MASK 0
#endif
__global__ void __launch_bounds__(512) fwd_kernel(Params p) {
  extern __shared__ __attribute__((aligned(16))) char lds[];
#if PROBE_MASK
  volatile unsigned long long* tst = (volatile unsigned long long*)(p.ws + OFF_BND + 256) + blockIdx.x * 16;
  if (threadIdx.x == 0) tst[0] = wall_clock64();
#define STAMP(k) if (threadIdx.x == 0) tst[k + 1] = wall_clock64();
#else
#define STAMP(k)
#endif
#define PHASE(k, call) if (PH_MASK & (1 << k)) { call; if (k == 0) { cg::this_grid().sync(); STAMP(k) } else if (k < 7) { grid_barrier((unsigned*)(p.ws + OFF_BAR), gridDim.x * (unsigned)k); STAMP(k) } }
  PHASE(0, phase0(p, lds))
  PHASE(1, phase1(p))
  PHASE(2, phase_g1(p, lds))
  PHASE(3, phase_g2(p, lds))
  PHASE(4, phase_attn(p, lds))
  PHASE(5, phase_g3(p, lds))
  PHASE(6, phase_g4(p, lds))
  PHASE(7, phase5(p))
#undef PHASE
#if PROBE_MASK
  if (blockIdx.x == 0) {
    __syncthreads();
    float* dshp = (float*)lds;
    if (threadIdx.x == 0) {
    unsigned long long tot = 0;
    for (int k = 0; k < 7; ++k) if (PROBE_MASK & (1 << k)) tot += tst[k + 1] - tst[k];
    dshp[0] = sqrtf((float)tot * (0.01f / 4000.0f));
    }
    __syncthreads();
    const float d = dshp[0];
    for (int i = threadIdx.x; i < 8 * 1024; i += 512) p.out[i] += d;
  }
#endif
}
#define MAIN_KERNEL fwd_kernel
#else
template <int PH>
__global__ void __launch_bounds__(512) ph_kernel(Params p) {
  extern __shared__ __attribute__((aligned(16))) char lds[];
  if (PH == 0) phase0(p, lds);
  if (PH == 1) phase1(p);
  if (PH == 2) phase_g1(p, lds);
  if (PH == 3) phase_g2(p, lds);
  if (PH == 4) phase_attn(p, lds);
  if (PH == 5) phase_g3(p, lds);
  if (PH == 6) phase_g4(p, lds);
  if (PH == 7) phase5(p);
}
#define MAIN_KERNEL ph_kernel<4>
#endif

extern "C" void kernel_launch(void* const* d_in, const int* in_sizes, int n_in, void* d_out, int out_size, void* d_ws, size_t ws_size,
                              hipStream_t stream) {
  Params p{};
  p.x_prompt = (const float*)d_in[0]; p.x_sample = (const float*)d_in[1]; p.c_prompt = (const float*)d_in[2]; p.c_sample = (const float*)d_in[3];
  p.ada_w = (const float*)d_in[4]; p.ada_b = (const float*)d_in[5]; p.pre_g = (const float*)d_in[6]; p.post_g = (const float*)d_in[7];
  p.w_in = (const float*)d_in[8]; p.a_q_g = (const float*)d_in[9]; p.a_k_g = (const float*)d_in[10]; p.b_q_g = (const float*)d_in[11];
  p.b_q_up = (const float*)d_in[12]; p.b_kv_g = (const float*)d_in[13]; p.b_kv_up = (const float*)d_in[14]; p.a_out = (const float*)d_in[15];
  p.b_out = (const float*)d_in[16]; p.w_o = (const float*)d_in[17];
  p.out = (float*)d_out; p.ws = (char*)d_ws;
  static int grid_blocks = 0;
  if (!grid_blocks) {
    int dev = 0, cus = 0, per_cu = 0;
    (void)hipGetDevice(&dev);
    (void)hipDeviceGetAttribute(&cus, hipDeviceAttributeMultiprocessorCount, dev);
    (void)hipFuncSetAttribute((const void*)MAIN_KERNEL, hipFuncAttributeMaxDynamicSharedMemorySize, LDS_BYTES);
    (void)hipOccupancyMaxActiveBlocksPerMultiprocessor(&per_cu, MAIN_KERNEL, 512, LDS_BYTES);
    if (per_cu < 1) per_cu = 1;
    if (per_cu > 1) per_cu = 1;
    grid_blocks = cus * per_cu;
    if (grid_blocks <= 0) grid_blocks = 256;
  }
#if MK_SINGLE
  void* args[] = {&p};
  hipError_t err = hipLaunchCooperativeKernel((const void*)fwd_kernel, dim3(grid_blocks), dim3(512), args, LDS_BYTES, stream);
  if (err != hipSuccess) fprintf(stderr, "cooperative launch failed: %s (grid %d)\n", hipGetErrorString(err), grid_blocks);
#else
  static bool attr_set = false;
  if (!attr_set) {
    (void)hipFuncSetAttribute((const void*)ph_kernel<0>, hipFuncAttributeMaxDynamicSharedMemorySize, LDS_BYTES);
    (void)hipFuncSetAttribute((const void*)ph_kernel<2>, hipFuncAttributeMaxDynamicSharedMemorySize, LDS_BYTES);
    (void)hipFuncSetAttribute((const void*)ph_kernel<3>, hipFuncAttributeMaxDynamicSharedMemorySize, LDS_BYTES);
    (void)hipFuncSetAttribute((const void*)ph_kernel<5>, hipFuncAttributeMaxDynamicSharedMemorySize, LDS_BYTES);
    (void)hipFuncSetAttribute((const void*)ph_kernel<6>, hipFuncAttributeMaxDynamicSharedMemorySize, LDS_BYTES);
    attr_set = true;
  }
  hipLaunchKernelGGL(ph_kernel<0>, dim3(grid_blocks), dim3(512), LDS_BYTES, stream, p);
  hipLaunchKernelGGL(ph_kernel<1>, dim3(grid_blocks), dim3(512), LDS_BYTES, stream, p);
  hipLaunchKernelGGL(ph_kernel<2>, dim3(grid_blocks), dim3(512), LDS_BYTES, stream, p);
  hipLaunchKernelGGL(ph_kernel<3>, dim3(grid_blocks), dim3(512), LDS_BYTES, stream, p);
  hipLaunchKernelGGL(ph_kernel<4>, dim3(grid_blocks), dim3(512), LDS_BYTES, stream, p);
  hipLaunchKernelGGL(ph_kernel<5>, dim3(grid_blocks), dim3(512), LDS_BYTES, stream, p);
  hipLaunchKernelGGL(ph_kernel<6>, dim3(grid_blocks), dim3(512), LDS_BYTES, stream, p);
  hipLaunchKernelGGL(ph_kernel<7>, dim3(grid_blocks), dim3(512), LDS_BYTES, stream, p);
#endif
}
```

```cpp
#include <hip/hip_runtime.h>
#include <hip/hip_cooperative_groups.h>
#include <stdint.h>
#include <cstdio>
namespace cg = cooperative_groups;

#ifndef MK_SINGLE
#define MK_SINGLE 1
#endif
#ifndef QKT_SB
#define QKT_SB 0
#endif
#ifndef ATT_SAFE
#define ATT_SAFE 1
#endif
#ifndef PH_MASK
#define PH_MASK 255
#endif

typedef unsigned short bf16_t;
typedef short bf16x8 __attribute__((ext_vector_type(8)));
typedef short s16x4 __attribute__((ext_vector_type(4)));
typedef float f32x16 __attribute__((ext_vector_type(16)));
typedef unsigned u32x4 __attribute__((ext_vector_type(4)));
typedef unsigned u32x2 __attribute__((ext_vector_type(2)));

constexpr int T = 32768, NP = 16384, NS = 4096, DM = 1024;
constexpr float EPS = 1e-6f;
constexpr float LOG2E = 1.4426950408889634f;
constexpr float PS_A = 0.125f * LOG2E;
constexpr float PS_B = 0.10206207261596575f * LOG2E;

constexpr size_t U = 67108864ull;
constexpr size_t OFF_H = 0;
constexpr size_t OFF_QA = U;
constexpr size_t OFF_KA = U + U / 2;
constexpr size_t OFF_VA = OFF_KA + U / 8;
constexpr size_t OFF_KR = OFF_VA + U / 8;
constexpr size_t OFF_PART = OFF_KR + 2097152;
constexpr size_t OFF_QB = 2 * U;
constexpr size_t OFF_KBN = OFF_QB + (U / 4) * 3;
constexpr size_t OFF_VB = OFF_KBN + U / 2;
constexpr size_t OFF_W = OFF_VB + U / 2;
constexpr size_t OFF_WIN = OFF_W;
constexpr size_t OFF_WQUP = OFF_WIN + 4608ull * 1024 * 2;
constexpr size_t OFF_WKVUP = OFF_WQUP + 768ull * 384 * 2;
constexpr size_t OFF_WAOUT = OFF_WKVUP + 1024ull * 256 * 2;
constexpr size_t OFF_WBOUT = OFF_WAOUT + 1024ull * 512 * 2;
constexpr size_t OFF_WO = OFF_WBOUT + 1024ull * 512 * 2;
constexpr size_t OFF_MOD = OFF_WO + 1024ull * 1024 * 2;
constexpr size_t OFF_SSQ = OFF_MOD + 5 * 3072 * 4;
constexpr size_t OFF_TABA = OFF_SSQ + 3ull * T * 4;
constexpr size_t OFF_TABB = OFF_TABA + 256 * 16 * 8;
constexpr size_t OFF_BND = OFF_TABB + 256 * 8 * 8;
constexpr size_t OFF_BAR = OFF_BND + 128;
constexpr size_t WS_END = OFF_BND + 256 + 256 * 128;
static_assert(WS_END <= 4 * U, "workspace map exceeds 256 MiB");
constexpr size_t OO_BQ = 0;
constexpr size_t OO_BKV = (size_t)T * 384 * 2;
constexpr size_t OO_YB = 0;
constexpr size_t OO_GA = U;
constexpr size_t OO_GB = U + U / 2;
constexpr size_t OO_MERGED = U;

constexpr int LDS_BYTES = 163840;

struct Params {
  const float *x_prompt, *x_sample, *c_prompt, *c_sample, *ada_w, *ada_b, *pre_g, *post_g, *w_in, *a_q_g, *a_k_g, *b_q_g, *b_q_up,
      *b_kv_g, *b_kv_up, *a_out, *b_out, *w_o;
  float* out;
  char* ws;
};

__device__ __forceinline__ int opaque_tid() { int t = threadIdx.x; asm volatile("" : "+v"(t)); return t; }
typedef float f32x2_t __attribute__((ext_vector_type(2)));
typedef __bf16 bf16x2_t __attribute__((ext_vector_type(2)));
__device__ __forceinline__ unsigned cvtpk(float lo, float hi) { f32x2_t v = {lo, hi}; bf16x2_t b = __builtin_convertvector(v, bf16x2_t); return __builtin_bit_cast(unsigned, b); }
__device__ __forceinline__ float bf2f(unsigned short v) { return __uint_as_float(((unsigned)v) << 16); }
__device__ __forceinline__ int crow(int r, int hi) { return (r & 3) + 8 * (r >> 2) + 4 * hi; }
__device__ __forceinline__ void st4(bf16_t* p, float a, float b, float c, float d) { u32x2 w; w.x = cvtpk(a, b); w.y = cvtpk(c, d); *(u32x2*)p = w; }
__device__ __forceinline__ float sigmoidf_(float v) { return 1.0f / (1.0f + __expf(-v)); }
__device__ __forceinline__ const float* xrow_ptr(const Params& p, int tok) { return tok < NP ? p.x_prompt + (size_t)tok * DM : p.x_sample + (size_t)(tok - NP) * DM; }
__device__ __forceinline__ int batch_of(int tok) { return tok < NP ? 0 : 1 + ((tok - NP) >> 12); }
__device__ __forceinline__ int pos_of(int tok) { return tok < NP ? tok : ((tok - NP) & 4095); }

__device__ __forceinline__ int win_src(int n) {
  if (n < 768) return n;
  if (n < 1152) return 1280 + (n - 768);
  if (n < 1408) return 1664 + (n - 1152);
  if (n < 1440) return 1920 + (n - 1408);
  if (n < 1536) return -1;
  if (n < 2048) return 768 + (n - 1536);
  if (n < 2560) return 1952 + (n - 2048);
  return 2464 + (n - 2560);
}
__device__ __forceinline__ void cvt_tile(const float* __restrict__ W, int ldn, int K, bf16_t* __restrict__ dst, bool remap,
                                         const float* __restrict__ gain, int item, float* tl  , int tid) {
  const int ktiles = K >> 6, n0 = (item / ktiles) * 64, k0 = (item % ktiles) * 64;
  __syncthreads();
  {
    const int n4 = (tid & 15) * 4, kr = tid >> 4;
    const int nd = n0 + n4;
    const int src = remap ? win_src(nd) : nd;
#pragma unroll
    for (int i = 0; i < 2; ++i) {
      const int k = kr + 32 * i;
      float4 v = make_float4(0.f, 0.f, 0.f, 0.f);
      if (src >= 0) v = *(const float4*)(W + (size_t)(k0 + k) * ldn + src);
      if (gain) { const float g = gain[k0 + k]; v.x *= g; v.y *= g; v.z *= g; v.w *= g; }
      float* r = tl + k * 65 + n4;
      r[0] = v.x; r[1] = v.y; r[2] = v.z; r[3] = v.w;
    }
  }
  __syncthreads();
  {
    const int n = tid >> 3, kc = tid & 7;
    const float* c = tl + (kc * 8) * 65 + n;
    u32x4 o; o.x = cvtpk(c[0], c[65]); o.y = cvtpk(c[130], c[195]); o.z = cvtpk(c[260], c[325]); o.w = cvtpk(c[390], c[455]);
    *(u32x4*)(dst + (size_t)(n0 + n) * K + k0 + kc * 8) = o;
  }
}

__device__ __forceinline__ void phase0(const Params& p, char* lds) {
  const int tid = opaque_tid(), gsz = gridDim.x * 512, gtid = blockIdx.x * 512 + tid;
  if (gtid == 0) {
    float* bnd = (float*)(p.ws + OFF_BND);
    float gq = 0.f, gk = 0.f;
    for (int i = 0; i < 64; ++i) { gq = fmaxf(gq, fabsf(p.a_q_g[i])); gk = fmaxf(gk, fabsf(p.a_k_g[i])); }
    bnd[0] = 64.0f * gq * gk * PS_A;
    bnd[1] = 0.f; bnd[2] = 0.f; bnd[3] = 0.f;
    __hip_atomic_store((unsigned*)(p.ws + OFF_BAR), 0u, __ATOMIC_RELAXED, __HIP_MEMORY_SCOPE_AGENT);
  }
  float2* tabA = (float2*)(p.ws + OFF_TABA);
  float2* tabB = (float2*)(p.ws + OFF_TABB);
  for (int i = gtid; i < 256 * 16 + 256 * 8; i += gsz) {
    int pos, f; float inv;
    const float L2T = 13.287712379549449f;
    if (i < 4096) { pos = i >> 4; f = i & 15; inv = exp2f(-(float)f * (1.0f / 16.0f) * L2T); }
    else { int k = i - 4096; pos = k >> 3; f = k & 7; inv = exp2f(-(float)f * (1.0f / 8.0f) * L2T); }
    float ang = (float)pos * inv;
    float rev = ang * 0.15915494309189535f; rev -= floorf(rev);
    float2 cs; cs.x = __builtin_amdgcn_cosf(rev); cs.y = __builtin_amdgcn_sinf(rev);
    if (i < 4096) tabA[i] = cs; else tabB[i - 4096] = cs;
  }
  {
    float* tl = (float*)(lds + 16384);
    for (int it = blockIdx.x; it < 1800; it += gridDim.x) {
      if (it < 1152) cvt_tile(p.w_in, 4512, 1024, (bf16_t*)(p.ws + OFF_WIN), true, nullptr, it, tl, tid);
      else if (it < 1224) cvt_tile(p.b_q_up, 768, 384, (bf16_t*)(p.ws + OFF_WQUP), false, p.b_q_g, it - 1152, tl, tid);
      else if (it < 1288) cvt_tile(p.b_kv_up, 1024, 256, (bf16_t*)(p.ws + OFF_WKVUP), false, p.b_kv_g, it - 1224, tl, tid);
      else if (it < 1416) cvt_tile(p.a_out, 1024, 512, (bf16_t*)(p.ws + OFF_WAOUT), false, nullptr, it - 1288, tl, tid);
      else if (it < 1544) cvt_tile(p.b_out, 1024, 512, (bf16_t*)(p.ws + OFF_WBOUT), false, nullptr, it - 1416, tl, tid);
      else cvt_tile(p.w_o, 1024, 1024, (bf16_t*)(p.ws + OFF_WO), false, nullptr, it - 1544, tl, tid);
    }
  }
  float* red = (float*)lds;
  float* sl = (float*)(lds + 16384);
  float* mod = (float*)(p.ws + OFF_MOD);
  __syncthreads();
  for (int i = tid; i < 5 * 1024; i += 512) { const float cv = i < 1024 ? p.c_prompt[i] : p.c_sample[i - 1024]; sl[i] = cv * sigmoidf_(cv); }
  __syncthreads();
  for (int it = blockIdx.x; it < 256; it += gridDim.x) {
    const int c = tid & 15, kg = tid >> 4;
    float a0 = 0.f, a1 = 0.f, a2 = 0.f, a3 = 0.f, a4 = 0.f;
    if (c < 12) {
      const float* wp = p.ada_w + it * 12 + c;
#pragma unroll 8
      for (int k = kg; k < 1024; k += 32) {
        const float w = wp[(size_t)k * 3072];
        a0 += sl[k] * w; a1 += sl[1024 + k] * w; a2 += sl[2048 + k] * w; a3 += sl[3072 + k] * w; a4 += sl[4096 + k] * w;
      }
    }
    float* rp = red + (kg * 16 + c) * 5;
    rp[0] = a0; rp[1] = a1; rp[2] = a2; rp[3] = a3; rp[4] = a4;
    __syncthreads();
    if (tid < 60) {
      const int cc = tid / 5, b = tid % 5;
      float s = 0.f;
      for (int g = 0; g < 32; ++g) s += red[(g * 16 + cc) * 5 + b];
      const int col = it * 12 + cc;
      mod[b * 3072 + col] = s + p.ada_b[col];
    }
    __syncthreads();
  }
}

__device__ __forceinline__ float wave_sum(float v) {
#pragma unroll
  for (int o = 32; o >= 1; o >>= 1) v += __shfl_xor(v, o);
  return v;
}
__device__ __forceinline__ void phase1(const Params& p) {
  const int tid = opaque_tid(), wid = tid >> 6, lane = tid & 63;
  const float* mod = (const float*)(p.ws + OFF_MOD);
  bf16_t* H = (bf16_t*)(p.ws + OFF_H);
  const int NW = gridDim.x * 8;
  for (int row0 = blockIdx.x * 8 + wid; row0 < T; row0 += 4 * NW) {
    float4 v[4][4];
#pragma unroll
    for (int j = 0; j < 4; ++j) {
      const int row = row0 + j * NW;
      if (row < T) {
        const float* xr = xrow_ptr(p, row);
#pragma unroll
        for (int i = 0; i < 4; ++i) v[j][i] = *(const float4*)(xr + i * 256 + lane * 4);
      }
    }
#pragma unroll
    for (int j = 0; j < 4; ++j) {
      const int row = row0 + j * NW;
      if (row < T) {
        const int b = batch_of(row);
        float ss = 0.f;
#pragma unroll
        for (int i = 0; i < 4; ++i) ss += v[j][i].x * v[j][i].x + v[j][i].y * v[j][i].y + v[j][i].z * v[j][i].z + v[j][i].w * v[j][i].w;
        ss = wave_sum(ss);
        const float rn = rsqrtf(ss * (1.0f / 1024.0f) + EPS);
#pragma unroll
        for (int i = 0; i < 4; ++i) {
          const int col = i * 256 + lane * 4;
          const float4 g = *(const float4*)(p.pre_g + col);
          const float4 sh = *(const float4*)(mod + b * 3072 + col);
          const float4 sc = *(const float4*)(mod + b * 3072 + 1024 + col);
          st4(H + (size_t)row * DM + col, v[j][i].x * rn * g.x * (1.f + sc.x) + sh.x, v[j][i].y * rn * g.y * (1.f + sc.y) + sh.y,
              v[j][i].z * rn * g.z * (1.f + sc.z) + sh.z, v[j][i].w * rn * g.w * (1.f + sc.w) + sh.w);
        }
      }
    }
  }
}

constexpr int G_XB = 256 * 128, G_WB = 128 * 128, G_STAGE = G_XB + G_WB;
__device__ __forceinline__ int gswz(int row, int c) { return row * 128 + ((c ^ ((row >> 1) & 7)) << 4); }

__device__ __forceinline__ void gemm_kloop(const bf16_t* __restrict__ X, int ldx, const bf16_t* __restrict__ W, int ldw, int nk,
                                           f32x16 (&acc)[2][2], char* lds) {
  const int tid = opaque_tid(), wid = __builtin_amdgcn_readfirstlane(tid >> 6), lane = tid & 63, r32 = lane & 31, hi = lane >> 5, wm = wid & 3, wn = wid >> 2;
  const int srow = tid >> 3, sch = tid & 7;
  const char* xg = (const char*)X;
  const char* wg = (const char*)W;
  const unsigned xstep = (unsigned)ldx * 128u, wstep = (unsigned)ldw * 128u;
  const unsigned xo0 = (unsigned)(srow * ldx + sch * 8) * 2u, wo0 = (unsigned)(srow * ldw + sch * 8) * 2u;
  const int sw = gswz(srow, sch);
  u32x4 xa[4], wa[2], xb[4], wb[2];
  const int fsw = (r32 >> 1) & 7;
  int koff[4];
#pragma unroll
  for (int ks = 0; ks < 4; ++ks) koff[ks] = ((2 * ks + hi) ^ fsw) << 4;
  const int rowA = G_XB + (wn * 64 + r32) * 128, rowB = (wm * 64 + r32) * 128;
#define GLOAD(xr, wr, kt) do { _Pragma("unroll") for (int i = 0; i < 4; ++i) xr[i] = *(const u32x4*)(xg + (xo0 + i * xstep + (unsigned)(kt) * 128u)); \
    _Pragma("unroll") for (int i = 0; i < 2; ++i) wr[i] = *(const u32x4*)(wg + (wo0 + i * wstep + (unsigned)(kt) * 128u)); } while (0)
#define GWRITE(s, xr, wr) do { char* b_ = lds + (s) * G_STAGE; _Pragma("unroll") for (int i = 0; i < 4; ++i) *(u32x4*)(b_ + sw + i * 8192) = xr[i]; \
    _Pragma("unroll") for (int i = 0; i < 2; ++i) *(u32x4*)(b_ + G_XB + sw + i * 8192) = wr[i]; } while (0)
#define GCOMPUTE(s) do { const char* sb = lds + (s) * G_STAGE; _Pragma("unroll") for (int ks = 0; ks < 4; ++ks) { \
      const bf16x8 a0 = *(const bf16x8*)(sb + rowA + koff[ks]); const bf16x8 a1 = *(const bf16x8*)(sb + rowA + 4096 + koff[ks]); \
      const bf16x8 b0 = *(const bf16x8*)(sb + rowB + koff[ks]); const bf16x8 b1 = *(const bf16x8*)(sb + rowB + 4096 + koff[ks]); \
      acc[0][0] = __builtin_amdgcn_mfma_f32_32x32x16_bf16(a0, b0, acc[0][0], 0, 0, 0); acc[0][1] = __builtin_amdgcn_mfma_f32_32x32x16_bf16(a0, b1, acc[0][1], 0, 0, 0); \
      acc[1][0] = __builtin_amdgcn_mfma_f32_32x32x16_bf16(a1, b0, acc[1][0], 0, 0, 0); acc[1][1] = __builtin_amdgcn_mfma_f32_32x32x16_bf16(a1, b1, acc[1][1], 0, 0, 0); } } while (0)
  __syncthreads();
  GLOAD(xa, wa, 0); GLOAD(xb, wb, 1); GWRITE(0, xa, wa); __syncthreads();
#pragma nounroll
  for (int kt = 0; kt < nk; kt += 2) {
    const int ka = kt + 2 < nk ? kt + 2 : nk - 2, kb = kt + 3 < nk ? kt + 3 : nk - 1;
    GLOAD(xa, wa, ka);
    GCOMPUTE(0);
    GWRITE(1, xb, wb);
    __syncthreads();
    GLOAD(xb, wb, kb);
    GCOMPUTE(1);
    GWRITE(0, xa, wa);
    __syncthreads();
  }
  asm volatile("s_waitcnt vmcnt(0)" ::: "memory");
#undef GLOAD
#undef GWRITE
#undef GCOMPUTE
}
__device__ __forceinline__ void zero_acc(f32x16 (&acc)[2][2]) {
#pragma unroll
  for (int a = 0; a < 2; ++a)
#pragma unroll
    for (int b = 0; b < 2; ++b)
#pragma unroll
      for (int r = 0; r < 16; ++r) acc[a][b][r] = 0.f;
}

constexpr int G2_XB = 256 * 128, G2_STAGE = 2 * G2_XB;
__device__ __forceinline__ void gemm_kloop256(const bf16_t* __restrict__ X, int ldx, const bf16_t* __restrict__ W, int ldw, int nk,
                                              f32x16 (&acc)[2][4], char* lds) {
  const int tid = opaque_tid(), wid = __builtin_amdgcn_readfirstlane(tid >> 6), lane = tid & 63, r32 = lane & 31, hi = lane >> 5, wm = wid & 1, wn = wid >> 1;
  const int srow = tid >> 3, sch = tid & 7;
  const char* xg = (const char*)X; const char* wg = (const char*)W;
  const unsigned xstep = (unsigned)ldx * 128u, wstep = (unsigned)ldw * 128u;
  const unsigned xo0 = (unsigned)(srow * ldx + sch * 8) * 2u, wo0 = (unsigned)(srow * ldw + sch * 8) * 2u;
  const int sw = gswz(srow, sch);
  u32x4 xa[4], wa[4];
  const int fsw = (r32 >> 1) & 7;
  int koff[4];
#pragma unroll
  for (int ks = 0; ks < 4; ++ks) koff[ks] = ((2 * ks + hi) ^ fsw) << 4;
  const int rowA = G2_XB + (wn * 64 + r32) * 128, rowB = (wm * 128 + r32) * 128;
#define GLOAD(xr, wr, kt) do { _Pragma("unroll") for (int i = 0; i < 4; ++i) { xr[i] = *(const u32x4*)(xg + (xo0 + i * xstep + (unsigned)(kt) * 128u)); \
    wr[i] = *(const u32x4*)(wg + (wo0 + i * wstep + (unsigned)(kt) * 128u)); } } while (0)
#define GWRITE(s, xr, wr) do { char* b_ = lds + (s) * G2_STAGE; _Pragma("unroll") for (int i = 0; i < 4; ++i) { *(u32x4*)(b_ + sw + i * 8192) = xr[i]; \
    *(u32x4*)(b_ + G2_XB + sw + i * 8192) = wr[i]; } } while (0)
#define GCOMPUTE(s) do { const char* sb = lds + (s) * G2_STAGE; _Pragma("unroll") for (int ks = 0; ks < 4; ++ks) { \
      const bf16x8 a0 = *(const bf16x8*)(sb + rowA + koff[ks]); const bf16x8 a1 = *(const bf16x8*)(sb + rowA + 4096 + koff[ks]); \
      _Pragma("unroll") for (int ti = 0; ti < 4; ++ti) { const bf16x8 b = *(const bf16x8*)(sb + rowB + ti * 4096 + koff[ks]); \
        acc[0][ti] = __builtin_amdgcn_mfma_f32_32x32x16_bf16(a0, b, acc[0][ti], 0, 0, 0); acc[1][ti] = __builtin_amdgcn_mfma_f32_32x32x16_bf16(a1, b, acc[1][ti], 0, 0, 0); } } } while (0)
  __syncthreads();
  GLOAD(xa, wa, 0); GWRITE(0, xa, wa); __syncthreads();
#pragma nounroll
  for (int kt = 0; kt < nk; kt += 2) {
    const int ka = kt + 1, kb = kt + 2 < nk ? kt + 2 : nk - 1;
    GLOAD(xa, wa, ka);
    GCOMPUTE(0);
    GWRITE(1, xa, wa);
    __syncthreads();
    GLOAD(xa, wa, kb);
    GCOMPUTE(1);
    GWRITE(0, xa, wa);
    __syncthreads();
  }
  asm volatile("s_waitcnt vmcnt(0)" ::: "memory");
#undef GLOAD
#undef GWRITE
#undef GCOMPUTE
}
__device__ __forceinline__ void zero_acc4(f32x16 (&acc)[2][4]) {
#pragma unroll
  for (int a = 0; a < 2; ++a)
#pragma unroll
    for (int b = 0; b < 4; ++b)
#pragma unroll
      for (int r = 0; r < 16; ++r) acc[a][b][r] = 0.f;
}

__device__ __forceinline__ void stage_put(char* wb, int t, int q, float a, float b, float c, float d) {
  u32x2 w; w.x = cvtpk(a, b); w.y = cvtpk(c, d);
  *(u32x2*)(wb + t * 128 + ((q ^ ((t & 7) << 1)) << 3)) = w;
}
__device__ __forceinline__ void stage_flush(const char* wb, bf16_t* dst, int ld, int lane) {
#pragma unroll
  for (int i = 0; i < 8; ++i) {
    const int row = i * 8 + (lane >> 3), c = lane & 7;
    const u32x4 v = *(const u32x4*)(wb + row * 128 + ((c ^ (row & 7)) << 4));
    *(u32x4*)(dst + (size_t)row * ld + c * 8) = v;
  }
}
__device__ __forceinline__ void stage_flush128(const char* wb, bf16_t* dst, int ld, int lane) {
#pragma unroll
  for (int i = 0; i < 16; ++i) {
    const int row = i * 8 + (lane >> 3), c = lane & 7;
    const u32x4 v = *(const u32x4*)(wb + row * 128 + ((c ^ (row & 7)) << 4));
    *(u32x4*)(dst + (size_t)row * ld + c * 8) = v;
  }
}
__device__ __forceinline__ void stage_flush_add(const char* wb, bf16_t* dst, int ld, int lane) {
#pragma unroll
  for (int i = 0; i < 8; ++i) {
    const int row = i * 8 + (lane >> 3), c = lane & 7;
    const u32x4 v = *(const u32x4*)(wb + row * 128 + ((c ^ (row & 7)) << 4));
    u32x4* gp = (u32x4*)(dst + (size_t)row * ld + c * 8);
    const u32x4 o = *gp;
    u32x4 r;
    r.x = cvtpk(__uint_as_float(v.x << 16) + __uint_as_float(o.x << 16), __uint_as_float(v.x & 0xffff0000u) + __uint_as_float(o.x & 0xffff0000u));
    r.y = cvtpk(__uint_as_float(v.y << 16) + __uint_as_float(o.y << 16), __uint_as_float(v.y & 0xffff0000u) + __uint_as_float(o.y & 0xffff0000u));
    r.z = cvtpk(__uint_as_float(v.z << 16) + __uint_as_float(o.z << 16), __uint_as_float(v.z & 0xffff0000u) + __uint_as_float(o.z & 0xffff0000u));
    r.w = cvtpk(__uint_as_float(v.w << 16) + __uint_as_float(o.w << 16), __uint_as_float(v.w & 0xffff0000u) + __uint_as_float(o.w & 0xffff0000u));
    *gp = r;
  }
}
__device__ __forceinline__ void epi_rope64(const f32x16& a0, const f32x16& a1, int t, const float* __restrict__ gain, float ps,
                                           const float2* __restrict__ tabA, char* wb, int tl, int hi) {
  float ss = 0.f;
#pragma unroll
  for (int r = 0; r < 16; ++r) ss += a0[r] * a0[r] + a1[r] * a1[r];
  ss += __shfl_xor(ss, 32);
  const float rn = rsqrtf(ss * (1.0f / 64.0f) + EPS);
  const int prow = t >> 6, pcol = t & 63;
#pragma unroll
  for (int g = 0; g < 4; ++g) {
    const int f0 = 8 * (g & 1) + 4 * hi, pos = g < 2 ? prow : pcol, d = 8 * g + 4 * hi;
    const float4* tp = (const float4*)(tabA + pos * 16 + f0);
    const float4 t01 = tp[0], t23 = tp[1];
    const float4 g1 = *(const float4*)(gain + d), g2 = *(const float4*)(gain + 32 + d);
    const float x10 = a0[4 * g + 0] * rn * g1.x, x11 = a0[4 * g + 1] * rn * g1.y, x12 = a0[4 * g + 2] * rn * g1.z, x13 = a0[4 * g + 3] * rn * g1.w;
    const float x20 = a1[4 * g + 0] * rn * g2.x, x21 = a1[4 * g + 1] * rn * g2.y, x22 = a1[4 * g + 2] * rn * g2.z, x23 = a1[4 * g + 3] * rn * g2.w;
    stage_put(wb, tl, 2 * g + hi, (x10 * t01.x - x20 * t01.y) * ps, (x11 * t01.z - x21 * t01.w) * ps, (x12 * t23.x - x22 * t23.y) * ps, (x13 * t23.z - x23 * t23.w) * ps);
    stage_put(wb, tl, 8 + 2 * g + hi, (x20 * t01.x + x10 * t01.y) * ps, (x21 * t01.z + x11 * t01.w) * ps, (x22 * t23.x + x12 * t23.y) * ps, (x23 * t23.z + x13 * t23.w) * ps);
  }
}
__device__ __forceinline__ void rope32_vals(const f32x16& a, float mul, int t, const float2* __restrict__ tabB, int hi, int g, float (&o1)[4], float (&o2)[4]) {
  const int pos = g == 0 ? (t >> 6) : (t & 63);
  const float4* tp = (const float4*)(tabB + pos * 8 + 4 * hi);
  const float4 t01 = tp[0], t23 = tp[1];
  const float x10 = a[4 * g + 0] * mul, x11 = a[4 * g + 1] * mul, x12 = a[4 * g + 2] * mul, x13 = a[4 * g + 3] * mul;
  const float x20 = a[8 + 4 * g + 0] * mul, x21 = a[8 + 4 * g + 1] * mul, x22 = a[8 + 4 * g + 2] * mul, x23 = a[8 + 4 * g + 3] * mul;
  o1[0] = x10 * t01.x - x20 * t01.y; o1[1] = x11 * t01.z - x21 * t01.w; o1[2] = x12 * t23.x - x22 * t23.y; o1[3] = x13 * t23.z - x23 * t23.w;
  o2[0] = x20 * t01.x + x10 * t01.y; o2[1] = x21 * t01.z + x11 * t01.w; o2[2] = x22 * t23.x + x12 * t23.y; o2[3] = x23 * t23.z + x13 * t23.w;
}
__device__ __forceinline__ void epi_rope32(const f32x16& a, float mul, int t, const float2* __restrict__ tabB, char* wb, int tl, int qb, int hi) {
#pragma unroll
  for (int g = 0; g < 2; ++g) {
    float o1[4], o2[4];
    rope32_vals(a, mul, t, tabB, hi, g, o1, o2);
    stage_put(wb, tl, qb + 2 * g + hi, o1[0], o1[1], o1[2], o1[3]);
    stage_put(wb, tl, qb + 4 + 2 * g + hi, o2[0], o2[1], o2[2], o2[3]);
  }
}
__device__ __forceinline__ void epi_rope32_direct(const f32x16& a, float mul, int t, const float2* __restrict__ tabB, bf16_t* dst, int hi) {
#pragma unroll
  for (int g = 0; g < 2; ++g) {
    float o1[4], o2[4];
    rope32_vals(a, mul, t, tabB, hi, g, o1, o2);
    st4(dst + 8 * g + 4 * hi, o1[0], o1[1], o1[2], o1[3]);
    st4(dst + 16 + 8 * g + 4 * hi, o2[0], o2[1], o2[2], o2[3]);
  }
}
__device__ __forceinline__ void epi_plain32(const f32x16& a, float mul, char* wb, int tl, int qb, int hi) {
#pragma unroll
  for (int g = 0; g < 4; ++g) stage_put(wb, tl, qb + 2 * g + hi, a[4 * g] * mul, a[4 * g + 1] * mul, a[4 * g + 2] * mul, a[4 * g + 3] * mul);
}
__device__ __forceinline__ void epi_silu32(const f32x16& a, char* wb, int tl, int qb, int hi) {
#pragma unroll
  for (int g = 0; g < 4; ++g)
    stage_put(wb, tl, qb + 2 * g + hi, a[4 * g] * sigmoidf_(a[4 * g]), a[4 * g + 1] * sigmoidf_(a[4 * g + 1]), a[4 * g + 2] * sigmoidf_(a[4 * g + 2]),
              a[4 * g + 3] * sigmoidf_(a[4 * g + 3]));
}
__device__ __forceinline__ float sumsq16(const f32x16& a) {
  float s = 0.f;
#pragma unroll
  for (int r = 0; r < 16; ++r) s += a[r] * a[r];
  return s;
}

struct TileIter {
  int q, step, end, NT, mbase; bool xcd;
  __device__ __forceinline__ TileIter(int nt_count) {
    NT = nt_count; xcd = (gridDim.x == 256);
    if (xcd) { q = blockIdx.x >> 3; step = 32; end = 16 * NT; mbase = (blockIdx.x & 7) * 16; }
    else { q = blockIdx.x; step = gridDim.x; end = 128 * NT; mbase = 0; }
  }
  __device__ __forceinline__ bool next(int& mt, int& nt) { if (q >= end) return false; mt = mbase + q / NT; nt = q % NT; q += step; return true; }
};

__device__ __forceinline__ void bound_max(float* dst, float v) {
#pragma unroll
  for (int o = 32; o >= 1; o >>= 1) v = fmaxf(v, __shfl_xor(v, o));
  if ((threadIdx.x & 63) == 0) atomicMax((unsigned*)dst, __float_as_uint(v));
}
__device__ __forceinline__ void phase_g1(const Params& p, char* lds) {
  const int tid = opaque_tid(), wid = __builtin_amdgcn_readfirstlane(tid >> 6), lane = tid & 63, r32 = lane & 31, hi = lane >> 5, wm = wid & 1, wn4 = wid >> 1;
  const int wn = wn4 & 1;
  const bf16_t* H = (const bf16_t*)(p.ws + OFF_H);
  const bf16_t* WIN = (const bf16_t*)(p.ws + OFF_WIN);
  const float2* tabA = (const float2*)(p.ws + OFF_TABA);
  const float2* tabB = (const float2*)(p.ws + OFF_TABB);
  float* part = (float*)(p.ws + OFF_PART);
  char* dout = (char*)p.out;
  float bmax_kr = 0.f;
  TileIter it(10); int mt, nt2;
  while (it.next(mt, nt2)) {
    const int m0 = mt * 256;
    f32x16 acc[2][4];
    zero_acc4(acc);
    gemm_kloop256(H + (size_t)m0 * DM, DM, WIN + (size_t)nt2 * 256 * DM, DM, 16, acc, lds);
    const int nt = nt2 * 2 + (wn4 >> 1);
    char* wb = lds + wid * 16384;
    const int tok0 = m0 + wm * 128;
#pragma unroll
    for (int ti = 0; ti < 4; ++ti) {
      const int tl = ti * 32 + r32, tok = tok0 + tl;
      const int t = pos_of(tok);
      if (nt < 4) {
        epi_rope64(acc[0][ti], acc[1][ti], t, p.a_q_g, PS_A, tabA, wb, tl, hi);
      } else if (nt == 4) {
        epi_rope64(acc[0][ti], acc[1][ti], t, p.a_k_g, 1.0f, tabA, wb, tl, hi);
      } else if (nt == 5) {
        epi_plain32(acc[0][ti], 1.0f, wb, tl, 0, hi); epi_plain32(acc[1][ti], 1.0f, wb, tl, 8, hi);
      } else if (nt < 9) {
        epi_plain32(acc[0][ti], 1.0f, wb, tl, 0, hi); epi_plain32(acc[1][ti], 1.0f, wb, tl, 8, hi);
        float s = sumsq16(acc[0][ti]) + sumsq16(acc[1][ti]); s += __shfl_xor(s, 32);
        if (hi == 0) part[((nt - 6) * 2 + wn) * T + tok] = s;
      } else if (nt < 11) {
        epi_plain32(acc[0][ti], 1.0f, wb, tl, 0, hi); epi_plain32(acc[1][ti], 1.0f, wb, tl, 8, hi);
        float s = sumsq16(acc[0][ti]) + sumsq16(acc[1][ti]); s += __shfl_xor(s, 32);
        if (hi == 0) part[(6 + (nt - 9) * 2 + wn) * T + tok] = s;
      } else if (nt == 11) {
        if (wn == 0) {
          epi_rope32_direct(acc[0][ti], 1.0f, t, tabB, (bf16_t*)(p.ws + OFF_KR) + (size_t)tok * 32, hi);
          float s = sumsq16(acc[0][ti]); s += __shfl_xor(s, 32);
          bmax_kr = fmaxf(bmax_kr, s);
        }
      } else {
        epi_silu32(acc[0][ti], wb, tl, 0, hi); epi_silu32(acc[1][ti], wb, tl, 8, hi);
      }
    }
    if (nt != 11) {
      bf16_t* dst; int ld;
      if (nt < 4) { dst = (bf16_t*)(p.ws + OFF_QA) + (size_t)tok0 * 512 + (nt * 2 + wn) * 64; ld = 512; }
      else if (nt == 4) { dst = (bf16_t*)(p.ws + OFF_KA) + (size_t)tok0 * 128 + wn * 64; ld = 128; }
      else if (nt == 5) { dst = (bf16_t*)(p.ws + OFF_VA) + (size_t)tok0 * 128 + wn * 64; ld = 128; }
      else if (nt < 9) { dst = (bf16_t*)(dout + OO_BQ) + (size_t)tok0 * 384 + (nt - 6) * 128 + wn * 64; ld = 384; }
      else if (nt < 11) { dst = (bf16_t*)(dout + OO_BKV) + (size_t)tok0 * 256 + (nt - 9) * 128 + wn * 64; ld = 256; }
      else if (nt < 16) { dst = (bf16_t*)(dout + OO_GA) + (size_t)tok0 * 512 + (nt - 12) * 128 + wn * 64; ld = 512; }
      else { dst = (bf16_t*)(dout + OO_GB) + (size_t)tok0 * 512 + (nt - 16) * 128 + wn * 64; ld = 512; }
      stage_flush128(wb, dst, ld, lane);
    }
  }
  bound_max((float*)(p.ws + OFF_BND) + 3, bmax_kr);
}

__device__ __forceinline__ void phase_g2(const Params& p, char* lds) {
  const int tid = opaque_tid(), wid = __builtin_amdgcn_readfirstlane(tid >> 6), lane = tid & 63, r32 = lane & 31, hi = lane >> 5, wm = wid & 3, wn = wid >> 2;
  const float2* tabB = (const float2*)(p.ws + OFF_TABB);
  const float* part = (const float*)(p.ws + OFF_PART);
  char* dout = (char*)p.out;
  float bmax_q = 0.f, bmax_k = 0.f;
  TileIter it(14); int mt, j;
  while (it.next(mt, j)) {
    const int m0 = mt * 256;
    f32x16 acc[2][2];
    zero_acc(acc);
    char* wb = lds + wid * 8192;
    const int tok0 = m0 + wm * 64;
    if (j < 6) {
      gemm_kloop((const bf16_t*)(dout + OO_BQ) + (size_t)m0 * 384, 384, (const bf16_t*)(p.ws + OFF_WQUP) + (size_t)j * 128 * 384, 384, 6, acc, lds);
#pragma unroll
      for (int ti = 0; ti < 2; ++ti) {
        const int tl = ti * 32 + r32, tok = tok0 + tl;
        const int t = pos_of(tok);
        const float sq = (part[tok] + part[T + tok]) + (part[2 * T + tok] + part[3 * T + tok]) + (part[4 * T + tok] + part[5 * T + tok]);
        const float rn = rsqrtf(sq * (1.0f / 384.0f) + EPS) * PS_B;
#pragma unroll
        for (int fi = 0; fi < 2; ++fi) {
          const int blk = j * 4 + wn * 2 + fi;
          if (blk % 3 == 2) epi_rope32(acc[fi][ti], rn, t, tabB, wb, tl, fi * 8, hi);
          else epi_plain32(acc[fi][ti], rn, wb, tl, fi * 8, hi);
          float s = sumsq16(acc[fi][ti]); s += __shfl_xor(s, 32);
          bmax_q = fmaxf(bmax_q, s * rn * rn);
        }
      }
      stage_flush(wb, (bf16_t*)(p.ws + OFF_QB) + (size_t)tok0 * 768 + (j * 4 + wn * 2) * 32, 768, lane);
    } else {
      const int jn = j - 6;
      gemm_kloop((const bf16_t*)(dout + OO_BKV) + (size_t)m0 * 256, 256, (const bf16_t*)(p.ws + OFF_WKVUP) + (size_t)jn * 128 * 256, 256, 4, acc, lds);
#pragma unroll
      for (int ti = 0; ti < 2; ++ti) {
        const int tl = ti * 32 + r32, tok = tok0 + tl;
        const float sk = (part[6 * T + tok] + part[7 * T + tok]) + (part[8 * T + tok] + part[9 * T + tok]);
        const float rn = rsqrtf(sk * (1.0f / 256.0f) + EPS);
        epi_plain32(acc[0][ti], rn, wb, tl, 0, hi); epi_plain32(acc[1][ti], rn, wb, tl, 8, hi);
        if (wn == 0) {
          float s0 = sumsq16(acc[0][ti]), s1 = sumsq16(acc[1][ti]); s0 += __shfl_xor(s0, 32); s1 += __shfl_xor(s1, 32);
          bmax_k = fmaxf(bmax_k, fmaxf(s0, s1) * rn * rn);
        }
      }
      stage_flush(wb, (bf16_t*)(p.ws + (wn == 0 ? OFF_KBN : OFF_VB)) + (size_t)tok0 * 512 + jn * 64, 512, lane);
    }
  }
  bound_max((float*)(p.ws + OFF_BND) + 1, bmax_q);
  bound_max((float*)(p.ws + OFF_BND) + 2, bmax_k);
}

__device__ __forceinline__ void phase_g3(const Params& p, char* lds) {
  const int tid = opaque_tid(), wid = __builtin_amdgcn_readfirstlane(tid >> 6), lane = tid & 63, r32 = lane & 31, hi = lane >> 5, wm = wid & 3, wn = wid >> 2;
  char* dout = (char*)p.out;
  const bf16_t* H = (const bf16_t*)(p.ws + OFF_H);
  const bf16_t* WIN = (const bf16_t*)(p.ws + OFF_WIN);
  bf16_t* MG = (bf16_t*)(dout + OO_MERGED);
  TileIter it(8); int mt, nt;
  while (it.next(mt, nt)) {
    const int m0 = mt * 256;
#pragma nounroll
    for (int s = 0; s < 2; ++s) {
      f32x16 acc[2][2];
      zero_acc(acc);
      const bf16_t* Y = s == 0 ? (const bf16_t*)(p.ws + OFF_QA) : (const bf16_t*)(dout + OO_YB);
      const bf16_t* WOUT = (const bf16_t*)(p.ws + (s == 0 ? OFF_WAOUT : OFF_WBOUT));
      gemm_kloop(H + (size_t)m0 * DM, DM, WIN + (size_t)(2560 + s * 1024 + nt * 128) * DM, DM, 16, acc, lds);
      unsigned* gl = (unsigned*)(lds + 2 * G_STAGE) + tid;
#pragma unroll
      for (int fi = 0; fi < 2; ++fi)
#pragma unroll
        for (int ti = 0; ti < 2; ++ti)
#pragma unroll
          for (int q = 0; q < 8; ++q) gl[((fi * 2 + ti) * 8 + q) * 512] = cvtpk(sigmoidf_(acc[fi][ti][2 * q]), sigmoidf_(acc[fi][ti][2 * q + 1]));
      zero_acc(acc);
      gemm_kloop(Y + (size_t)m0 * 512, 512, WOUT + (size_t)nt * 128 * 512, 512, 8, acc, lds);
      char* wb = lds + wid * 8192;
#pragma unroll
      for (int ti = 0; ti < 2; ++ti) {
        const int tl = ti * 32 + r32;
#pragma unroll
        for (int fi = 0; fi < 2; ++fi) {
#pragma unroll
          for (int g = 0; g < 4; ++g) {
            const unsigned g01 = gl[((fi * 2 + ti) * 8 + 2 * g) * 512], g23 = gl[((fi * 2 + ti) * 8 + 2 * g + 1) * 512];
            stage_put(wb, tl, fi * 8 + 2 * g + hi, __uint_as_float(g01 << 16) * acc[fi][ti][4 * g], __uint_as_float(g01 & 0xffff0000u) * acc[fi][ti][4 * g + 1],
                      __uint_as_float(g23 << 16) * acc[fi][ti][4 * g + 2], __uint_as_float(g23 & 0xffff0000u) * acc[fi][ti][4 * g + 3]);
          }
        }
      }
      bf16_t* dst = MG + (size_t)(m0 + wm * 64) * DM + nt * 128 + wn * 64;
      if (s == 0) stage_flush(wb, dst, DM, lane); else stage_flush_add(wb, dst, DM, lane);
    }
  }
}

__device__ __forceinline__ void phase_g4(const Params& p, char* lds) {
  const int tid = opaque_tid(), wid = __builtin_amdgcn_readfirstlane(tid >> 6), lane = tid & 63, r32 = lane & 31, hi = lane >> 5, wm = wid & 1, wn4 = wid >> 1;
  char* dout = (char*)p.out;
  const bf16_t* MG = (const bf16_t*)(dout + OO_MERGED);
  bf16_t* Z = (bf16_t*)(p.ws + OFF_H);
  float* part = (float*)(p.ws + OFF_PART) + 10 * T;
  TileIter it(4); int mt, nt;
  while (it.next(mt, nt)) {
    const int m0 = mt * 256;
    f32x16 acc[2][4];
    zero_acc4(acc);
    gemm_kloop256(MG + (size_t)m0 * DM, DM, (const bf16_t*)(p.ws + OFF_WO) + (size_t)nt * 256 * DM, DM, 16, acc, lds);
    char* wb = lds + wid * 16384;
    const int tok0 = m0 + wm * 128;
#pragma unroll
    for (int ti = 0; ti < 4; ++ti) {
      const int tl = ti * 32 + r32, tok = tok0 + tl;
      epi_plain32(acc[0][ti], 1.0f, wb, tl, 0, hi); epi_plain32(acc[1][ti], 1.0f, wb, tl, 8, hi);
      float s = sumsq16(acc[0][ti]) + sumsq16(acc[1][ti]); s += __shfl_xor(s, 32);
      if (hi == 0) part[(nt * 4 + wn4) * T + tok] = s;
    }
    stage_flush128(wb, Z + (size_t)tok0 * DM + nt * 256 + wn4 * 64, DM, lane);
  }
}

__device__ __forceinline__ void phase5(const Params& p) {
  const int tid = opaque_tid(), wid = tid >> 6, lane = tid & 63;
  const float* mod = (const float*)(p.ws + OFF_MOD);
  const bf16_t* Z = (const bf16_t*)(p.ws + OFF_H);
  const float* part = (const float*)(p.ws + OFF_PART) + 10 * T;
  const int NW = gridDim.x * 8;
  for (int row0 = blockIdx.x * 8 + wid; row0 < T; row0 += 2 * NW) {
    float4 xv[2][4]; u32x2 zz[2][4]; float pz[2];
#pragma unroll
    for (int j = 0; j < 2; ++j) {
      const int row = row0 + j * NW;
      if (row < T) {
        const float* xr = xrow_ptr(p, row);
        pz[j] = lane < 16 ? part[lane * T + row] : 0.f;
#pragma unroll
        for (int i = 0; i < 4; ++i) { xv[j][i] = *(const float4*)(xr + i * 256 + lane * 4); zz[j][i] = *(const u32x2*)(Z + (size_t)row * DM + i * 256 + lane * 4); }
      }
    }
#pragma unroll
    for (int j = 0; j < 2; ++j) {
      const int row = row0 + j * NW;
      if (row < T) {
        const int b = batch_of(row);
        const float rn = rsqrtf(wave_sum(pz[j]) * (1.0f / 1024.0f) + EPS);
        float* o = p.out + (size_t)row * DM;
#pragma unroll
        for (int i = 0; i < 4; ++i) {
          const int col = i * 256 + lane * 4;
          const float4 g = *(const float4*)(p.post_g + col);
          const float4 gt = *(const float4*)(mod + b * 3072 + 2048 + col);
          float4 r;
          r.x = xv[j][i].x + gt.x * (__uint_as_float(zz[j][i].x << 16) * rn * g.x);
          r.y = xv[j][i].y + gt.y * (__uint_as_float(zz[j][i].x & 0xffff0000u) * rn * g.y);
          r.z = xv[j][i].z + gt.z * (__uint_as_float(zz[j][i].y << 16) * rn * g.z);
          r.w = xv[j][i].w + gt.w * (__uint_as_float(zz[j][i].y & 0xffff0000u) * rn * g.w);
          *(float4*)(o + col) = r;
        }
      }
    }
  }
}

#define SBAR() __builtin_amdgcn_sched_barrier(0)
constexpr float ATT_THR = 8.0f;
constexpr int SHM_V = 64 * 64 * 2;
template <int DK> struct KL { static constexpr int RB = DK == 64 ? 128 : 256; static constexpr int SHM_K = 64 * RB; };
template <int DK> __device__ __forceinline__ int kswz(int row, int c) {
  if (DK == 64) return row * 128 + ((c ^ ((row >> 1) & 7)) << 4);
  return row * 256 + ((c ^ (row & 15)) << 4);
}
__device__ __forceinline__ int v_st(int k, int c) {
  const int kk = (k & ~0xC) | ((k & 4) << 1) | ((k & 8) >> 1);
  return ((kk >> 3) * 2 + (c >> 5)) * 512 + ((kk & 7) * 32 + (c & 31)) * 2;
}
__device__ __forceinline__ int v_rd_base(int lane) { return ((lane & 3) << 3) | (((lane >> 2) & 3) << 6) | (((lane >> 4) & 1) << 5) | (((lane >> 5) & 1) << 8); }
constexpr int v_rd_off(int d0, int ks, int half) { return d0 * 512 + ks * 2048 + half * 1024; }
typedef __attribute__((address_space(3))) const char* lds_cptr;
typedef short v4i16_t __attribute__((ext_vector_type(4)));
__device__ __forceinline__ s16x4 vtr(lds_cptr p) { return __builtin_bit_cast(s16x4, __builtin_amdgcn_ds_read_tr16_b64_v4i16((__attribute__((address_space(3))) v4i16_t*)p)); }
template <int D0> __device__ __forceinline__ void pv_one(f32x16& od, lds_cptr vb, bf16x8 pa0, bf16x8 pa1, bf16x8 pa2, bf16x8 pa3) {
  const s16x4 l0 = vtr(vb + v_rd_off(D0, 0, 0)), h0 = vtr(vb + v_rd_off(D0, 0, 1)), l1 = vtr(vb + v_rd_off(D0, 1, 0)), h1 = vtr(vb + v_rd_off(D0, 1, 1));
  const s16x4 l2 = vtr(vb + v_rd_off(D0, 2, 0)), h2 = vtr(vb + v_rd_off(D0, 2, 1)), l3 = vtr(vb + v_rd_off(D0, 3, 0)), h3 = vtr(vb + v_rd_off(D0, 3, 1));
#define PK(L, Hh) (bf16x8){L[0], L[1], L[2], L[3], Hh[0], Hh[1], Hh[2], Hh[3]}
  od = __builtin_amdgcn_mfma_f32_32x32x16_bf16(pa0, PK(l0, h0), od, 0, 0, 0);
  od = __builtin_amdgcn_mfma_f32_32x32x16_bf16(pa1, PK(l1, h1), od, 0, 0, 0);
  od = __builtin_amdgcn_mfma_f32_32x32x16_bf16(pa2, PK(l2, h2), od, 0, 0, 0);
  od = __builtin_amdgcn_mfma_f32_32x32x16_bf16(pa3, PK(l3, h3), od, 0, 0, 0);
#undef PK
}
__device__ __forceinline__ void pv_all(f32x16* o, lds_cptr vb, bf16x8 pa0, bf16x8 pa1, bf16x8 pa2, bf16x8 pa3) {
  pv_one<0>(o[0], vb, pa0, pa1, pa2, pa3); pv_one<1>(o[1], vb, pa0, pa1, pa2, pa3);
}
__device__ __forceinline__ void partialSM(f32x16& p0, f32x16& p1, float& m_reg, float& alpha) {
  float pmax = p0[0];
#pragma unroll
  for (int r = 1; r < 16; ++r) pmax = fmaxf(pmax, p0[r]);
#pragma unroll
  for (int r = 0; r < 16; ++r) pmax = fmaxf(pmax, p1[r]);
  { auto rr = __builtin_amdgcn_permlane32_swap(__float_as_uint(pmax), __float_as_uint(pmax), false, false);
    pmax = fmaxf(__uint_as_float(rr[0]), __uint_as_float(rr[1])); }
  float mn;
  if (__builtin_expect(__all(pmax - m_reg <= ATT_THR), 1)) { mn = m_reg; alpha = 1.f; }
  else { mn = fmaxf(m_reg, pmax); alpha = __builtin_amdgcn_exp2f(m_reg - mn); m_reg = mn; }
#pragma unroll
  for (int r = 0; r < 16; ++r) p0[r] -= mn;
#pragma unroll
  for (int r = 0; r < 16; ++r) p1[r] -= mn;
#pragma unroll
  for (int r = 0; r < 16; ++r) p0[r] = __builtin_amdgcn_exp2f(p0[r]);
}
__device__ __forceinline__ void finishSM(f32x16& p0, f32x16& p1, float alpha, float& l_reg, bf16x8& pa0, bf16x8& pa1, bf16x8& pa2, bf16x8& pa3) {
#pragma unroll
  for (int r = 0; r < 16; ++r) p1[r] = __builtin_amdgcn_exp2f(p1[r]);
  float ps = 0.f;
#pragma unroll
  for (int r = 0; r < 16; ++r) ps += p0[r];
#pragma unroll
  for (int r = 0; r < 16; ++r) ps += p1[r];
  { auto rr = __builtin_amdgcn_permlane32_swap(__float_as_uint(ps), __float_as_uint(ps), false, false);
    ps = __uint_as_float(rr[0]) + __uint_as_float(rr[1]); }
  l_reg = l_reg * alpha + ps;
#define PK4(P, BASE, OUT) do { unsigned a0 = cvtpk(P[BASE + 0], P[BASE + 1]), a1 = cvtpk(P[BASE + 2], P[BASE + 3]);   \
    unsigned b0 = cvtpk(P[BASE + 4], P[BASE + 5]), b1 = cvtpk(P[BASE + 6], P[BASE + 7]);                              \
    auto r0 = __builtin_amdgcn_permlane32_swap(a0, b0, false, false); auto r1 = __builtin_amdgcn_permlane32_swap(a1, b1, false, false); \
    u32x4 w = {r0[0], r1[0], r0[1], r1[1]}; OUT = *reinterpret_cast<bf16x8*>(&w); } while (0)
  PK4(p0, 0, pa0); PK4(p0, 8, pa1); PK4(p1, 0, pa2); PK4(p1, 8, pa3);
#undef PK4
}
template <int DK> __device__ __forceinline__ void qkt(f32x16& p0, f32x16& p1, const char* Ks, const bf16x8* qr, int r32, int hi) {
#pragma unroll
  for (int r = 0; r < 16; ++r) { p0[r] = 0.f; p1[r] = 0.f; }
#pragma unroll
  for (int d0 = 0; d0 < DK / 16; ++d0) {
    const int off = kswz<DK>(r32, 2 * d0 + hi);
    const bf16x8 b0 = *reinterpret_cast<const bf16x8*>(Ks + off);
    const bf16x8 b1 = *reinterpret_cast<const bf16x8*>(Ks + off + 32 * KL<DK>::RB);
    p0 = __builtin_amdgcn_mfma_f32_32x32x16_bf16(b0, qr[d0], p0, 0, 0, 0);
    p1 = __builtin_amdgcn_mfma_f32_32x32x16_bf16(b1, qr[d0], p1, 0, 0, 0);
    if (QKT_SB && (d0 & 1) == 1 && d0 + 1 < DK / 16) SBAR();
  }
}

template <int DK>
__device__ __forceinline__ void attn_unit(const bf16_t* Qb, int ldq, const bf16_t* __restrict__ Kh, int ldk, const bf16_t* __restrict__ Krp,
                                          const bf16_t* __restrict__ Vh, int ldv, const bf16_t* Gb, bf16_t* Ob, int seq, char* lds) {
  constexpr int SHM_K = KL<DK>::SHM_K;
  const int tid = opaque_tid(), wid = __builtin_amdgcn_readfirstlane(tid >> 6), lane = tid & 63, r32 = lane & 31, hi = lane >> 5;
  char* V_lds = lds; char* K_lds = lds + 2 * SHM_V;
  float* ws = (float*)(lds + 2 * SHM_V + 2 * SHM_K) + wid * 64; float* li_l = ws; float* al_l = ws + 32;
  float m_reg = -1e30f, l_reg = 0.f; f32x16 o[2]; bf16x8 qr[DK / 16];
#pragma unroll
  for (int r = 0; r < 16; ++r) { o[0][r] = 0.f; o[1][r] = 0.f; }
  const bf16_t* Qw = Qb + (size_t)(wid * 32 + r32) * ldq + hi * 8;
#pragma unroll
  for (int d0 = 0; d0 < DK / 16; ++d0) qr[d0] = *reinterpret_cast<const bf16x8*>(Qw + d0 * 16);
  const int srow = tid >> 3, sc = tid & 7, vst = v_st(srow, sc * 8), kst = kswz<DK>(srow, sc);
  const int rrow = tid >> 2, rc = tid & 3, krst = kswz<DK>(rrow & 63, 8 + rc);
  const bool dor = (DK == 96) && (wid < 4);
  const lds_cptr vb0 = (lds_cptr)V_lds + v_rd_base(lane);
  struct { u32x4 v, k, r; } sr_[1];
  const unsigned voff0 = (unsigned)(srow * ldv + sc * 8) * 2u, koff0 = (unsigned)(srow * ldk + sc * 8) * 2u, roff0 = (unsigned)(rrow * 32 + rc * 8) * 2u;
#define SLOAD(i, k0) do { sr_[i].v = *(const u32x4*)((const char*)Vh + (voff0 + (unsigned)((k0) * ldv) * 2u)); sr_[i].k = *(const u32x4*)((const char*)Kh + (koff0 + (unsigned)((k0) * ldk) * 2u)); \
    if (dor) sr_[i].r = *(const u32x4*)((const char*)Krp + (roff0 + (unsigned)((k0) * 64))); } while (0)
#define SWRITE(b, i) do { *(u32x4*)(V_lds + (b) * SHM_V + vst) = sr_[i].v; *(u32x4*)(K_lds + (b) * SHM_K + kst) = sr_[i].k; \
    if (dor) *(u32x4*)(K_lds + (b) * SHM_K + krst) = sr_[i].r; } while (0)
#define RESC(a) do { if (__any((a) < 1.f)) { if (hi == 0) al_l[r32] = (a); asm volatile("s_waitcnt lgkmcnt(0)" ::: "memory"); \
    _Pragma("unroll") for (int d = 0; d < 2; ++d) _Pragma("unroll") for (int r = 0; r < 16; ++r) o[d][r] *= al_l[crow(r, hi)]; } } while (0)
  f32x16 pA0, pA1, pB0, pB1; float alA, alB; bf16x8 pa0, pa1, pa2, pa3; const int NT = seq / 64;
  __syncthreads();
  SLOAD(0, 0); SWRITE(0, 0); __syncthreads();
  qkt<DK>(pA0, pA1, K_lds, qr, r32, hi); partialSM(pA0, pA1, m_reg, alA);
  SLOAD(0, 64);
  SWRITE(1, 0); __syncthreads();
  for (int j = 1; j + 1 < NT; j += 2) {
    SBAR(); qkt<DK>(pB0, pB1, K_lds + SHM_K, qr, r32, hi);
    finishSM(pA0, pA1, alA, l_reg, pa0, pa1, pa2, pa3); SBAR();
    SLOAD(0, (j + 1) * 64); SBAR();
    pv_all(o, vb0, pa0, pa1, pa2, pa3); partialSM(pB0, pB1, m_reg, alB);
    __syncthreads(); SWRITE(0, 0);
    RESC(alB); __syncthreads();
    SBAR(); qkt<DK>(pA0, pA1, K_lds, qr, r32, hi);
    finishSM(pB0, pB1, alB, l_reg, pa0, pa1, pa2, pa3); SBAR();
    SLOAD(0, (j + 2) * 64); SBAR();
    pv_all(o, vb0 + SHM_V, pa0, pa1, pa2, pa3); partialSM(pA0, pA1, m_reg, alA);
    __syncthreads(); SWRITE(1, 0);
    RESC(alA); __syncthreads();
  }
  SBAR(); qkt<DK>(pB0, pB1, K_lds + SHM_K, qr, r32, hi);
  finishSM(pA0, pA1, alA, l_reg, pa0, pa1, pa2, pa3); SBAR();
  pv_all(o, vb0, pa0, pa1, pa2, pa3); partialSM(pB0, pB1, m_reg, alB);
  __syncthreads(); RESC(alB);
  finishSM(pB0, pB1, alB, l_reg, pa0, pa1, pa2, pa3); SBAR();
  pv_all(o, vb0 + SHM_V, pa0, pa1, pa2, pa3);
  if (hi == 0) li_l[r32] = l_reg; asm volatile("s_waitcnt lgkmcnt(0)" ::: "memory");
  float rli[16];
#pragma unroll
  for (int r = 0; r < 16; ++r) rli[r] = __builtin_amdgcn_rcpf(li_l[crow(r, hi)]);
#pragma unroll
  for (int r = 0; r < 16; ++r) {
    const size_t rowo = (size_t)(wid * 32 + crow(r, hi)) * 512;
#pragma unroll
    for (int d0 = 0; d0 < 2; ++d0) {
      const size_t idx = rowo + d0 * 32 + r32;
      const float g = bf2f(Gb[idx]);
      Ob[idx] = (bf16_t)(cvtpk(o[d0][r] * rli[r] * g, 0.f) & 0xffffu);
    }
  }
#undef SLOAD
#undef SWRITE
#undef RESC
}

__device__ __forceinline__ void exp16(f32x16& p) {
#pragma unroll
  for (int r = 0; r < 16; ++r) p[r] = __builtin_amdgcn_exp2f(p[r]);
}
__device__ __forceinline__ void finishFast(f32x16& p0, f32x16& p1, float& l_reg, bf16x8& pa0, bf16x8& pa1, bf16x8& pa2, bf16x8& pa3) {
  exp16(p1);
  float ps = 0.f;
#pragma unroll
  for (int r = 0; r < 16; ++r) ps += p0[r];
#pragma unroll
  for (int r = 0; r < 16; ++r) ps += p1[r];
  l_reg += ps;
#define PK4(P, BASE, OUT) do { unsigned a0 = cvtpk(P[BASE + 0], P[BASE + 1]), a1 = cvtpk(P[BASE + 2], P[BASE + 3]);   \
    unsigned b0 = cvtpk(P[BASE + 4], P[BASE + 5]), b1 = cvtpk(P[BASE + 6], P[BASE + 7]);                              \
    auto r0 = __builtin_amdgcn_permlane32_swap(a0, b0, false, false); auto r1 = __builtin_amdgcn_permlane32_swap(a1, b1, false, false); \
    u32x4 w = {r0[0], r1[0], r0[1], r1[1]}; OUT = *reinterpret_cast<bf16x8*>(&w); } while (0)
  PK4(p0, 0, pa0); PK4(p0, 8, pa1); PK4(p1, 0, pa2); PK4(p1, 8, pa3);
#undef PK4
}
template <int DK>
__device__ __forceinline__ void attn_unit_fast(const bf16_t* Qb, int ldq, const bf16_t* __restrict__ Kh, int ldk, const bf16_t* __restrict__ Krp,
                                               const bf16_t* __restrict__ Vh, int ldv, const bf16_t* Gb, bf16_t* Ob, int seq, char* lds) {
  constexpr int SHM_K = KL<DK>::SHM_K;
  const int tid = opaque_tid(), wid = __builtin_amdgcn_readfirstlane(tid >> 6), lane = tid & 63, r32 = lane & 31, hi = lane >> 5;
  char* V_lds = lds; char* K_lds = lds + 3 * SHM_V;
  float* ws = (float*)(lds + 3 * SHM_V + 3 * SHM_K) + wid * 64; float* li_l = ws;
  float l_reg = 0.f; f32x16 o[2]; bf16x8 qr[DK / 16];
#pragma unroll
  for (int r = 0; r < 16; ++r) { o[0][r] = 0.f; o[1][r] = 0.f; }
  const bf16_t* Qw = Qb + (size_t)(wid * 32 + r32) * ldq + hi * 8;
#pragma unroll
  for (int d0 = 0; d0 < DK / 16; ++d0) qr[d0] = *reinterpret_cast<const bf16x8*>(Qw + d0 * 16);
  const int srow = tid >> 3, sc = tid & 7, vst = v_st(srow, sc * 8), kst = kswz<DK>(srow, sc);
  const int rrow = tid >> 2, rc = tid & 3, krst = kswz<DK>(rrow & 63, 8 + rc);
  const bool dor = (DK == 96) && (wid < 4);
  const lds_cptr vb0 = (lds_cptr)V_lds + v_rd_base(lane);
  struct { u32x4 v, k, r; } sr_[1];
  const unsigned voff0 = (unsigned)(srow * ldv + sc * 8) * 2u, koff0 = (unsigned)(srow * ldk + sc * 8) * 2u, roff0 = (unsigned)(rrow * 32 + rc * 8) * 2u;
#define SLOAD(i, k0) do { sr_[i].v = *(const u32x4*)((const char*)Vh + (voff0 + (unsigned)((k0) * ldv) * 2u)); sr_[i].k = *(const u32x4*)((const char*)Kh + (koff0 + (unsigned)((k0) * ldk) * 2u)); \
    if (dor) sr_[i].r = *(const u32x4*)((const char*)Krp + (roff0 + (unsigned)((k0) * 64))); } while (0)
#define SWRITE(slot, i) do { *(u32x4*)(V_lds + (slot) * SHM_V + vst) = sr_[i].v; *(u32x4*)(K_lds + (slot) * SHM_K + kst) = sr_[i].k; \
    if (dor) *(u32x4*)(K_lds + (slot) * SHM_K + krst) = sr_[i].r; } while (0)
  f32x16 pA0, pA1, pB0, pB1; bf16x8 pa0, pa1, pa2, pa3; const int NT = seq / 64;
  int sp = 2, st = 0, sn = 1;
#define ROT() do { sp = st; st = sn; sn = (sn == 2) ? 0 : sn + 1; } while (0)
#define STEP(C0, C1, P0, P1, SETW, t, DOW) do { SBAR(); qkt<DK>(C0, C1, K_lds + st * SHM_K, qr, r32, hi); \
    finishFast(P0, P1, l_reg, pa0, pa1, pa2, pa3); \
    if (DOW) { SWRITE(sn, 0); if ((t) + 2 < NT) SLOAD(0, ((t) + 2) * 64); } \
    pv_all(o, vb0 + sp * SHM_V, pa0, pa1, pa2, pa3); exp16(C0); \
    __syncthreads(); ROT(); } while (0)
  __syncthreads();
  SLOAD(0, 0); SWRITE(0, 0); SLOAD(0, 64); __syncthreads();
  qkt<DK>(pA0, pA1, K_lds, qr, r32, hi);
  SWRITE(1, 0); SLOAD(0, 128);
  exp16(pA0);
  __syncthreads(); ROT();
  for (int t = 1; t + 1 < NT; t += 2) {
    STEP(pB0, pB1, pA0, pA1, 0, t, true);
    STEP(pA0, pA1, pB0, pB1, 1, t + 1, true);
  }
  STEP(pB0, pB1, pA0, pA1, 0, NT - 1, false);
  finishFast(pB0, pB1, l_reg, pa0, pa1, pa2, pa3); SBAR();
  pv_all(o, vb0 + sp * SHM_V, pa0, pa1, pa2, pa3);
  { auto rr = __builtin_amdgcn_permlane32_swap(__float_as_uint(l_reg), __float_as_uint(l_reg), false, false);
    l_reg = __uint_as_float(rr[0]) + __uint_as_float(rr[1]); }
  if (hi == 0) li_l[r32] = l_reg; asm volatile("s_waitcnt lgkmcnt(0)" ::: "memory");
  float rli[16];
#pragma unroll
  for (int r = 0; r < 16; ++r) rli[r] = __builtin_amdgcn_rcpf(li_l[crow(r, hi)]);
  {
    float* ost = (float*)(lds + 81920) + wid * 2048;
#pragma unroll
    for (int r = 0; r < 16; ++r) {
      const int row = crow(r, hi);
      ost[row * 64 + r32] = o[0][r] * rli[r];
      ost[row * 64 + 32 + r32] = o[1][r] * rli[r];
    }
#pragma unroll
    for (int i = 0; i < 8; ++i) {
      const int row = i * 4 + (lane >> 4), c4 = (lane & 15) * 4;
      const float4 v = *(const float4*)(ost + row * 64 + c4);
      const size_t idx = (size_t)(wid * 32 + row) * 512 + c4;
      const u32x2 g = *(const u32x2*)(Gb + idx);
      st4(Ob + idx, v.x * __uint_as_float(g.x << 16), v.y * __uint_as_float(g.x & 0xffff0000u), v.z * __uint_as_float(g.y << 16), v.w * __uint_as_float(g.y & 0xffff0000u));
    }
  }
#undef SLOAD
#undef SWRITE
#undef ROT
#undef STEP
}

__device__ __forceinline__ void phase_attn(const Params& p, char* lds) {
  char* dout = (char*)p.out;
  const float* bnd = (const float*)(p.ws + OFF_BND);
  const bool fastA = bnd[0] < 60.0f;
  const bool fastB = 3.0f * bnd[1] * (2.0f * bnd[2] + bnd[3]) < 3600.0f;
  for (int u = blockIdx.x; u < 2048; u += gridDim.x) {
    const int i = u >> 8, v = u & 255, cls = i >> 1, sub = i & 1, head = v & 7, j = v >> 3;
    int seq0, seq, tok0;
    if (cls < 2) { seq0 = 0; seq = NP; tok0 = (2 * j + sub) * 256; }
    else { const int bi = j >> 3, qb = 2 * (j & 7) + sub; seq0 = NP + bi * NS; seq = NS; tok0 = seq0 + qb * 256; }
    if ((cls & 1) == 0) {
      bf16_t* QA = (bf16_t*)(p.ws + OFF_QA);
      const bf16_t* Kp = (const bf16_t*)(p.ws + OFF_KA) + (size_t)seq0 * 128 + (head >> 2) * 64;
      const bf16_t* Vp = (const bf16_t*)(p.ws + OFF_VA) + (size_t)seq0 * 128 + (head >> 2) * 64;
      const bf16_t* Gp = (const bf16_t*)(dout + OO_GA) + (size_t)tok0 * 512 + head * 64;
      bf16_t* Qp = QA + (size_t)tok0 * 512 + head * 64;
      if (fastA) attn_unit_fast<64>(Qp, 512, Kp, 128, nullptr, Vp, 128, Gp, Qp, seq, lds);
      else if (ATT_SAFE) attn_unit<64>(Qp, 512, Kp, 128, nullptr, Vp, 128, Gp, Qp, seq, lds);
    } else {
      const bf16_t* Qp = (const bf16_t*)(p.ws + OFF_QB) + (size_t)tok0 * 768 + head * 96;
      const bf16_t* Kp = (const bf16_t*)(p.ws + OFF_KBN) + (size_t)seq0 * 512 + head * 64;
      const bf16_t* Rp = (const bf16_t*)(p.ws + OFF_KR) + (size_t)seq0 * 32;
      const bf16_t* Vp = (const bf16_t*)(p.ws + OFF_VB) + (size_t)seq0 * 512 + head * 64;
      const bf16_t* Gp = (const bf16_t*)(dout + OO_GB) + (size_t)tok0 * 512 + head * 64;
      bf16_t* Op = (bf16_t*)(dout + OO_YB) + (size_t)tok0 * 512 + head * 64;
      if (fastB) attn_unit_fast<96>(Qp, 768, Kp, 512, Rp, Vp, 512, Gp, Op, seq, lds);
      else if (ATT_SAFE) attn_unit<96>(Qp, 768, Kp, 512, Rp, Vp, 512, Gp, Op, seq, lds);
    }
  }
}

__device__ __forceinline__ void grid_barrier(unsigned* ctr, unsigned target) {
  asm volatile("s_waitcnt vmcnt(0)" ::: "memory");
  __syncthreads();
  if (threadIdx.x == 0) {
    __builtin_amdgcn_fence(__ATOMIC_RELEASE, "agent");
    asm volatile("s_waitcnt vmcnt(0)" ::: "memory");
    (void)__hip_atomic_fetch_add(ctr, 1u, __ATOMIC_RELAXED, __HIP_MEMORY_SCOPE_AGENT);
    unsigned spins = 0;
    while (__hip_atomic_load(ctr, __ATOMIC_RELAXED, __HIP_MEMORY_SCOPE_AGENT) < target) {
      __builtin_amdgcn_s_sleep(2);
      if (++spins > (1u << 24)) break;
    }
    __builtin_amdgcn_fence(__ATOMIC_ACQUIRE, "agent");
    asm volatile("s_waitcnt vmcnt(0)" ::: "memory");
  }
  __syncthreads();
}

#if MK_SINGLE
#ifndef PROBE_MASK
#define PROBE_MASK 0
#endif
__global__ void __launch_bounds__(512) fwd_kernel(Params p) {
  extern __shared__ __attribute__((aligned(16))) char lds[];
#if PROBE_MASK
  volatile unsigned long long* tst = (volatile unsigned long long*)(p.ws + OFF_BND + 256) + blockIdx.x * 16;
  if (threadIdx.x == 0) tst[0] = wall_clock64();
#define STAMP(k) if (threadIdx.x == 0) tst[k + 1] = wall_clock64();
#else
#define STAMP(k)
#endif
#define PHASE(k, call) if (PH_MASK & (1 << k)) { call; if (k == 0) { cg::this_grid().sync(); STAMP(k) } else if (k < 7) { grid_barrier((unsigned*)(p.ws + OFF_BAR), gridDim.x * (unsigned)k); STAMP(k) } }
  PHASE(0, phase0(p, lds))
  PHASE(1, phase1(p))
  PHASE(2, phase_g1(p, lds))
  PHASE(3, phase_g2(p, lds))
  PHASE(4, phase_attn(p, lds))
  PHASE(5, phase_g3(p, lds))
  PHASE(6, phase_g4(p, lds))
  PHASE(7, phase5(p))
#undef PHASE
#if PROBE_MASK
  if (blockIdx.x == 0) {
    __syncthreads();
    float* dshp = (float*)lds;
    if (threadIdx.x == 0) {
    unsigned long long tot = 0;
    for (int k = 0; k < 7; ++k) if (PROBE_MASK & (1 << k)) tot += tst[k + 1] - tst[k];
    dshp[0] = sqrtf((float)tot * (0.01f / 4000.0f));
    }
    __syncthreads();
    const float d = dshp[0];
    for (int i = threadIdx.x; i < 8 * 1024; i += 512) p.out[i] += d;
  }
#endif
}
#define MAIN_KERNEL fwd_kernel
#else
template <int PH>
__global__ void __launch_bounds__(512) ph_kernel(Params p) {
  extern __shared__ __attribute__((aligned(16))) char lds[];
  if (PH == 0) phase0(p, lds);
  if (PH == 1) phase1(p);
  if (PH == 2) phase_g1(p, lds);
  if (PH == 3) phase_g2(p, lds);
  if (PH == 4) phase_attn(p, lds);
  if (PH == 5) phase_g3(p, lds);
  if (PH == 6) phase_g4(p, lds);
  if (PH == 7) phase5(p);
}
#define MAIN_KERNEL ph_kernel<4>
#endif

extern "C" void kernel_launch(void* const* d_in, const int* in_sizes, int n_in, void* d_out, int out_size, void* d_ws, size_t ws_size,
                              hipStream_t stream) {
  Params p{};
  p.x_prompt = (const float*)d_in[0]; p.x_sample = (const float*)d_in[1]; p.c_prompt = (const float*)d_in[2]; p.c_sample = (const float*)d_in[3];
  p.ada_w = (const float*)d_in[4]; p.ada_b = (const float*)d_in[5]; p.pre_g = (const float*)d_in[6]; p.post_g = (const float*)d_in[7];
  p.w_in = (const float*)d_in[8]; p.a_q_g = (const float*)d_in[9]; p.a_k_g = (const float*)d_in[10]; p.b_q_g = (const float*)d_in[11];
  p.b_q_up = (const float*)d_in[12]; p.b_kv_g = (const float*)d_in[13]; p.b_kv_up = (const float*)d_in[14]; p.a_out = (const float*)d_in[15];
  p.b_out = (const float*)d_in[16]; p.w_o = (const float*)d_in[17];
  p.out = (float*)d_out; p.ws = (char*)d_ws;
  static int grid_blocks = 0;
  if (!grid_blocks) {
    int dev = 0, cus = 0, per_cu = 0;
    (void)hipGetDevice(&dev);
    (void)hipDeviceGetAttribute(&cus, hipDeviceAttributeMultiprocessorCount, dev);
    (void)hipFuncSetAttribute((const void*)MAIN_KERNEL, hipFuncAttributeMaxDynamicSharedMemorySize, LDS_BYTES);
    (void)hipOccupancyMaxActiveBlocksPerMultiprocessor(&per_cu, MAIN_KERNEL, 512, LDS_BYTES);
    if (per_cu < 1) per_cu = 1;
    if (per_cu > 1) per_cu = 1;
    grid_blocks = cus * per_cu;
    if (grid_blocks <= 0) grid_blocks = 256;
  }
#if MK_SINGLE
  void* args[] = {&p};
  hipError_t err = hipLaunchCooperativeKernel((const void*)fwd_kernel, dim3(grid_blocks), dim3(512), args, LDS_BYTES, stream);
  if (err != hipSuccess) fprintf(stderr, "cooperative launch failed: %s (grid %d)\n", hipGetErrorString(err), grid_blocks);
#else
  static bool attr_set = false;
  if (!attr_set) {
    (void)hipFuncSetAttribute((const void*)ph_kernel<0>, hipFuncAttributeMaxDynamicSharedMemorySize, LDS_BYTES);
    (void)hipFuncSetAttribute((const void*)ph_kernel<2>, hipFuncAttributeMaxDynamicSharedMemorySize, LDS_BYTES);
    (void)hipFuncSetAttribute((const void*)ph_kernel<3>, hipFuncAttributeMaxDynamicSharedMemorySize, LDS_BYTES);
    (void)hipFuncSetAttribute((const void*)ph_kernel<5>, hipFuncAttributeMaxDynamicSharedMemorySize, LDS_BYTES);
    (void)hipFuncSetAttribute((const void*)ph_kernel<6>, hipFuncAttributeMaxDynamicSharedMemorySize, LDS_BYTES);
    attr_set = true;
  }
  hipLaunchKernelGGL(ph_kernel<0>, dim3(grid_blocks), dim3(512), LDS_BYTES, stream, p);
  hipLaunchKernelGGL(ph_kernel<1>, dim3(grid_blocks), dim3(512), LDS_BYTES, stream, p);
  hipLaunchKernelGGL(ph_kernel<2>, dim3(grid_blocks), dim3(512), LDS_BYTES, stream, p);
  hipLaunchKernelGGL(ph_kernel<3>, dim3(grid_blocks), dim3(512), LDS_BYTES, stream, p);
  hipLaunchKernelGGL(ph_kernel<4>, dim3(grid_blocks), dim3(512), LDS_BYTES, stream, p);
  hipLaunchKernelGGL(ph_kernel<5>, dim3(grid_blocks), dim3(512), LDS_BYTES, stream, p);
  hipLaunchKernelGGL(ph_kernel<6>, dim3(grid_blocks), dim3(512), LDS_BYTES, stream, p);
  hipLaunchKernelGGL(ph_kernel<7>, dim3(grid_blocks), dim3(512), LDS_BYTES, stream, p);
#endif
}
```

```cpp
#include <hip/hip_runtime.h>
#include <hip/hip_cooperative_groups.h>
#include <stdint.h>
#include <cstdio>
namespace cg = cooperative_groups;

#ifndef MK_SINGLE
#define MK_SINGLE 1
#endif
#ifndef QKT_SB
#define QKT_SB 0
#endif
#ifndef ATT_SAFE
#define ATT_SAFE 1
#endif
#ifndef PH_MASK
#define PH_MASK 255
#endif

typedef unsigned short bf16_t;
typedef short bf16x8 __attribute__((ext_vector_type(8)));
typedef short s16x4 __attribute__((ext_vector_type(4)));
typedef float f32x16 __attribute__((ext_vector_type(16)));
typedef unsigned u32x4 __attribute__((ext_vector_type(4)));
typedef unsigned u32x2 __attribute__((ext_vector_type(2)));

constexpr int T = 32768, NP = 16384, NS = 4096, DM = 1024;
constexpr float EPS = 1e-6f;
constexpr float LOG2E = 1.4426950408889634f;
constexpr float PS_A = 0.125f * LOG2E;
constexpr float PS_B = 0.10206207261596575f * LOG2E;

constexpr size_t U = 67108864ull;
constexpr size_t OFF_H = 0;
constexpr size_t OFF_QA = U;
constexpr size_t OFF_KA = U + U / 2;
constexpr size_t OFF_VA = OFF_KA + U / 8;
constexpr size_t OFF_KR = OFF_VA + U / 8;
constexpr size_t OFF_PART = OFF_KR + 2097152;
constexpr size_t OFF_QB = 2 * U;
constexpr size_t OFF_KBN = OFF_QB + (U / 4) * 3;
constexpr size_t OFF_VB = OFF_KBN + U / 2;
constexpr size_t OFF_W = OFF_VB + U / 2;
constexpr size_t OFF_WIN = OFF_W;
constexpr size_t OFF_WQUP = OFF_WIN + 4608ull * 1024 * 2;
constexpr size_t OFF_WKVUP = OFF_WQUP + 768ull * 384 * 2;
constexpr size_t OFF_WAOUT = OFF_WKVUP + 1024ull * 256 * 2;
constexpr size_t OFF_WBOUT = OFF_WAOUT + 1024ull * 512 * 2;
constexpr size_t OFF_WO = OFF_WBOUT + 1024ull * 512 * 2;
constexpr size_t OFF_MOD = OFF_WO + 1024ull * 1024 * 2;
constexpr size_t OFF_SSQ = OFF_MOD + 5 * 3072 * 4;
constexpr size_t OFF_TABA = OFF_SSQ + 3ull * T * 4;
constexpr size_t OFF_TABB = OFF_TABA + 256 * 16 * 8;
constexpr size_t OFF_BND = OFF_TABB + 256 * 8 * 8;
constexpr size_t OFF_BAR = OFF_BND + 128;
constexpr size_t WS_END = OFF_BND + 256 + 256 * 128;
static_assert(WS_END <= 4 * U, "workspace map exceeds 256 MiB");
constexpr size_t OO_BQ = 0;
constexpr size_t OO_BKV = (size_t)T * 384 * 2;
constexpr size_t OO_YB = 0;
constexpr size_t OO_GA = U;
constexpr size_t OO_GB = U + U / 2;
constexpr size_t OO_MERGED = U;

constexpr int LDS_BYTES = 163840;

struct Params {
  const float *x_prompt, *x_sample, *c_prompt, *c_sample, *ada_w, *ada_b, *pre_g, *post_g, *w_in, *a_q_g, *a_k_g, *b_q_g, *b_q_up,
      *b_kv_g, *b_kv_up, *a_out, *b_out, *w_o;
  float* out;
  char* ws;
};

typedef float f32x4n __attribute__((ext_vector_type(4)));
__device__ __forceinline__ float4 nt_load4(const float* p) { const f32x4n v = __builtin_nontemporal_load((const f32x4n*)p); return make_float4(v.x, v.y, v.z, v.w); }
__device__ __forceinline__ void nt_store4(float* p, float4 r) { f32x4n v = {r.x, r.y, r.z, r.w}; __builtin_nontemporal_store(v, (f32x4n*)p); }
__device__ __forceinline__ int opaque_tid() { int t = threadIdx.x; asm volatile("" : "+v"(t)); return t; }
typedef float f32x2_t __attribute__((ext_vector_type(2)));
typedef __bf16 bf16x2_t __attribute__((ext_vector_type(2)));
__device__ __forceinline__ unsigned cvtpk(float lo, float hi) { f32x2_t v = {lo, hi}; bf16x2_t b = __builtin_convertvector(v, bf16x2_t); return __builtin_bit_cast(unsigned, b); }
__device__ __forceinline__ float bf2f(unsigned short v) { return __uint_as_float(((unsigned)v) << 16); }
__device__ __forceinline__ int crow(int r, int hi) { return (r & 3) + 8 * (r >> 2) + 4 * hi; }
__device__ __forceinline__ void st4(bf16_t* p, float a, float b, float c, float d) { u32x2 w; w.x = cvtpk(a, b); w.y = cvtpk(c, d); *(u32x2*)p = w; }
__device__ __forceinline__ float sigmoidf_(float v) { return 1.0f / (1.0f + __expf(-v)); }
__device__ __forceinline__ const float* xrow_ptr(const Params& p, int tok) { return tok < NP ? p.x_prompt + (size_t)tok * DM : p.x_sample + (size_t)(tok - NP) * DM; }
__device__ __forceinline__ int batch_of(int tok) { return tok < NP ? 0 : 1 + ((tok - NP) >> 12); }
__device__ __forceinline__ int pos_of(int tok) { return tok < NP ? tok : ((tok - NP) & 4095); }

__device__ __forceinline__ int win_src(int n) {
  if (n < 768) return n;
  if (n < 1152) return 1280 + (n - 768);
  if (n < 1408) return 1664 + (n - 1152);
  if (n < 1440) return 1920 + (n - 1408);
  if (n < 1536) return -1;
  if (n < 2048) return 768 + (n - 1536);
  if (n < 2560) return 1952 + (n - 2048);
  return 2464 + (n - 2560);
}
__device__ __forceinline__ void cvt_tile(const float* __restrict__ W, int ldn, int K, bf16_t* __restrict__ dst, bool remap,
                                         const float* __restrict__ gain, int item, float* tl  , int tid) {
  const int ktiles = K >> 6, n0 = (item / ktiles) * 64, k0 = (item % ktiles) * 64;
  __syncthreads();
  {
    const int n4 = (tid & 15) * 4, kr = tid >> 4;
    const int nd = n0 + n4;
    const int src = remap ? win_src(nd) : nd;
#pragma unroll
    for (int i = 0; i < 2; ++i) {
      const int k = kr + 32 * i;
      float4 v = make_float4(0.f, 0.f, 0.f, 0.f);
      if (src >= 0) v = *(const float4*)(W + (size_t)(k0 + k) * ldn + src);
      if (gain) { const float g = gain[k0 + k]; v.x *= g; v.y *= g; v.z *= g; v.w *= g; }
      float* r = tl + k * 65 + n4;
      r[0] = v.x; r[1] = v.y; r[2] = v.z; r[3] = v.w;
    }
  }
  __syncthreads();
  {
    const int n = tid >> 3, kc = tid & 7;
    const float* c = tl + (kc * 8) * 65 + n;
    u32x4 o; o.x = cvtpk(c[0], c[65]); o.y = cvtpk(c[130], c[195]); o.z = cvtpk(c[260], c[325]); o.w = cvtpk(c[390], c[455]);
    *(u32x4*)(dst + (size_t)(n0 + n) * K + k0 + kc * 8) = o;
  }
}

__device__ __forceinline__ void phase0(const Params& p, char* lds) {
  const int tid = opaque_tid(), gsz = gridDim.x * 512, gtid = blockIdx.x * 512 + tid;
  if (gtid == 0) {
    float* bnd = (float*)(p.ws + OFF_BND);
    float gq = 0.f, gk = 0.f;
    for (int i = 0; i < 64; ++i) { gq = fmaxf(gq, fabsf(p.a_q_g[i])); gk = fmaxf(gk, fabsf(p.a_k_g[i])); }
    bnd[0] = 64.0f * gq * gk * PS_A;
    bnd[1] = 0.f; bnd[2] = 0.f; bnd[3] = 0.f;
    __hip_atomic_store((unsigned*)(p.ws + OFF_BAR), 0u, __ATOMIC_RELAXED, __HIP_MEMORY_SCOPE_AGENT);
  }
  float2* tabA = (float2*)(p.ws + OFF_TABA);
  float2* tabB = (float2*)(p.ws + OFF_TABB);
  for (int i = gtid; i < 256 * 16 + 256 * 8; i += gsz) {
    int pos, f; float inv;
    const float L2T = 13.287712379549449f;
    if (i < 4096) { pos = i >> 4; f = i & 15; inv = exp2f(-(float)f * (1.0f / 16.0f) * L2T); }
    else { int k = i - 4096; pos = k >> 3; f = k & 7; inv = exp2f(-(float)f * (1.0f / 8.0f) * L2T); }
    float ang = (float)pos * inv;
    float rev = ang * 0.15915494309189535f; rev -= floorf(rev);
    float2 cs; cs.x = __builtin_amdgcn_cosf(rev); cs.y = __builtin_amdgcn_sinf(rev);
    if (i < 4096) tabA[i] = cs; else tabB[i - 4096] = cs;
  }
  {
    float* tl = (float*)(lds + 16384);
    for (int it = blockIdx.x; it < 1800; it += gridDim.x) {
      if (it < 1152) cvt_tile(p.w_in, 4512, 1024, (bf16_t*)(p.ws + OFF_WIN), true, nullptr, it, tl, tid);
      else if (it < 1224) cvt_tile(p.b_q_up, 768, 384, (bf16_t*)(p.ws + OFF_WQUP), false, p.b_q_g, it - 1152, tl, tid);
      else if (it < 1288) cvt_tile(p.b_kv_up, 1024, 256, (bf16_t*)(p.ws + OFF_WKVUP), false, p.b_kv_g, it - 1224, tl, tid);
      else if (it < 1416) cvt_tile(p.a_out, 1024, 512, (bf16_t*)(p.ws + OFF_WAOUT), false, nullptr, it - 1288, tl, tid);
      else if (it < 1544) cvt_tile(p.b_out, 1024, 512, (bf16_t*)(p.ws + OFF_WBOUT), false, nullptr, it - 1416, tl, tid);
      else cvt_tile(p.w_o, 1024, 1024, (bf16_t*)(p.ws + OFF_WO), false, nullptr, it - 1544, tl, tid);
    }
  }
  float* red = (float*)lds;
  float* sl = (float*)(lds + 16384);
  float* mod = (float*)(p.ws + OFF_MOD);
  __syncthreads();
  for (int i = tid; i < 5 * 1024; i += 512) { const float cv = i < 1024 ? p.c_prompt[i] : p.c_sample[i - 1024]; sl[i] = cv * sigmoidf_(cv); }
  __syncthreads();
  for (int it = blockIdx.x; it < 256; it += gridDim.x) {
    const int c = tid & 15, kg = tid >> 4;
    float a0 = 0.f, a1 = 0.f, a2 = 0.f, a3 = 0.f, a4 = 0.f;
    if (c < 12) {
      const float* wp = p.ada_w + it * 12 + c;
#pragma unroll 8
      for (int k = kg; k < 1024; k += 32) {
        const float w = wp[(size_t)k * 3072];
        a0 += sl[k] * w; a1 += sl[1024 + k] * w; a2 += sl[2048 + k] * w; a3 += sl[3072 + k] * w; a4 += sl[4096 + k] * w;
      }
    }
    float* rp = red + (kg * 16 + c) * 5;
    rp[0] = a0; rp[1] = a1; rp[2] = a2; rp[3] = a3; rp[4] = a4;
    __syncthreads();
    if (tid < 60) {
      const int cc = tid / 5, b = tid % 5;
      float s = 0.f;
      for (int g = 0; g < 32; ++g) s += red[(g * 16 + cc) * 5 + b];
      const int col = it * 12 + cc;
      mod[b * 3072 + col] = s + p.ada_b[col];
    }
    __syncthreads();
  }
}

__device__ __forceinline__ float wave_sum(float v) {
#pragma unroll
  for (int o = 32; o >= 1; o >>= 1) v += __shfl_xor(v, o);
  return v;
}
__device__ __forceinline__ void phase1(const Params& p) {
  const int tid = opaque_tid(), wid = tid >> 6, lane = tid & 63;
  const float* mod = (const float*)(p.ws + OFF_MOD);
  bf16_t* H = (bf16_t*)(p.ws + OFF_H);
  const int NW = gridDim.x * 8;
  for (int row0 = blockIdx.x * 8 + wid; row0 < T; row0 += 4 * NW) {
    float4 v[4][4];
#pragma unroll
    for (int j = 0; j < 4; ++j) {
      const int row = row0 + j * NW;
      if (row < T) {
        const float* xr = xrow_ptr(p, row);
#pragma unroll
        for (int i = 0; i < 4; ++i) v[j][i] = nt_load4(xr + i * 256 + lane * 4);
      }
    }
#pragma unroll
    for (int j = 0; j < 4; ++j) {
      const int row = row0 + j * NW;
      if (row < T) {
        const int b = batch_of(row);
        float ss = 0.f;
#pragma unroll
        for (int i = 0; i < 4; ++i) ss += v[j][i].x * v[j][i].x + v[j][i].y * v[j][i].y + v[j][i].z * v[j][i].z + v[j][i].w * v[j][i].w;
        ss = wave_sum(ss);
        const float rn = rsqrtf(ss * (1.0f / 1024.0f) + EPS);
#pragma unroll
        for (int i = 0; i < 4; ++i) {
          const int col = i * 256 + lane * 4;
          const float4 g = *(const float4*)(p.pre_g + col);
          const float4 sh = *(const float4*)(mod + b * 3072 + col);
          const float4 sc = *(const float4*)(mod + b * 3072 + 1024 + col);
          st4(H + (size_t)row * DM + col, v[j][i].x * rn * g.x * (1.f + sc.x) + sh.x, v[j][i].y * rn * g.y * (1.f + sc.y) + sh.y,
              v[j][i].z * rn * g.z * (1.f + sc.z) + sh.z, v[j][i].w * rn * g.w * (1.f + sc.w) + sh.w);
        }
      }
    }
  }
}

constexpr int G_XB = 256 * 128, G_WB = 128 * 128, G_STAGE = G_XB + G_WB;
__device__ __forceinline__ int gswz(int row, int c) { return row * 128 + ((c ^ ((row >> 1) & 7)) << 4); }

__device__ __forceinline__ void gemm_kloop(const bf16_t* __restrict__ X, int ldx, const bf16_t* __restrict__ W, int ldw, int nk,
                                           f32x16 (&acc)[2][2], char* lds) {
  const int tid = opaque_tid(), wid = __builtin_amdgcn_readfirstlane(tid >> 6), lane = tid & 63, r32 = lane & 31, hi = lane >> 5, wm = wid & 3, wn = wid >> 2;
  const int srow = tid >> 3, sch = tid & 7;
  const char* xg = (const char*)X;
  const char* wg = (const char*)W;
  const unsigned xstep = (unsigned)ldx * 128u, wstep = (unsigned)ldw * 128u;
  const unsigned xo0 = (unsigned)(srow * ldx + sch * 8) * 2u, wo0 = (unsigned)(srow * ldw + sch * 8) * 2u;
  const int sw = gswz(srow, sch);
  u32x4 xa[4], wa[2], xb[4], wb[2];
  const int fsw = (r32 >> 1) & 7;
  int koff[4];
#pragma unroll
  for (int ks = 0; ks < 4; ++ks) koff[ks] = ((2 * ks + hi) ^ fsw) << 4;
  const int rowA = G_XB + (wn * 64 + r32) * 128, rowB = (wm * 64 + r32) * 128;
#define GLOAD(xr, wr, kt) do { _Pragma("unroll") for (int i = 0; i < 4; ++i) xr[i] = *(const u32x4*)(xg + (xo0 + i * xstep + (unsigned)(kt) * 128u)); \
    _Pragma("unroll") for (int i = 0; i < 2; ++i) wr[i] = *(const u32x4*)(wg + (wo0 + i * wstep + (unsigned)(kt) * 128u)); } while (0)
#define GWRITE(s, xr, wr) do { char* b_ = lds + (s) * G_STAGE; _Pragma("unroll") for (int i = 0; i < 4; ++i) *(u32x4*)(b_ + sw + i * 8192) = xr[i]; \
    _Pragma("unroll") for (int i = 0; i < 2; ++i) *(u32x4*)(b_ + G_XB + sw + i * 8192) = wr[i]; } while (0)
#define GCOMPUTE(s) do { const char* sb = lds + (s) * G_STAGE; _Pragma("unroll") for (int ks = 0; ks < 4; ++ks) { \
      const bf16x8 a0 = *(const bf16x8*)(sb + rowA + koff[ks]); const bf16x8 a1 = *(const bf16x8*)(sb + rowA + 4096 + koff[ks]); \
      const bf16x8 b0 = *(const bf16x8*)(sb + rowB + koff[ks]); const bf16x8 b1 = *(const bf16x8*)(sb + rowB + 4096 + koff[ks]); \
      acc[0][0] = __builtin_amdgcn_mfma_f32_32x32x16_bf16(a0, b0, acc[0][0], 0, 0, 0); acc[0][1] = __builtin_amdgcn_mfma_f32_32x32x16_bf16(a0, b1, acc[0][1], 0, 0, 0); \
      acc[1][0] = __builtin_amdgcn_mfma_f32_32x32x16_bf16(a1, b0, acc[1][0], 0, 0, 0); acc[1][1] = __builtin_amdgcn_mfma_f32_32x32x16_bf16(a1, b1, acc[1][1], 0, 0, 0); } } while (0)
  __syncthreads();
  GLOAD(xa, wa, 0); GLOAD(xb, wb, 1); GWRITE(0, xa, wa); __syncthreads();
#pragma nounroll
  for (int kt = 0; kt < nk; kt += 2) {
    const int ka = kt + 2 < nk ? kt + 2 : nk - 2, kb = kt + 3 < nk ? kt + 3 : nk - 1;
    GLOAD(xa, wa, ka);
    GCOMPUTE(0);
    GWRITE(1, xb, wb);
    __syncthreads();
    GLOAD(xb, wb, kb);
    GCOMPUTE(1);
    GWRITE(0, xa, wa);
    __syncthreads();
  }
  asm volatile("s_waitcnt vmcnt(0)" ::: "memory");
#undef GLOAD
#undef GWRITE
#undef GCOMPUTE
}
__device__ __forceinline__ void zero_acc(f32x16 (&acc)[2][2]) {
#pragma unroll
  for (int a = 0; a < 2; ++a)
#pragma unroll
    for (int b = 0; b < 2; ++b)
#pragma unroll
      for (int r = 0; r < 16; ++r) acc[a][b][r] = 0.f;
}

constexpr int G2_XB = 256 * 128, G2_STAGE = 2 * G2_XB;
__device__ __forceinline__ void gemm_kloop256(const bf16_t* __restrict__ X, int ldx, const bf16_t* __restrict__ W, int ldw, int nk,
                                              f32x16 (&acc)[2][4], char* lds) {
  const int tid = opaque_tid(), wid = __builtin_amdgcn_readfirstlane(tid >> 6), lane = tid & 63, r32 = lane & 31, hi = lane >> 5, wm = wid & 1, wn = wid >> 1;
  const int srow = tid >> 3, sch = tid & 7;
  const char* xg = (const char*)X; const char* wg = (const char*)W;
  const unsigned xstep = (unsigned)ldx * 128u, wstep = (unsigned)ldw * 128u;
  const unsigned xo0 = (unsigned)(srow * ldx + sch * 8) * 2u, wo0 = (unsigned)(srow * ldw + sch * 8) * 2u;
  const int sw = gswz(srow, sch);
  u32x4 xa[4], wa[4];
  const int fsw = (r32 >> 1) & 7;
  int koff[4];
#pragma unroll
  for (int ks = 0; ks < 4; ++ks) koff[ks] = ((2 * ks + hi) ^ fsw) << 4;
  const int rowA = G2_XB + (wn * 64 + r32) * 128, rowB = (wm * 128 + r32) * 128;
#define GLOAD(xr, wr, kt) do { _Pragma("unroll") for (int i = 0; i < 4; ++i) { xr[i] = *(const u32x4*)(xg + (xo0 + i * xstep + (unsigned)(kt) * 128u)); \
    wr[i] = *(const u32x4*)(wg + (wo0 + i * wstep + (unsigned)(kt) * 128u)); } } while (0)
#define GWRITE(s, xr, wr) do { char* b_ = lds + (s) * G2_STAGE; _Pragma("unroll") for (int i = 0; i < 4; ++i) { *(u32x4*)(b_ + sw + i * 8192) = xr[i]; \
    *(u32x4*)(b_ + G2_XB + sw + i * 8192) = wr[i]; } } while (0)
#define GCOMPUTE(s) do { const char* sb = lds + (s) * G2_STAGE; _Pragma("unroll") for (int ks = 0; ks < 4; ++ks) { \
      const bf16x8 a0 = *(const bf16x8*)(sb + rowA + koff[ks]); const bf16x8 a1 = *(const bf16x8*)(sb + rowA + 4096 + koff[ks]); \
      _Pragma("unroll") for (int ti = 0; ti < 4; ++ti) { const bf16x8 b = *(const bf16x8*)(sb + rowB + ti * 4096 + koff[ks]); \
        acc[0][ti] = __builtin_amdgcn_mfma_f32_32x32x16_bf16(a0, b, acc[0][ti], 0, 0, 0); acc[1][ti] = __builtin_amdgcn_mfma_f32_32x32x16_bf16(a1, b, acc[1][ti], 0, 0, 0); } } } while (0)
  __syncthreads();
  GLOAD(xa, wa, 0); GWRITE(0, xa, wa); __syncthreads();
#pragma nounroll
  for (int kt = 0; kt < nk; kt += 2) {
    const int ka = kt + 1, kb = kt + 2 < nk ? kt + 2 : nk - 1;
    GLOAD(xa, wa, ka);
    GCOMPUTE(0);
    GWRITE(1, xa, wa);
    __syncthreads();
    GLOAD(xa, wa, kb);
    GCOMPUTE(1);
    GWRITE(0, xa, wa);
    __syncthreads();
  }
  asm volatile("s_waitcnt vmcnt(0)" ::: "memory");
#undef GLOAD
#undef GWRITE
#undef GCOMPUTE
}
__device__ __forceinline__ void zero_acc4(f32x16 (&acc)[2][4]) {
#pragma unroll
  for (int a = 0; a < 2; ++a)
#pragma unroll
    for (int b = 0; b < 4; ++b)
#pragma unroll
      for (int r = 0; r < 16; ++r) acc[a][b][r] = 0.f;
}

__device__ __forceinline__ void stage_put(char* wb, int t, int q, float a, float b, float c, float d) {
  u32x2 w; w.x = cvtpk(a, b); w.y = cvtpk(c, d);
  *(u32x2*)(wb + t * 128 + ((q ^ ((t & 7) << 1)) << 3)) = w;
}
__device__ __forceinline__ void stage_flush(const char* wb, bf16_t* dst, int ld, int lane) {
#pragma unroll
  for (int i = 0; i < 8; ++i) {
    const int row = i * 8 + (lane >> 3), c = lane & 7;
    const u32x4 v = *(const u32x4*)(wb + row * 128 + ((c ^ (row & 7)) << 4));
    *(u32x4*)(dst + (size_t)row * ld + c * 8) = v;
  }
}
__device__ __forceinline__ void stage_flush128(const char* wb, bf16_t* dst, int ld, int lane) {
#pragma unroll
  for (int i = 0; i < 16; ++i) {
    const int row = i * 8 + (lane >> 3), c = lane & 7;
    const u32x4 v = *(const u32x4*)(wb + row * 128 + ((c ^ (row & 7)) << 4));
    *(u32x4*)(dst + (size_t)row * ld + c * 8) = v;
  }
}
__device__ __forceinline__ void stage_flush_add(const char* wb, bf16_t* dst, int ld, int lane) {
#pragma unroll
  for (int i = 0; i < 8; ++i) {
    const int row = i * 8 + (lane >> 3), c = lane & 7;
    const u32x4 v = *(const u32x4*)(wb + row * 128 + ((c ^ (row & 7)) << 4));
    u32x4* gp = (u32x4*)(dst + (size_t)row * ld + c * 8);
    const u32x4 o = *gp;
    u32x4 r;
    r.x = cvtpk(__uint_as_float(v.x << 16) + __uint_as_float(o.x << 16), __uint_as_float(v.x & 0xffff0000u) + __uint_as_float(o.x & 0xffff0000u));
    r.y = cvtpk(__uint_as_float(v.y << 16) + __uint_as_float(o.y << 16), __uint_as_float(v.y & 0xffff0000u) + __uint_as_float(o.y & 0xffff0000u));
    r.z = cvtpk(__uint_as_float(v.z << 16) + __uint_as_float(o.z << 16), __uint_as_float(v.z & 0xffff0000u) + __uint_as_float(o.z & 0xffff0000u));
    r.w = cvtpk(__uint_as_float(v.w << 16) + __uint_as_float(o.w << 16), __uint_as_float(v.w & 0xffff0000u) + __uint_as_float(o.w & 0xffff0000u));
    *gp = r;
  }
}
__device__ __forceinline__ void epi_rope64(const f32x16& a0, const f32x16& a1, int t, const float* __restrict__ gain, float ps,
                                           const float2* __restrict__ tabA, char* wb, int tl, int hi) {
  float ss = 0.f;
#pragma unroll
  for (int r = 0; r < 16; ++r) ss += a0[r] * a0[r] + a1[r] * a1[r];
  ss += __shfl_xor(ss, 32);
  const float rn = rsqrtf(ss * (1.0f / 64.0f) + EPS);
  const int prow = t >> 6, pcol = t & 63;
#pragma unroll
  for (int g = 0; g < 4; ++g) {
    const int f0 = 8 * (g & 1) + 4 * hi, pos = g < 2 ? prow : pcol, d = 8 * g + 4 * hi;
    const float4* tp = (const float4*)(tabA + pos * 16 + f0);
    const float4 t01 = tp[0], t23 = tp[1];
    const float4 g1 = *(const float4*)(gain + d), g2 = *(const float4*)(gain + 32 + d);
    const float x10 = a0[4 * g + 0] * rn * g1.x, x11 = a0[4 * g + 1] * rn * g1.y, x12 = a0[4 * g + 2] * rn * g1.z, x13 = a0[4 * g + 3] * rn * g1.w;
    const float x20 = a1[4 * g + 0] * rn * g2.x, x21 = a1[4 * g + 1] * rn * g2.y, x22 = a1[4 * g + 2] * rn * g2.z, x23 = a1[4 * g + 3] * rn * g2.w;
    stage_put(wb, tl, 2 * g + hi, (x10 * t01.x - x20 * t01.y) * ps, (x11 * t01.z - x21 * t01.w) * ps, (x12 * t23.x - x22 * t23.y) * ps, (x13 * t23.z - x23 * t23.w) * ps);
    stage_put(wb, tl, 8 + 2 * g + hi, (x20 * t01.x + x10 * t01.y) * ps, (x21 * t01.z + x11 * t01.w) * ps, (x22 * t23.x + x12 * t23.y) * ps, (x23 * t23.z + x13 * t23.w) * ps);
  }
}
__device__ __forceinline__ void rope32_vals(const f32x16& a, float mul, int t, const float2* __restrict__ tabB, int hi, int g, float (&o1)[4], float (&o2)[4]) {
  const int pos = g == 0 ? (t >> 6) : (t & 63);
  const float4* tp = (const float4*)(tabB + pos * 8 + 4 * hi);
  const float4 t01 = tp[0], t23 = tp[1];
  const float x10 = a[4 * g + 0] * mul, x11 = a[4 * g + 1] * mul, x12 = a[4 * g + 2] * mul, x13 = a[4 * g + 3] * mul;
  const float x20 = a[8 + 4 * g + 0] * mul, x21 = a[8 + 4 * g + 1] * mul, x22 = a[8 + 4 * g + 2] * mul, x23 = a[8 + 4 * g + 3] * mul;
  o1[0] = x10 * t01.x - x20 * t01.y; o1[1] = x11 * t01.z - x21 * t01.w; o1[2] = x12 * t23.x - x22 * t23.y; o1[3] = x13 * t23.z - x23 * t23.w;
  o2[0] = x20 * t01.x + x10 * t01.y; o2[1] = x21 * t01.z + x11 * t01.w; o2[2] = x22 * t23.x + x12 * t23.y; o2[3] = x23 * t23.z + x13 * t23.w;
}
__device__ __forceinline__ void epi_rope32(const f32x16& a, float mul, int t, const float2* __restrict__ tabB, char* wb, int tl, int qb, int hi) {
#pragma unroll
  for (int g = 0; g < 2; ++g) {
    float o1[4], o2[4];
    rope32_vals(a, mul, t, tabB, hi, g, o1, o2);
    stage_put(wb, tl, qb + 2 * g + hi, o1[0], o1[1], o1[2], o1[3]);
    stage_put(wb, tl, qb + 4 + 2 * g + hi, o2[0], o2[1], o2[2], o2[3]);
  }
}
__device__ __forceinline__ void epi_rope32_direct(const f32x16& a, float mul, int t, const float2* __restrict__ tabB, bf16_t* dst, int hi) {
#pragma unroll
  for (int g = 0; g < 2; ++g) {
    float o1[4], o2[4];
    rope32_vals(a, mul, t, tabB, hi, g, o1, o2);
    st4(dst + 8 * g + 4 * hi, o1[0], o1[1], o1[2], o1[3]);
    st4(dst + 16 + 8 * g + 4 * hi, o2[0], o2[1], o2[2], o2[3]);
  }
}
__device__ __forceinline__ void epi_plain32(const f32x16& a, float mul, char* wb, int tl, int qb, int hi) {
#pragma unroll
  for (int g = 0; g < 4; ++g) stage_put(wb, tl, qb + 2 * g + hi, a[4 * g] * mul, a[4 * g + 1] * mul, a[4 * g + 2] * mul, a[4 * g + 3] * mul);
}
__device__ __forceinline__ void epi_silu32(const f32x16& a, char* wb, int tl, int qb, int hi) {
#pragma unroll
  for (int g = 0; g < 4; ++g)
    stage_put(wb, tl, qb + 2 * g + hi, a[4 * g] * sigmoidf_(a[4 * g]), a[4 * g + 1] * sigmoidf_(a[4 * g + 1]), a[4 * g + 2] * sigmoidf_(a[4 * g + 2]),
              a[4 * g + 3] * sigmoidf_(a[4 * g + 3]));
}
__device__ __forceinline__ float sumsq16(const f32x16& a) {
  float s = 0.f;
#pragma unroll
  for (int r = 0; r < 16; ++r) s += a[r] * a[r];
  return s;
}

struct TileIter {
  int q, step, end, NT, mbase; bool xcd;
  __device__ __forceinline__ TileIter(int nt_count) {
    NT = nt_count; xcd = (gridDim.x == 256);
    if (xcd) { q = blockIdx.x >> 3; step = 32; end = 16 * NT; mbase = (blockIdx.x & 7) * 16; }
    else { q = blockIdx.x; step = gridDim.x; end = 128 * NT; mbase = 0; }
  }
  __device__ __forceinline__ bool next(int& mt, int& nt) { if (q >= end) return false; mt = mbase + q / NT; nt = q % NT; q += step; return true; }
};

__device__ __forceinline__ void bound_max(float* dst, float v) {
#pragma unroll
  for (int o = 32; o >= 1; o >>= 1) v = fmaxf(v, __shfl_xor(v, o));
  if ((threadIdx.x & 63) == 0) atomicMax((unsigned*)dst, __float_as_uint(v));
}
__device__ __forceinline__ void phase_g1(const Params& p, char* lds) {
  const int tid = opaque_tid(), wid = __builtin_amdgcn_readfirstlane(tid >> 6), lane = tid & 63, r32 = lane & 31, hi = lane >> 5, wm = wid & 1, wn4 = wid >> 1;
  const int wn = wn4 & 1;
  const bf16_t* H = (const bf16_t*)(p.ws + OFF_H);
  const bf16_t* WIN = (const bf16_t*)(p.ws + OFF_WIN);
  const float2* tabA = (const float2*)(p.ws + OFF_TABA);
  const float2* tabB = (const float2*)(p.ws + OFF_TABB);
  float* part = (float*)(p.ws + OFF_PART);
  char* dout = (char*)p.out;
  float bmax_kr = 0.f;
  TileIter it(10); int mt, nt2;
  while (it.next(mt, nt2)) {
    const int m0 = mt * 256;
    f32x16 acc[2][4];
    zero_acc4(acc);
    gemm_kloop256(H + (size_t)m0 * DM, DM, WIN + (size_t)nt2 * 256 * DM, DM, 16, acc, lds);
    const int nt = nt2 * 2 + (wn4 >> 1);
    char* wb = lds + wid * 16384;
    const int tok0 = m0 + wm * 128;
#pragma unroll
    for (int ti = 0; ti < 4; ++ti) {
      const int tl = ti * 32 + r32, tok = tok0 + tl;
      const int t = pos_of(tok);
      if (nt < 4) {
        epi_rope64(acc[0][ti], acc[1][ti], t, p.a_q_g, PS_A, tabA, wb, tl, hi);
      } else if (nt == 4) {
        epi_rope64(acc[0][ti], acc[1][ti], t, p.a_k_g, 1.0f, tabA, wb, tl, hi);
      } else if (nt == 5) {
        epi_plain32(acc[0][ti], 1.0f, wb, tl, 0, hi); epi_plain32(acc[1][ti], 1.0f, wb, tl, 8, hi);
      } else if (nt < 9) {
        epi_plain32(acc[0][ti], 1.0f, wb, tl, 0, hi); epi_plain32(acc[1][ti], 1.0f, wb, tl, 8, hi);
        float s = sumsq16(acc[0][ti]) + sumsq16(acc[1][ti]); s += __shfl_xor(s, 32);
        if (hi == 0) part[((nt - 6) * 2 + wn) * T + tok] = s;
      } else if (nt < 11) {
        epi_plain32(acc[0][ti], 1.0f, wb, tl, 0, hi); epi_plain32(acc[1][ti], 1.0f, wb, tl, 8, hi);
        float s = sumsq16(acc[0][ti]) + sumsq16(acc[1][ti]); s += __shfl_xor(s, 32);
        if (hi == 0) part[(6 + (nt - 9) * 2 + wn) * T + tok] = s;
      } else if (nt == 11) {
        if (wn == 0) {
          epi_rope32_direct(acc[0][ti], 1.0f, t, tabB, (bf16_t*)(p.ws + OFF_KR) + (size_t)tok * 32, hi);
          float s = sumsq16(acc[0][ti]); s += __shfl_xor(s, 32);
          bmax_kr = fmaxf(bmax_kr, s);
        }
      } else {
        epi_silu32(acc[0][ti], wb, tl, 0, hi); epi_silu32(acc[1][ti], wb, tl, 8, hi);
      }
    }
    if (nt != 11) {
      bf16_t* dst; int ld;
      if (nt < 4) { dst = (bf16_t*)(p.ws + OFF_QA) + (size_t)tok0 * 512 + (nt * 2 + wn) * 64; ld = 512; }
      else if (nt == 4) { dst = (bf16_t*)(p.ws + OFF_KA) + (size_t)tok0 * 128 + wn * 64; ld = 128; }
      else if (nt == 5) { dst = (bf16_t*)(p.ws + OFF_VA) + (size_t)tok0 * 128 + wn * 64; ld = 128; }
      else if (nt < 9) { dst = (bf16_t*)(dout + OO_BQ) + (size_t)tok0 * 384 + (nt - 6) * 128 + wn * 64; ld = 384; }
      else if (nt < 11) { dst = (bf16_t*)(dout + OO_BKV) + (size_t)tok0 * 256 + (nt - 9) * 128 + wn * 64; ld = 256; }
      else if (nt < 16) { dst = (bf16_t*)(dout + OO_GA) + (size_t)tok0 * 512 + (nt - 12) * 128 + wn * 64; ld = 512; }
      else { dst = (bf16_t*)(dout + OO_GB) + (size_t)tok0 * 512 + (nt - 16) * 128 + wn * 64; ld = 512; }
      stage_flush128(wb, dst, ld, lane);
    }
  }
  bound_max((float*)(p.ws + OFF_BND) + 3, bmax_kr);
}

__device__ __forceinline__ void phase_g2(const Params& p, char* lds) {
  const int tid = opaque_tid(), wid = __builtin_amdgcn_readfirstlane(tid >> 6), lane = tid & 63, r32 = lane & 31, hi = lane >> 5, wm = wid & 3, wn = wid >> 2;
  const float2* tabB = (const float2*)(p.ws + OFF_TABB);
  const float* part = (const float*)(p.ws + OFF_PART);
  char* dout = (char*)p.out;
  float bmax_q = 0.f, bmax_k = 0.f;
  TileIter it(14); int mt, j;
  while (it.next(mt, j)) {
    const int m0 = mt * 256;
    f32x16 acc[2][2];
    zero_acc(acc);
    char* wb = lds + wid * 8192;
    const int tok0 = m0 + wm * 64;
    if (j < 6) {
      gemm_kloop((const bf16_t*)(dout + OO_BQ) + (size_t)m0 * 384, 384, (const bf16_t*)(p.ws + OFF_WQUP) + (size_t)j * 128 * 384, 384, 6, acc, lds);
#pragma unroll
      for (int ti = 0; ti < 2; ++ti) {
        const int tl = ti * 32 + r32, tok = tok0 + tl;
        const int t = pos_of(tok);
        const float sq = (part[tok] + part[T + tok]) + (part[2 * T + tok] + part[3 * T + tok]) + (part[4 * T + tok] + part[5 * T + tok]);
        const float rn = rsqrtf(sq * (1.0f / 384.0f) + EPS) * PS_B;
#pragma unroll
        for (int fi = 0; fi < 2; ++fi) {
          const int blk = j * 4 + wn * 2 + fi;
          if (blk % 3 == 2) epi_rope32(acc[fi][ti], rn, t, tabB, wb, tl, fi * 8, hi);
          else epi_plain32(acc[fi][ti], rn, wb, tl, fi * 8, hi);
          float s = sumsq16(acc[fi][ti]); s += __shfl_xor(s, 32);
          bmax_q = fmaxf(bmax_q, s * rn * rn);
        }
      }
      stage_flush(wb, (bf16_t*)(p.ws + OFF_QB) + (size_t)tok0 * 768 + (j * 4 + wn * 2) * 32, 768, lane);
    } else {
      const int jn = j - 6;
      gemm_kloop((const bf16_t*)(dout + OO_BKV) + (size_t)m0 * 256, 256, (const bf16_t*)(p.ws + OFF_WKVUP) + (size_t)jn * 128 * 256, 256, 4, acc, lds);
#pragma unroll
      for (int ti = 0; ti < 2; ++ti) {
        const int tl = ti * 32 + r32, tok = tok0 + tl;
        const float sk = (part[6 * T + tok] + part[7 * T + tok]) + (part[8 * T + tok] + part[9 * T + tok]);
        const float rn = rsqrtf(sk * (1.0f / 256.0f) + EPS);
        epi_plain32(acc[0][ti], rn, wb, tl, 0, hi); epi_plain32(acc[1][ti], rn, wb, tl, 8, hi);
        if (wn == 0) {
          float s0 = sumsq16(acc[0][ti]), s1 = sumsq16(acc[1][ti]); s0 += __shfl_xor(s0, 32); s1 += __shfl_xor(s1, 32);
          bmax_k = fmaxf(bmax_k, fmaxf(s0, s1) * rn * rn);
        }
      }
      stage_flush(wb, (bf16_t*)(p.ws + (wn == 0 ? OFF_KBN : OFF_VB)) + (size_t)tok0 * 512 + jn * 64, 512, lane);
    }
  }
  bound_max((float*)(p.ws + OFF_BND) + 1, bmax_q);
  bound_max((float*)(p.ws + OFF_BND) + 2, bmax_k);
}

__device__ __forceinline__ void phase_g3(const Params& p, char* lds) {
  const int tid = opaque_tid(), wid = __builtin_amdgcn_readfirstlane(tid >> 6), lane = tid & 63, r32 = lane & 31, hi = lane >> 5, wm = wid & 3, wn = wid >> 2;
  char* dout = (char*)p.out;
  const bf16_t* H = (const bf16_t*)(p.ws + OFF_H);
  const bf16_t* WIN = (const bf16_t*)(p.ws + OFF_WIN);
  bf16_t* MG = (bf16_t*)(dout + OO_MERGED);
  TileIter it(8); int mt, nt;
  while (it.next(mt, nt)) {
    const int m0 = mt * 256;
#pragma nounroll
    for (int s = 0; s < 2; ++s) {
      f32x16 acc[2][2];
      zero_acc(acc);
      const bf16_t* Y = s == 0 ? (const bf16_t*)(p.ws + OFF_QA) : (const bf16_t*)(dout + OO_YB);
      const bf16_t* WOUT = (const bf16_t*)(p.ws + (s == 0 ? OFF_WAOUT : OFF_WBOUT));
      gemm_kloop(H + (size_t)m0 * DM, DM, WIN + (size_t)(2560 + s * 1024 + nt * 128) * DM, DM, 16, acc, lds);
      unsigned* gl = (unsigned*)(lds + 2 * G_STAGE) + tid;
#pragma unroll
      for (int fi = 0; fi < 2; ++fi)
#pragma unroll
        for (int ti = 0; ti < 2; ++ti)
#pragma unroll
          for (int q = 0; q < 8; ++q) gl[((fi * 2 + ti) * 8 + q) * 512] = cvtpk(sigmoidf_(acc[fi][ti][2 * q]), sigmoidf_(acc[fi][ti][2 * q + 1]));
      zero_acc(acc);
      gemm_kloop(Y + (size_t)m0 * 512, 512, WOUT + (size_t)nt * 128 * 512, 512, 8, acc, lds);
      char* wb = lds + wid * 8192;
#pragma unroll
      for (int ti = 0; ti < 2; ++ti) {
        const int tl = ti * 32 + r32;
#pragma unroll
        for (int fi = 0; fi < 2; ++fi) {
#pragma unroll
          for (int g = 0; g < 4; ++g) {
            const unsigned g01 = gl[((fi * 2 + ti) * 8 + 2 * g) * 512], g23 = gl[((fi * 2 + ti) * 8 + 2 * g + 1) * 512];
            stage_put(wb, tl, fi * 8 + 2 * g + hi, __uint_as_float(g01 << 16) * acc[fi][ti][4 * g], __uint_as_float(g01 & 0xffff0000u) * acc[fi][ti][4 * g + 1],
                      __uint_as_float(g23 << 16) * acc[fi][ti][4 * g + 2], __uint_as_float(g23 & 0xffff0000u) * acc[fi][ti][4 * g + 3]);
          }
        }
      }
      bf16_t* dst = MG + (size_t)(m0 + wm * 64) * DM + nt * 128 + wn * 64;
      if (s == 0) stage_flush(wb, dst, DM, lane); else stage_flush_add(wb, dst, DM, lane);
    }
  }
}

__device__ __forceinline__ void phase_g4(const Params& p, char* lds) {
  const int tid = opaque_tid(), wid = __builtin_amdgcn_readfirstlane(tid >> 6), lane = tid & 63, r32 = lane & 31, hi = lane >> 5, wm = wid & 1, wn4 = wid >> 1;
  char* dout = (char*)p.out;
  const bf16_t* MG = (const bf16_t*)(dout + OO_MERGED);
  bf16_t* Z = (bf16_t*)(p.ws + OFF_H);
  float* part = (float*)(p.ws + OFF_PART) + 10 * T;
  TileIter it(4); int mt, nt;
  while (it.next(mt, nt)) {
    const int m0 = mt * 256;
    f32x16 acc[2][4];
    zero_acc4(acc);
    gemm_kloop256(MG + (size_t)m0 * DM, DM, (const bf16_t*)(p.ws + OFF_WO) + (size_t)nt * 256 * DM, DM, 16, acc, lds);
    char* wb = lds + wid * 16384;
    const int tok0 = m0 + wm * 128;
#pragma unroll
    for (int ti = 0; ti < 4; ++ti) {
      const int tl = ti * 32 + r32, tok = tok0 + tl;
      epi_plain32(acc[0][ti], 1.0f, wb, tl, 0, hi); epi_plain32(acc[1][ti], 1.0f, wb, tl, 8, hi);
      float s = sumsq16(acc[0][ti]) + sumsq16(acc[1][ti]); s += __shfl_xor(s, 32);
      if (hi == 0) part[(nt * 4 + wn4) * T + tok] = s;
    }
    stage_flush128(wb, Z + (size_t)tok0 * DM + nt * 256 + wn4 * 64, DM, lane);
  }
}

__device__ __forceinline__ void phase5(const Params& p) {
  const int tid = opaque_tid(), wid = tid >> 6, lane = tid & 63;
  const float* mod = (const float*)(p.ws + OFF_MOD);
  const bf16_t* Z = (const bf16_t*)(p.ws + OFF_H);
  const float* part = (const float*)(p.ws + OFF_PART) + 10 * T;
  const int NW = gridDim.x * 8;
  for (int row0 = blockIdx.x * 8 + wid; row0 < T; row0 += 2 * NW) {
    float4 xv[2][4]; u32x2 zz[2][4]; float pz[2];
#pragma unroll
    for (int j = 0; j < 2; ++j) {
      const int row = row0 + j * NW;
      if (row < T) {
        const float* xr = xrow_ptr(p, row);
        pz[j] = lane < 16 ? part[lane * T + row] : 0.f;
#pragma unroll
        for (int i = 0; i < 4; ++i) { xv[j][i] = nt_load4(xr + i * 256 + lane * 4); zz[j][i] = __builtin_nontemporal_load((const u32x2*)(Z + (size_t)row * DM + i * 256 + lane * 4)); }
      }
    }
#pragma unroll
    for (int j = 0; j < 2; ++j) {
      const int row = row0 + j * NW;
      if (row < T) {
        const int b = batch_of(row);
        const float rn = rsqrtf(wave_sum(pz[j]) * (1.0f / 1024.0f) + EPS);
        float* o = p.out + (size_t)row * DM;
#pragma unroll
        for (int i = 0; i < 4; ++i) {
          const int col = i * 256 + lane * 4;
          const float4 g = *(const float4*)(p.post_g + col);
          const float4 gt = *(const float4*)(mod + b * 3072 + 2048 + col);
          float4 r;
          r.x = xv[j][i].x + gt.x * (__uint_as_float(zz[j][i].x << 16) * rn * g.x);
          r.y = xv[j][i].y + gt.y * (__uint_as_float(zz[j][i].x & 0xffff0000u) * rn * g.y);
          r.z = xv[j][i].z + gt.z * (__uint_as_float(zz[j][i].y << 16) * rn * g.z);
          r.w = xv[j][i].w + gt.w * (__uint_as_float(zz[j][i].y & 0xffff0000u) * rn * g.w);
          nt_store4(o + col, r);
        }
      }
    }
  }
}

#define SBAR() __builtin_amdgcn_sched_barrier(0)
constexpr float ATT_THR = 8.0f;
constexpr int SHM_V = 64 * 64 * 2;
template <int DK> struct KL { static constexpr int RB = DK == 64 ? 128 : 256; static constexpr int SHM_K = 64 * RB; };
template <int DK> __device__ __forceinline__ int kswz(int row, int c) {
  if (DK == 64) return row * 128 + ((c ^ ((row >> 1) & 7)) << 4);
  return row * 256 + ((c ^ (row & 15)) << 4);
}
__device__ __forceinline__ int v_st(int k, int c) {
  const int kk = (k & ~0xC) | ((k & 4) << 1) | ((k & 8) >> 1);
  return ((kk >> 3) * 2 + (c >> 5)) * 512 + ((kk & 7) * 32 + (c & 31)) * 2;
}
__device__ __forceinline__ int v_rd_base(int lane) { return ((lane & 3) << 3) | (((lane >> 2) & 3) << 6) | (((lane >> 4) & 1) << 5) | (((lane >> 5) & 1) << 8); }
constexpr int v_rd_off(int d0, int ks, int half) { return d0 * 512 + ks * 2048 + half * 1024; }
typedef __attribute__((address_space(3))) const char* lds_cptr;
typedef short v4i16_t __attribute__((ext_vector_type(4)));
__device__ __forceinline__ s16x4 vtr(lds_cptr p) { return __builtin_bit_cast(s16x4, __builtin_amdgcn_ds_read_tr16_b64_v4i16((__attribute__((address_space(3))) v4i16_t*)p)); }
template <int D0> __device__ __forceinline__ void pv_one(f32x16& od, lds_cptr vb, bf16x8 pa0, bf16x8 pa1, bf16x8 pa2, bf16x8 pa3) {
  const s16x4 l0 = vtr(vb + v_rd_off(D0, 0, 0)), h0 = vtr(vb + v_rd_off(D0, 0, 1)), l1 = vtr(vb + v_rd_off(D0, 1, 0)), h1 = vtr(vb + v_rd_off(D0, 1, 1));
  const s16x4 l2 = vtr(vb + v_rd_off(D0, 2, 0)), h2 = vtr(vb + v_rd_off(D0, 2, 1)), l3 = vtr(vb + v_rd_off(D0, 3, 0)), h3 = vtr(vb + v_rd_off(D0, 3, 1));
#define PK(L, Hh) (bf16x8){L[0], L[1], L[2], L[3], Hh[0], Hh[1], Hh[2], Hh[3]}
  od = __builtin_amdgcn_mfma_f32_32x32x16_bf16(pa0, PK(l0, h0), od, 0, 0, 0);
  od = __builtin_amdgcn_mfma_f32_32x32x16_bf16(pa1, PK(l1, h1), od, 0, 0, 0);
  od = __builtin_amdgcn_mfma_f32_32x32x16_bf16(pa2, PK(l2, h2), od, 0, 0, 0);
  od = __builtin_amdgcn_mfma_f32_32x32x16_bf16(pa3, PK(l3, h3), od, 0, 0, 0);
#undef PK
}
__device__ __forceinline__ void pv_all(f32x16* o, lds_cptr vb, bf16x8 pa0, bf16x8 pa1, bf16x8 pa2, bf16x8 pa3) {
  pv_one<0>(o[0], vb, pa0, pa1, pa2, pa3); pv_one<1>(o[1], vb, pa0, pa1, pa2, pa3);
}
__device__ __forceinline__ void partialSM(f32x16& p0, f32x16& p1, float& m_reg, float& alpha) {
  float pmax = p0[0];
#pragma unroll
  for (int r = 1; r < 16; ++r) pmax = fmaxf(pmax, p0[r]);
#pragma unroll
  for (int r = 0; r < 16; ++r) pmax = fmaxf(pmax, p1[r]);
  { auto rr = __builtin_amdgcn_permlane32_swap(__float_as_uint(pmax), __float_as_uint(pmax), false, false);
    pmax = fmaxf(__uint_as_float(rr[0]), __uint_as_float(rr[1])); }
  float mn;
  if (__builtin_expect(__all(pmax - m_reg <= ATT_THR), 1)) { mn = m_reg; alpha = 1.f; }
  else { mn = fmaxf(m_reg, pmax); alpha = __builtin_amdgcn_exp2f(m_reg - mn); m_reg = mn; }
#pragma unroll
  for (int r = 0; r < 16; ++r) p0[r] -= mn;
#pragma unroll
  for (int r = 0; r < 16; ++r) p1[r] -= mn;
#pragma unroll
  for (int r = 0; r < 16; ++r) p0[r] = __builtin_amdgcn_exp2f(p0[r]);
}
__device__ __forceinline__ void finishSM(f32x16& p0, f32x16& p1, float alpha, float& l_reg, bf16x8& pa0, bf16x8& pa1, bf16x8& pa2, bf16x8& pa3) {
#pragma unroll
  for (int r = 0; r < 16; ++r) p1[r] = __builtin_amdgcn_exp2f(p1[r]);
  float ps = 0.f;
#pragma unroll
  for (int r = 0; r < 16; ++r) ps += p0[r];
#pragma unroll
  for (int r = 0; r < 16; ++r) ps += p1[r];
  { auto rr = __builtin_amdgcn_permlane32_swap(__float_as_uint(ps), __float_as_uint(ps), false, false);
    ps = __uint_as_float(rr[0]) + __uint_as_float(rr[1]); }
  l_reg = l_reg * alpha + ps;
#define PK4(P, BASE, OUT) do { unsigned a0 = cvtpk(P[BASE + 0], P[BASE + 1]), a1 = cvtpk(P[BASE + 2], P[BASE + 3]);   \
    unsigned b0 = cvtpk(P[BASE + 4], P[BASE + 5]), b1 = cvtpk(P[BASE + 6], P[BASE + 7]);                              \
    auto r0 = __builtin_amdgcn_permlane32_swap(a0, b0, false, false); auto r1 = __builtin_amdgcn_permlane32_swap(a1, b1, false, false); \
    u32x4 w = {r0[0], r1[0], r0[1], r1[1]}; OUT = *reinterpret_cast<bf16x8*>(&w); } while (0)
  PK4(p0, 0, pa0); PK4(p0, 8, pa1); PK4(p1, 0, pa2); PK4(p1, 8, pa3);
#undef PK4
}
template <int DK> __device__ __forceinline__ void qkt(f32x16& p0, f32x16& p1, const char* Ks, const bf16x8* qr, int r32, int hi) {
#pragma unroll
  for (int r = 0; r < 16; ++r) { p0[r] = 0.f; p1[r] = 0.f; }
#pragma unroll
  for (int d0 = 0; d0 < DK / 16; ++d0) {
    const int off = kswz<DK>(r32, 2 * d0 + hi);
    const bf16x8 b0 = *reinterpret_cast<const bf16x8*>(Ks + off);
    const bf16x8 b1 = *reinterpret_cast<const bf16x8*>(Ks + off + 32 * KL<DK>::RB);
    p0 = __builtin_amdgcn_mfma_f32_32x32x16_bf16(b0, qr[d0], p0, 0, 0, 0);
    p1 = __builtin_amdgcn_mfma_f32_32x32x16_bf16(b1, qr[d0], p1, 0, 0, 0);
    if (QKT_SB && (d0 & 1) == 1 && d0 + 1 < DK / 16) SBAR();
  }
}

template <int DK>
__device__ __forceinline__ void attn_unit(const bf16_t* Qb, int ldq, const bf16_t* __restrict__ Kh, int ldk, const bf16_t* __restrict__ Krp,
                                          const bf16_t* __restrict__ Vh, int ldv, const bf16_t* Gb, bf16_t* Ob, int seq, char* lds) {
  constexpr int SHM_K = KL<DK>::SHM_K;
  const int tid = opaque_tid(), wid = __builtin_amdgcn_readfirstlane(tid >> 6), lane = tid & 63, r32 = lane & 31, hi = lane >> 5;
  char* V_lds = lds; char* K_lds = lds + 2 * SHM_V;
  float* ws = (float*)(lds + 2 * SHM_V + 2 * SHM_K) + wid * 64; float* li_l = ws; float* al_l = ws + 32;
  float m_reg = -1e30f, l_reg = 0.f; f32x16 o[2]; bf16x8 qr[DK / 16];
#pragma unroll
  for (int r = 0; r < 16; ++r) { o[0][r] = 0.f; o[1][r] = 0.f; }
  const bf16_t* Qw = Qb + (size_t)(wid * 32 + r32) * ldq + hi * 8;
#pragma unroll
  for (int d0 = 0; d0 < DK / 16; ++d0) qr[d0] = *reinterpret_cast<const bf16x8*>(Qw + d0 * 16);
  const int srow = tid >> 3, sc = tid & 7, vst = v_st(srow, sc * 8), kst = kswz<DK>(srow, sc);
  const int rrow = tid >> 2, rc = tid & 3, krst = kswz<DK>(rrow & 63, 8 + rc);
  const bool dor = (DK == 96) && (wid < 4);
  const lds_cptr vb0 = (lds_cptr)V_lds + v_rd_base(lane);
  struct { u32x4 v, k, r; } sr_[1];
  const unsigned voff0 = (unsigned)(srow * ldv + sc * 8) * 2u, koff0 = (unsigned)(srow * ldk + sc * 8) * 2u, roff0 = (unsigned)(rrow * 32 + rc * 8) * 2u;
#define SLOAD(i, k0) do { sr_[i].v = *(const u32x4*)((const char*)Vh + (voff0 + (unsigned)((k0) * ldv) * 2u)); sr_[i].k = *(const u32x4*)((const char*)Kh + (koff0 + (unsigned)((k0) * ldk) * 2u)); \
    if (dor) sr_[i].r = *(const u32x4*)((const char*)Krp + (roff0 + (unsigned)((k0) * 64))); } while (0)
#define SWRITE(b, i) do { *(u32x4*)(V_lds + (b) * SHM_V + vst) = sr_[i].v; *(u32x4*)(K_lds + (b) * SHM_K + kst) = sr_[i].k; \
    if (dor) *(u32x4*)(K_lds + (b) * SHM_K + krst) = sr_[i].r; } while (0)
#define RESC(a) do { if (__any((a) < 1.f)) { if (hi == 0) al_l[r32] = (a); asm volatile("s_waitcnt lgkmcnt(0)" ::: "memory"); \
    _Pragma("unroll") for (int d = 0; d < 2; ++d) _Pragma("unroll") for (int r = 0; r < 16; ++r) o[d][r] *= al_l[crow(r, hi)]; } } while (0)
  f32x16 pA0, pA1, pB0, pB1; float alA, alB; bf16x8 pa0, pa1, pa2, pa3; const int NT = seq / 64;
  __syncthreads();
  SLOAD(0, 0); SWRITE(0, 0); __syncthreads();
  qkt<DK>(pA0, pA1, K_lds, qr, r32, hi); partialSM(pA0, pA1, m_reg, alA);
  SLOAD(0, 64);
  SWRITE(1, 0); __syncthreads();
  for (int j = 1; j + 1 < NT; j += 2) {
    SBAR(); qkt<DK>(pB0, pB1, K_lds + SHM_K, qr, r32, hi);
    finishSM(pA0, pA1, alA, l_reg, pa0, pa1, pa2, pa3); SBAR();
    SLOAD(0, (j + 1) * 64); SBAR();
    pv_all(o, vb0, pa0, pa1, pa2, pa3); partialSM(pB0, pB1, m_reg, alB);
    __syncthreads(); SWRITE(0, 0);
    RESC(alB); __syncthreads();
    SBAR(); qkt<DK>(pA0, pA1, K_lds, qr, r32, hi);
    finishSM(pB0, pB1, alB, l_reg, pa0, pa1, pa2, pa3); SBAR();
    SLOAD(0, (j + 2) * 64); SBAR();
    pv_all(o, vb0 + SHM_V, pa0, pa1, pa2, pa3); partialSM(pA0, pA1, m_reg, alA);
    __syncthreads(); SWRITE(1, 0);
    RESC(alA); __syncthreads();
  }
  SBAR(); qkt<DK>(pB0, pB1, K_lds + SHM_K, qr, r32, hi);
  finishSM(pA0, pA1, alA, l_reg, pa0, pa1, pa2, pa3); SBAR();
  pv_all(o, vb0, pa0, pa1, pa2, pa3); partialSM(pB0, pB1, m_reg, alB);
  __syncthreads(); RESC(alB);
  finishSM(pB0, pB1, alB, l_reg, pa0, pa1, pa2, pa3); SBAR();
  pv_all(o, vb0 + SHM_V, pa0, pa1, pa2, pa3);
  if (hi == 0) li_l[r32] = l_reg; asm volatile("s_waitcnt lgkmcnt(0)" ::: "memory");
  float rli[16];
#pragma unroll
  for (int r = 0; r < 16; ++r) rli[r] = __builtin_amdgcn_rcpf(li_l[crow(r, hi)]);
#pragma unroll
  for (int r = 0; r < 16; ++r) {
    const size_t rowo = (size_t)(wid * 32 + crow(r, hi)) * 512;
#pragma unroll
    for (int d0 = 0; d0 < 2; ++d0) {
      const size_t idx = rowo + d0 * 32 + r32;
      const float g = bf2f(Gb[idx]);
      Ob[idx] = (bf16_t)(cvtpk(o[d0][r] * rli[r] * g, 0.f) & 0xffffu);
    }
  }
#undef SLOAD
#undef SWRITE
#undef RESC
}

__device__ __forceinline__ void exp16(f32x16& p) {
#pragma unroll
  for (int r = 0; r < 16; ++r) p[r] = __builtin_amdgcn_exp2f(p[r]);
}
__device__ __forceinline__ void finishFast(f32x16& p0, f32x16& p1, float& l_reg, bf16x8& pa0, bf16x8& pa1, bf16x8& pa2, bf16x8& pa3) {
  exp16(p1);
  float ps = 0.f;
#pragma unroll
  for (int r = 0; r < 16; ++r) ps += p0[r];
#pragma unroll
  for (int r = 0; r < 16; ++r) ps += p1[r];
  l_reg += ps;
#define PK4(P, BASE, OUT) do { unsigned a0 = cvtpk(P[BASE + 0], P[BASE + 1]), a1 = cvtpk(P[BASE + 2], P[BASE + 3]);   \
    unsigned b0 = cvtpk(P[BASE + 4], P[BASE + 5]), b1 = cvtpk(P[BASE + 6], P[BASE + 7]);                              \
    auto r0 = __builtin_amdgcn_permlane32_swap(a0, b0, false, false); auto r1 = __builtin_amdgcn_permlane32_swap(a1, b1, false, false); \
    u32x4 w = {r0[0], r1[0], r0[1], r1[1]}; OUT = *reinterpret_cast<bf16x8*>(&w); } while (0)
  PK4(p0, 0, pa0); PK4(p0, 8, pa1); PK4(p1, 0, pa2); PK4(p1, 8, pa3);
#undef PK4
}
template <int DK>
__device__ __forceinline__ void attn_unit_fast(const bf16_t* Qb, int ldq, const bf16_t* __restrict__ Kh, int ldk, const bf16_t* __restrict__ Krp,
                                               const bf16_t* __restrict__ Vh, int ldv, const bf16_t* Gb, bf16_t* Ob, int seq, char* lds) {
  constexpr int SHM_K = KL<DK>::SHM_K;
  const int tid = opaque_tid(), wid = __builtin_amdgcn_readfirstlane(tid >> 6), lane = tid & 63, r32 = lane & 31, hi = lane >> 5;
  char* V_lds = lds; char* K_lds = lds + 3 * SHM_V;
  float* ws = (float*)(lds + 3 * SHM_V + 3 * SHM_K) + wid * 64; float* li_l = ws;
  float l_reg = 0.f; f32x16 o[2]; bf16x8 qr[DK / 16];
#pragma unroll
  for (int r = 0; r < 16; ++r) { o[0][r] = 0.f; o[1][r] = 0.f; }
  const bf16_t* Qw = Qb + (size_t)(wid * 32 + r32) * ldq + hi * 8;
#pragma unroll
  for (int d0 = 0; d0 < DK / 16; ++d0) qr[d0] = *reinterpret_cast<const bf16x8*>(Qw + d0 * 16);
  const int srow = tid >> 3, sc = tid & 7, vst = v_st(srow, sc * 8), kst = kswz<DK>(srow, sc);
  const int rrow = tid >> 2, rc = tid & 3, krst = kswz<DK>(rrow & 63, 8 + rc);
  const bool dor = (DK == 96) && (wid < 4);
  const lds_cptr vb0 = (lds_cptr)V_lds + v_rd_base(lane);
  struct { u32x4 v, k, r; } sr_[1];
  const unsigned voff0 = (unsigned)(srow * ldv + sc * 8) * 2u, koff0 = (unsigned)(srow * ldk + sc * 8) * 2u, roff0 = (unsigned)(rrow * 32 + rc * 8) * 2u;
#define SLOAD(i, k0) do { sr_[i].v = *(const u32x4*)((const char*)Vh + (voff0 + (unsigned)((k0) * ldv) * 2u)); sr_[i].k = *(const u32x4*)((const char*)Kh + (koff0 + (unsigned)((k0) * ldk) * 2u)); \
    if (dor) sr_[i].r = *(const u32x4*)((const char*)Krp + (roff0 + (unsigned)((k0) * 64))); } while (0)
#define SWRITE(slot, i) do { *(u32x4*)(V_lds + (slot) * SHM_V + vst) = sr_[i].v; *(u32x4*)(K_lds + (slot) * SHM_K + kst) = sr_[i].k; \
    if (dor) *(u32x4*)(K_lds + (slot) * SHM_K + krst) = sr_[i].r; } while (0)
  f32x16 pA0, pA1, pB0, pB1; bf16x8 pa0, pa1, pa2, pa3; const int NT = seq / 64;
  int sp = 2, st = 0, sn = 1;
#define ROT() do { sp = st; st = sn; sn = (sn == 2) ? 0 : sn + 1; } while (0)
#define STEP(C0, C1, P0, P1, SETW, t, DOW) do { SBAR(); qkt<DK>(C0, C1, K_lds + st * SHM_K, qr, r32, hi); \
    finishFast(P0, P1, l_reg, pa0, pa1, pa2, pa3); \
    if (DOW) { SWRITE(sn, 0); if ((t) + 2 < NT) SLOAD(0, ((t) + 2) * 64); } \
    pv_all(o, vb0 + sp * SHM_V, pa0, pa1, pa2, pa3); exp16(C0); \
    __syncthreads(); ROT(); } while (0)
  __syncthreads();
  SLOAD(0, 0); SWRITE(0, 0); SLOAD(0, 64); __syncthreads();
  qkt<DK>(pA0, pA1, K_lds, qr, r32, hi);
  SWRITE(1, 0); SLOAD(0, 128);
  exp16(pA0);
  __syncthreads(); ROT();
  for (int t = 1; t + 1 < NT; t += 2) {
    STEP(pB0, pB1, pA0, pA1, 0, t, true);
    STEP(pA0, pA1, pB0, pB1, 1, t + 1, true);
  }
  STEP(pB0, pB1, pA0, pA1, 0, NT - 1, false);
  finishFast(pB0, pB1, l_reg, pa0, pa1, pa2, pa3); SBAR();
  pv_all(o, vb0 + sp * SHM_V, pa0, pa1, pa2, pa3);
  { auto rr = __builtin_amdgcn_permlane32_swap(__float_as_uint(l_reg), __float_as_uint(l_reg), false, false);
    l_reg = __uint_as_float(rr[0]) + __uint_as_float(rr[1]); }
  if (hi == 0) li_l[r32] = l_reg; asm volatile("s_waitcnt lgkmcnt(0)" ::: "memory");
  float rli[16];
#pragma unroll
  for (int r = 0; r < 16; ++r) rli[r] = __builtin_amdgcn_rcpf(li_l[crow(r, hi)]);
  {
    float* ost = (float*)(lds + 81920) + wid * 2048;
#pragma unroll
    for (int r = 0; r < 16; ++r) {
      const int row = crow(r, hi);
      ost[row * 64 + r32] = o[0][r] * rli[r];
      ost[row * 64 + 32 + r32] = o[1][r] * rli[r];
    }
#pragma unroll
    for (int i = 0; i < 8; ++i) {
      const int row = i * 4 + (lane >> 4), c4 = (lane & 15) * 4;
      const float4 v = *(const float4*)(ost + row * 64 + c4);
      const size_t idx = (size_t)(wid * 32 + row) * 512 + c4;
      const u32x2 g = *(const u32x2*)(Gb + idx);
      st4(Ob + idx, v.x * __uint_as_float(g.x << 16), v.y * __uint_as_float(g.x & 0xffff0000u), v.z * __uint_as_float(g.y << 16), v.w * __uint_as_float(g.y & 0xffff0000u));
    }
  }
#undef SLOAD
#undef SWRITE
#undef ROT
#undef STEP
}

__device__ __forceinline__ void phase_attn(const Params& p, char* lds) {
  char* dout = (char*)p.out;
  const float* bnd = (const float*)(p.ws + OFF_BND);
  const bool fastA = bnd[0] < 60.0f;
  const bool fastB = 3.0f * bnd[1] * (2.0f * bnd[2] + bnd[3]) < 3600.0f;
  for (int u = blockIdx.x; u < 2048; u += gridDim.x) {
    const int i = u >> 8, v = u & 255, cls = i >> 1, sub = i & 1, head = v & 7, j = v >> 3;
    int seq0, seq, tok0;
    if (cls < 2) { seq0 = 0; seq = NP; tok0 = (2 * j + sub) * 256; }
    else { const int bi = j >> 3, qb = 2 * (j & 7) + sub; seq0 = NP + bi * NS; seq = NS; tok0 = seq0 + qb * 256; }
    if ((cls & 1) == 0) {
      bf16_t* QA = (bf16_t*)(p.ws + OFF_QA);
      const bf16_t* Kp = (const bf16_t*)(p.ws + OFF_KA) + (size_t)seq0 * 128 + (head >> 2) * 64;
      const bf16_t* Vp = (const bf16_t*)(p.ws + OFF_VA) + (size_t)seq0 * 128 + (head >> 2) * 64;
      const bf16_t* Gp = (const bf16_t*)(dout + OO_GA) + (size_t)tok0 * 512 + head * 64;
      bf16_t* Qp = QA + (size_t)tok0 * 512 + head * 64;
      if (fastA) attn_unit_fast<64>(Qp, 512, Kp, 128, nullptr, Vp, 128, Gp, Qp, seq, lds);
      else if (ATT_SAFE) attn_unit<64>(Qp, 512, Kp, 128, nullptr, Vp, 128, Gp, Qp, seq, lds);
    } else {
      const bf16_t* Qp = (const bf16_t*)(p.ws + OFF_QB) + (size_t)tok0 * 768 + head * 96;
      const bf16_t* Kp = (const bf16_t*)(p.ws + OFF_KBN) + (size_t)seq0 * 512 + head * 64;
      const bf16_t* Rp = (const bf16_t*)(p.ws + OFF_KR) + (size_t)seq0 * 32;
      const bf16_t* Vp = (const bf16_t*)(p.ws + OFF_VB) + (size_t)seq0 * 512 + head * 64;
      const bf16_t* Gp = (const bf16_t*)(dout + OO_GB) + (size_t)tok0 * 512 + head * 64;
      bf16_t* Op = (bf16_t*)(dout + OO_YB) + (size_t)tok0 * 512 + head * 64;
      if (fastB) attn_unit_fast<96>(Qp, 768, Kp, 512, Rp, Vp, 512, Gp, Op, seq, lds);
      else if (ATT_SAFE) attn_unit<96>(Qp, 768, Kp, 512, Rp, Vp, 512, Gp, Op, seq, lds);
    }
  }
}

__device__ __forceinline__ void grid_barrier(unsigned* ctr, unsigned target) {
  asm volatile("s_waitcnt vmcnt(0)" ::: "memory");
  __syncthreads();
  if (threadIdx.x == 0) {
    __builtin_amdgcn_fence(__ATOMIC_RELEASE, "agent");
    asm volatile("s_waitcnt vmcnt(0)" ::: "memory");
    (void)__hip_atomic_fetch_add(ctr, 1u, __ATOMIC_RELAXED, __HIP_MEMORY_SCOPE_AGENT);
    unsigned spins = 0;
    while (__hip_atomic_load(ctr, __ATOMIC_RELAXED, __HIP_MEMORY_SCOPE_AGENT) < target) {
      __builtin_amdgcn_s_sleep(2);
      if (++spins > (1u << 24)) break;
    }
    __builtin_amdgcn_fence(__ATOMIC_ACQUIRE, "agent");
    asm volatile("s_waitcnt vmcnt(0)" ::: "memory");
  }
  __syncthreads();
}

#if MK_SINGLE
#ifndef PROBE_MASK
#define PROBE_MASK 0
#endif
__global__ void __launch_bounds__(512) fwd_kernel(Params p) {
  extern __shared__ __attribute__((aligned(16))) char lds[];
#if PROBE_MASK
  volatile unsigned long long* tst = (volatile unsigned long long*)(p.ws + OFF_BND + 256) + blockIdx.x * 16;
  if (threadIdx.x == 0) tst[0] = wall_clock64();
#define STAMP(k) if (threadIdx.x == 0) tst[k + 1] = wall_clock64();
#else
#define STAMP(k)
#endif
#define PHASE(k, call) if (PH_MASK & (1 << k)) { call; if (k == 0) { cg::this_grid().sync(); STAMP(k) } else if (k < 7) { grid_barrier((unsigned*)(p.ws + OFF_BAR), gridDim.x * (unsigned)k); STAMP(k) } }
  PHASE(0, phase0(p, lds))
  PHASE(1, phase1(p))
  PHASE(2, phase_g1(p, lds))
  PHASE(3, phase_g2(p, lds))
  PHASE(4, phase_attn(p, lds))
  PHASE(5, phase_g3(p, lds))
  PHASE(6, phase_g4(p, lds))
  PHASE(7, phase5(p))
#undef PHASE
#if PROBE_MASK
  if (blockIdx.x == 0) {
    __syncthreads();
    float* dshp = (float*)lds;
    if (threadIdx.x == 0) {
    unsigned long long tot = 0;
    for (int k = 0; k < 7; ++k) if (PROBE_MASK & (1 << k)) tot += tst[k + 1] - tst[k];
    dshp[0] = sqrtf((float)tot * (0.01f / 4000.0f));
    }
    __syncthreads();
    const float d = dshp[0];
    for (int i = threadIdx.x; i < 8 * 1024; i += 512) p.out[i] += d;
  }
#endif
}
#define MAIN_KERNEL fwd_kernel
#else
template <int PH>
__global__ void __launch_bounds__(512) ph_kernel(Params p) {
  extern __shared__ __attribute__((aligned(16))) char lds[];
  if (PH == 0) phase0(p, lds);
  if (PH == 1) phase1(p);
  if (PH == 2) phase_g1(p, lds);
  if (PH == 3) phase_g2(p, lds);
  if (PH == 4) phase_attn(p, lds);
  if (PH == 5) phase_g3(p, lds);
  if (PH == 6) phase_g4(p, lds);
  if (PH == 7) phase5(p);
}
#define MAIN_KERNEL ph_kernel<4>
#endif

extern "C" void kernel_launch(void* const* d_in, const int* in_sizes, int n_in, void* d_out, int out_size, void* d_ws, size_t ws_size,
                              hipStream_t stream) {
  Params p{};
  p.x_prompt = (const float*)d_in[0]; p.x_sample = (const float*)d_in[1]; p.c_prompt = (const float*)d_in[2]; p.c_sample = (const float*)d_in[3];
  p.ada_w = (const float*)d_in[4]; p.ada_b = (const float*)d_in[5]; p.pre_g = (const float*)d_in[6]; p.post_g = (const float*)d_in[7];
  p.w_in = (const float*)d_in[8]; p.a_q_g = (const float*)d_in[9]; p.a_k_g = (const float*)d_in[10]; p.b_q_g = (const float*)d_in[11];
  p.b_q_up = (const float*)d_in[12]; p.b_kv_g = (const float*)d_in[13]; p.b_kv_up = (const float*)d_in[14]; p.a_out = (const float*)d_in[15];
  p.b_out = (const float*)d_in[16]; p.w_o = (const float*)d_in[17];
  p.out = (float*)d_out; p.ws = (char*)d_ws;
  static int grid_blocks = 0;
  if (!grid_blocks) {
    int dev = 0, cus = 0, per_cu = 0;
    (void)hipGetDevice(&dev);
    (void)hipDeviceGetAttribute(&cus, hipDeviceAttributeMultiprocessorCount, dev);
    (void)hipFuncSetAttribute((const void*)MAIN_KERNEL, hipFuncAttributeMaxDynamicSharedMemorySize, LDS_BYTES);
    (void)hipOccupancyMaxActiveBlocksPerMultiprocessor(&per_cu, MAIN_KERNEL, 512, LDS_BYTES);
    if (per_cu < 1) per_cu = 1;
    if (per_cu > 1) per_cu = 1;
    grid_blocks = cus * per_cu;
    if (grid_blocks <= 0) grid_blocks = 256;
  }
#if MK_SINGLE
  void* args[] = {&p};
  hipError_t err = hipLaunchCooperativeKernel((const void*)fwd_kernel, dim3(grid_blocks), dim3(512), args, LDS_BYTES, stream);
  if (err != hipSuccess) fprintf(stderr, "cooperative launch failed: %s (grid %d)\n", hipGetErrorString(err), grid_blocks);
#else
  static bool attr_set = false;
  if (!attr_set) {
    (void)hipFuncSetAttribute((const void*)ph_kernel<0>, hipFuncAttributeMaxDynamicSharedMemorySize, LDS_BYTES);
    (void)hipFuncSetAttribute((const void*)ph_kernel<2>, hipFuncAttributeMaxDynamicSharedMemorySize, LDS_BYTES);
    (void)hipFuncSetAttribute((const void*)ph_kernel<3>, hipFuncAttributeMaxDynamicSharedMemorySize, LDS_BYTES);
    (void)hipFuncSetAttribute((const void*)ph_kernel<5>, hipFuncAttributeMaxDynamicSharedMemorySize, LDS_BYTES);
    (void)hipFuncSetAttribute((const void*)ph_kernel<6>, hipFuncAttributeMaxDynamicSharedMemorySize, LDS_BYTES);
    attr_set = true;
  }
  hipLaunchKernelGGL(ph_kernel<0>, dim3(grid_blocks), dim3(512), LDS_BYTES, stream, p);
  hipLaunchKernelGGL(ph_kernel<1>, dim3(grid_blocks), dim3(512), LDS_BYTES, stream, p);
  hipLaunchKernelGGL(ph_kernel<2>, dim3(grid_blocks), dim3(512), LDS_BYTES, stream, p);
  hipLaunchKernelGGL(ph_kernel<3>, dim3(grid_blocks), dim3(512), LDS_BYTES, stream, p);
  hipLaunchKernelGGL(ph_kernel<4>, dim3(grid_blocks), dim3(512), LDS_BYTES, stream, p);
  hipLaunchKernelGGL(ph_kernel<5>, dim3(grid_blocks), dim3(512), LDS_BYTES, stream, p);
  hipLaunchKernelGGL(ph_kernel<6>, dim3(grid_blocks), dim3(512), LDS_BYTES, stream, p);
  hipLaunchKernelGGL(ph_kernel<7>, dim3(grid_blocks), dim3(512), LDS_BYTES, stream, p);
#endif
}
```
